# Optimizing an MI355X kernel written in HIP

```python
import jax, jax.numpy as jnp
from jax import lax
import numpy as np

D_MODEL = 2048
BATCH = 2
SEQ = 4096
DEPTH = 2

HEAD_DIM = 128
A_Q_HEADS = 8
A_KV_HEADS = 2
B_GROUPS = ((128, 1), (512, 4), (2048, 16))
B_HEADS_PER_GROUP = 2
B_HEADS = B_HEADS_PER_GROUP * len(B_GROUPS)
B_Q_BLOCK = 64
C_Q_HEADS = 8
C_KV_HEADS = 2
C_HALF_WINDOW = 128
Q_BLOCK = 128
N_BRANCHES = 3
GRID_W = 64
ROPE_THETA = 10000.0
PEER_HEADS = 8
PEER_N_KEYS = 128
PEER_N_EXPERTS = PEER_N_KEYS * PEER_N_KEYS
PEER_QUERY_DIM = 256
PEER_TOPK = 16
PEER_TOKEN_CHUNK = 128
LN_EPS = 1e-5
QK_EPS = 1e-6
NEG_INF = -1e30
DEEPNORM_ALPHA = (2 * DEPTH) ** 0.25
DEEPNORM_BETA = (8 * DEPTH) ** -0.25

A_Q_W = A_Q_HEADS * HEAD_DIM
A_KV_W = A_KV_HEADS * HEAD_DIM
B_W = B_HEADS * HEAD_DIM
C_Q_W = C_Q_HEADS * HEAD_DIM
C_KV_W = C_KV_HEADS * HEAD_DIM
IN_SPLITS = (A_Q_W, A_KV_W, A_KV_W, B_W, B_W, B_W, C_Q_W, C_KV_W, C_KV_W, N_BRANCHES * D_MODEL)
IN_WIDTH = sum(IN_SPLITS)

kernel_name = "hybrid_gated_mixers_peer_deepnorm_encoder"


def layer_norm(x, g, b):
    xf = x.astype(jnp.float32)
    mu = jnp.mean(xf, axis=-1, keepdims=True)
    var = jnp.mean(jnp.square(xf - mu), axis=-1, keepdims=True)
    return ((xf - mu) * lax.rsqrt(var + LN_EPS) * g + b).astype(x.dtype)


def rms_norm(x, g):
    xf = x.astype(jnp.float32)
    return (xf * lax.rsqrt(jnp.mean(jnp.square(xf), axis=-1, keepdims=True) + QK_EPS) * g).astype(x.dtype)


def alibi_slopes(n):
    return jnp.asarray(2.0 ** (-8.0 * np.arange(1, n + 1) / n), dtype=jnp.float32)


def axial_rope_tables(seq):
    rows = seq // GRID_W
    row = jnp.repeat(jnp.arange(rows, dtype=jnp.float32), GRID_W)
    col = jnp.tile(jnp.arange(GRID_W, dtype=jnp.float32), rows)
    quarter = HEAD_DIM // 4
    inv = ROPE_THETA ** (-jnp.arange(quarter, dtype=jnp.float32) / quarter)
    ang_r = row[:, None] * inv
    ang_c = col[:, None] * inv
    return jnp.cos(ang_r), jnp.sin(ang_r), jnp.cos(ang_c), jnp.sin(ang_c)


def axial_rope(x, cos_r, sin_r, cos_c, sin_c):
    xf = x.astype(jnp.float32)
    bshape = (1, x.shape[1]) + (1,) * (x.ndim - 3) + (-1,)

    def rot(xh, cos, sin):
        cos = cos.reshape(bshape)
        sin = sin.reshape(bshape)
        x1, x2 = jnp.split(xh, 2, axis=-1)
        return jnp.concatenate([x1 * cos - x2 * sin, x2 * cos + x1 * sin], axis=-1)

    xr, xc = jnp.split(xf, 2, axis=-1)
    return jnp.concatenate([rot(xr, cos_r, sin_r), rot(xc, cos_c, sin_c)], axis=-1).astype(x.dtype)


def banded_attention(q, k, v, half_win, q_block, slopes, dist_scale, sink=None):
    n, seq_len, hkv, grp, hd = q.shape
    nb = -(-seq_len // q_block)
    lp = nb * q_block
    q = jnp.pad(q, ((0, 0), (0, lp - seq_len), (0, 0), (0, 0), (0, 0)))
    pad_k = ((0, 0), (half_win, half_win + lp - seq_len), (0, 0), (0, 0))
    kp = jnp.pad(k, pad_k)
    vp = jnp.pad(v, pad_k)
    span = q_block + 2 * half_win
    starts = jnp.arange(nb) * q_block
    idx = starts[:, None] + jnp.arange(span)[None]
    kpos = idx - half_win
    qpos = starts[:, None] + jnp.arange(q_block)[None]
    dist = jnp.abs(qpos[:, :, None] - kpos[:, None, :])
    valid = (dist <= half_win) & (kpos[:, None, :] >= 0) & (kpos[:, None, :] < seq_len)
    kb = kp[:, idx]
    vb = vp[:, idx]
    qb = q.reshape(n, nb, q_block, hkv, grp, hd)
    s = jnp.einsum('nbqhgd,nbkhd->nbhgqk', qb, kb).astype(jnp.float32) * (hd ** -0.5)
    bias = slopes.astype(jnp.float32)[None, :, :, None, None] * (dist * dist_scale).astype(jnp.float32)[:, None, None]
    s = jnp.where(valid[:, None, None], s - bias, NEG_INF)
    m = jnp.max(s, axis=-1)
    if sink is not None:
        sk = sink.astype(jnp.float32)[None, None, :, :, None]
        m = jnp.maximum(m, sk)
    p = jnp.exp(s - m[..., None])
    denom = jnp.sum(p, axis=-1)
    if sink is not None:
        denom = denom + jnp.exp(sk - m)
    o = jnp.einsum('nbhgqk,nbkhd->nbqhgd', p.astype(v.dtype), vb).astype(jnp.float32)
    o = (o / jnp.moveaxis(denom, -1, 2)[..., None]).astype(v.dtype)
    lse = jnp.moveaxis(m + jnp.log(denom), -1, 2)
    o = o.reshape(n, lp, hkv, grp, hd)[:, :seq_len]
    lse = lse.reshape(n, lp, hkv, grp)[:, :seq_len]
    return o, lse


def mixer_a(q, k, v, q_gain, k_gain):
    b, s, _ = q.shape
    grp = A_Q_HEADS // A_KV_HEADS
    q = rms_norm(q.reshape(b, s, A_KV_HEADS, grp, HEAD_DIM), q_gain)
    k = rms_norm(k.reshape(b, s, A_KV_HEADS, HEAD_DIM), k_gain)
    v = v.reshape(b, s, A_KV_HEADS, HEAD_DIM)
    tables = axial_rope_tables(s)
    q = axial_rope(q, *tables)
    k = axial_rope(k, *tables)
    nb = s // Q_BLOCK
    qb = jnp.moveaxis(q.reshape(b, nb, Q_BLOCK, A_KV_HEADS, grp, HEAD_DIM), 1, 0)

    def one_block(qblk):
        sc = jnp.einsum('bqhgd,bkhd->bhgqk', qblk, k).astype(jnp.float32) * (HEAD_DIM ** -0.5)
        p = jax.nn.softmax(sc, axis=-1).astype(v.dtype)
        return jnp.einsum('bhgqk,bkhd->bqhgd', p, v)

    o = lax.map(one_block, qb)
    return jnp.moveaxis(o, 0, 1).reshape(b, s, A_Q_W)


def mixer_b(q, k, v):
    b, s, _ = q.shape
    hg = B_HEADS_PER_GROUP
    q = q.reshape(b, s, B_HEADS, HEAD_DIM)
    k = k.reshape(b, s, B_HEADS, HEAD_DIM)
    v = v.reshape(b, s, B_HEADS, HEAD_DIM)
    slopes = alibi_slopes(B_HEADS)
    outs, lses = [], []
    for g, (win, r) in enumerate(B_GROUPS):
        lo, hi = g * hg, (g + 1) * hg
        sub = s // r

        def strided(t):
            return t[:, :, lo:hi].reshape(b, sub, r, hg, HEAD_DIM).transpose(0, 2, 1, 3, 4).reshape(b * r, sub, hg, HEAD_DIM)

        o, lse = banded_attention(strided(q)[:, :, :, None], strided(k), strided(v),
                                  (win // 2) // r, B_Q_BLOCK, slopes[lo:hi][:, None], r)
        outs.append(o.reshape(b, r, sub, hg, HEAD_DIM).transpose(0, 2, 1, 3, 4).reshape(b, s, hg, HEAD_DIM))
        lses.append(lse.reshape(b, r, sub, hg).transpose(0, 2, 1, 3).reshape(b, s, hg))
    o = jnp.stack(outs, axis=2)
    w = jax.nn.softmax(jnp.stack(lses, axis=2), axis=2)
    return (o * w[..., None].astype(o.dtype)).reshape(b, s, B_W)


def mixer_c(q, k, v, sink):
    b, s, _ = q.shape
    grp = C_Q_HEADS // C_KV_HEADS
    q = q.reshape(b, s, C_KV_HEADS, grp, HEAD_DIM)
    k = k.reshape(b, s, C_KV_HEADS, HEAD_DIM)
    v = v.reshape(b, s, C_KV_HEADS, HEAD_DIM)
    slopes = alibi_slopes(C_Q_HEADS).reshape(C_KV_HEADS, grp)
    o, _ = banded_attention(q, k, v, C_HALF_WINDOW, Q_BLOCK, slopes, 1, sink)
    return o.reshape(b, s, C_Q_W)


def peer(h, w_q, sub_keys, u, v):
    b, s, d = h.shape
    t = b * s
    xt = h.reshape(t, d)
    q = (xt @ w_q).reshape(t, PEER_HEADS, 2, PEER_QUERY_DIM // 2)
    sc = jnp.einsum('thpd,pkd->thpk', q, sub_keys).astype(jnp.float32)
    vals, idx = lax.top_k(sc, PEER_TOPK)
    cand = vals[:, :, 0, :, None] + vals[:, :, 1, None, :]
    cand_idx = idx[:, :, 0, :, None] * PEER_N_KEYS + idx[:, :, 1, None, :]
    top_v, pos = lax.top_k(cand.reshape(t, PEER_HEADS, PEER_TOPK * PEER_TOPK), PEER_TOPK)
    expert = jnp.take_along_axis(cand_idx.reshape(t, PEER_HEADS, -1), pos, axis=-1)
    gate = jax.nn.softmax(top_v, axis=-1).astype(h.dtype)
    expert = expert.reshape(t, PEER_HEADS * PEER_TOPK)
    gate = gate.reshape(t, PEER_HEADS * PEER_TOPK)
    nc = t // PEER_TOKEN_CHUNK

    def chunk(args):
        xc, ec, gc = args
        act = jax.nn.gelu(jnp.einsum('cd,ckd->ck', xc, u[ec]), approximate=False)
        return jnp.einsum('ck,ckd->cd', gc * act, v[ec])

    out = lax.map(chunk, (xt.reshape(nc, PEER_TOKEN_CHUNK, d),
                          expert.reshape(nc, PEER_TOKEN_CHUNK, -1),
                          gate.reshape(nc, PEER_TOKEN_CHUNK, -1)))
    return out.reshape(b, s, d)


def setup_inputs(seed: int = 0) -> dict:
    key = jax.random.key(seed)
    ks = jax.random.split(key, 24)
    L, D = DEPTH, D_MODEL

    def nrm(k, shape, scale):
        return jax.random.normal(k, shape, jnp.float32) * scale

    return {
        "x": nrm(ks[0], (BATCH, SEQ, D), 1.0),
        "c": nrm(ks[1], (BATCH, D), 1.0),
        "w_mod": nrm(ks[2], (L, D, 6 * D), 0.1 * D ** -0.5),
        "b_mod": nrm(ks[3], (L, 6 * D), 0.02),
        "w_in": nrm(ks[4], (L, D, IN_WIDTH), D ** -0.5),
        "a_q_gain": 1.0 + nrm(ks[5], (L, HEAD_DIM), 0.02),
        "a_k_gain": 1.0 + nrm(ks[6], (L, HEAD_DIM), 0.02),
        "c_sink": nrm(ks[7], (L, C_KV_HEADS, C_Q_HEADS // C_KV_HEADS), 0.5),
        "w_pa": nrm(ks[8], (L, A_Q_W, D), DEEPNORM_BETA * A_Q_W ** -0.5),
        "w_pb": nrm(ks[9], (L, B_W, D), DEEPNORM_BETA * B_W ** -0.5),
        "w_pc": nrm(ks[10], (L, C_Q_W, D), DEEPNORM_BETA * C_Q_W ** -0.5),
        "w_o": nrm(ks[11], (L, D, D), DEEPNORM_BETA * D ** -0.5),
        "ln1_g": 1.0 + nrm(ks[12], (L, D), 0.02),
        "ln1_b": nrm(ks[13], (L, D), 0.02),
        "peer_wq": nrm(ks[14], (L, D, PEER_HEADS * PEER_QUERY_DIM), D ** -0.5),
        "peer_keys": nrm(ks[15], (L, 2, PEER_N_KEYS, PEER_QUERY_DIM // 2), (PEER_QUERY_DIM // 2) ** -0.5),
        "peer_u": nrm(ks[16], (L, PEER_N_EXPERTS, D), D ** -0.5),
        "peer_v": nrm(ks[17], (L, PEER_N_EXPERTS, D), DEEPNORM_BETA * PEER_HEADS ** -0.5),
        "ln2_g": 1.0 + nrm(ks[18], (L, D), 0.02),
        "ln2_b": nrm(ks[19], (L, D), 0.02),
    }


def reference(x, c, w_mod, b_mod, w_in, a_q_gain, a_k_gain, c_sink, w_pa, w_pb, w_pc, w_o,
              ln1_g, ln1_b, peer_wq, peer_keys, peer_u, peer_v, ln2_g, ln2_b):
    b, s, d = x.shape
    split_at = np.cumsum(IN_SPLITS)[:-1].tolist()
    for l in range(DEPTH):
        mod = (c @ w_mod[l] + b_mod[l])[:, None, :]
        sh_a, sc_a, g_a, sh_f, sc_f, g_f = jnp.split(mod, 6, axis=-1)
        h = x * (1.0 + sc_a) + sh_a
        qa, ka, va, qb, kb, vb, qc, kc, vc, gl = jnp.split(h @ w_in[l], split_at, axis=-1)
        ya = mixer_a(qa, ka, va, a_q_gain[l], a_k_gain[l]) @ w_pa[l]
        yb = mixer_b(qb, kb, vb) @ w_pb[l]
        yc = mixer_c(qc, kc, vc, c_sink[l]) @ w_pc[l]
        gates = jax.nn.sigmoid(gl.reshape(b, s, N_BRANCHES, d))
        merged = gates[:, :, 0] * ya + gates[:, :, 1] * yb + gates[:, :, 2] * yc
        y = merged @ w_o[l]
        x = layer_norm(DEEPNORM_ALPHA * x + (1.0 + g_a) * y, ln1_g[l], ln1_b[l])
        h = x * (1.0 + sc_f) + sh_f
        y = peer(h, peer_wq[l], peer_keys[l], peer_u[l], peer_v[l])
        x = layer_norm(DEEPNORM_ALPHA * x + (1.0 + g_f) * y, ln2_g[l], ln2_b[l])
    return x
```

```cpp
#include <hip/hip_runtime.h>
#include <hip/hip_bf16.h>
#include <cstdio>
#include <cstdint>

#ifndef MK_ONE_LAUNCH
#define MK_ONE_LAUNCH 1
#endif

#define LAS __attribute__((address_space(3)))
typedef unsigned short bf16_t;
typedef short bf16x8 __attribute__((ext_vector_type(8)));
typedef short s16x4 __attribute__((ext_vector_type(4)));
typedef float f32x2 __attribute__((ext_vector_type(2)));
typedef float f32x4 __attribute__((ext_vector_type(4)));
typedef float f32x16 __attribute__((ext_vector_type(16)));
typedef unsigned u32x2 __attribute__((ext_vector_type(2)));
typedef unsigned u32x4 __attribute__((ext_vector_type(4)));
typedef __bf16 bf16x2v __attribute__((ext_vector_type(2)));
typedef int i32x4 __attribute__((ext_vector_type(4)));
typedef int i32x8 __attribute__((ext_vector_type(8)));

constexpr int DM = 2048, NBATCH = 2, SEQ = 4096, NTOK = NBATCH * SEQ, DEPTH = 2, HD = 128;
constexpr int INW = 11520, QKVW = 5376, GLW = 6144, QKRAWW = 1280, AOW = 2816, MODW = 6 * DM;
constexpr int COL_QA = 0, COL_KA = 1024, COL_VA = 1280, COL_QB = 1536, COL_KB = 2304, COL_VB = 3072, COL_QC = 3840, COL_KC = 4864, COL_VC = 5120;
constexpr int AO_A = 0, AO_B = 1024, AO_C = 1792;
constexpr int NEXP = 16384, PEER_HK = 128;
constexpr float LN_EPS = 1e-5f, QK_EPS = 1e-6f, ALPHA = 1.4142135623730951f, LOG2E = 1.4426950408889634f, LN2 = 0.6931471805599453f;
constexpr int NTHREADS = 512, NWAVES = 8;

constexpr size_t al256(size_t x) { return (x + 255) / 256 * 256; }
constexpr size_t WS_CTL = 0;
constexpr size_t CTL_BYTES = 65536;
constexpr size_t WS_MOD = WS_CTL + CTL_BYTES;
constexpr size_t WS_ROPE = WS_MOD + al256((size_t)DEPTH * NBATCH * MODW * 4);
constexpr size_t WS_LSEB = WS_ROPE + 64 * 32 * 2 * 4;
constexpr size_t WS_W0 = WS_LSEB + (size_t)NTOK * 8 * 4;
constexpr size_t WL_WIN = 0;
constexpr size_t WL_SWIN = WL_WIN + (size_t)INW * DM / 2;
constexpr size_t WL_WP = WL_SWIN + al256((size_t)INW * 4);
constexpr size_t WL_WO = WL_WP + (size_t)DM * AOW * 2;
constexpr size_t WL_WQK = WL_WO + (size_t)DM * DM * 2;
constexpr size_t WL_SWQK = WL_WQK + (size_t)DM * DM;
constexpr size_t WL_UB = WL_SWQK + (size_t)DM * 4;
constexpr size_t WL_VB = WL_UB + (size_t)NEXP * DM / 2;
constexpr size_t WL_SU = WL_VB + (size_t)NEXP * DM / 2;
constexpr size_t WL_SV = WL_SU + (size_t)NEXP * 4;
constexpr size_t WL_BYTES = WL_SV + (size_t)NEXP * 4;
constexpr size_t WS_H = WS_W0 + DEPTH * WL_BYTES;
constexpr size_t WS_SH = WS_H + (size_t)NTOK * DM / 2;
constexpr size_t WS_H2 = WS_SH + (size_t)NTOK * 4;
constexpr size_t WS_SH2 = WS_H2 + (size_t)NTOK * DM;
constexpr size_t WS_QKVB = WS_SH2 + (size_t)NTOK * 4;
constexpr size_t WS_QKRAW = WS_QKVB + (size_t)NTOK * QKVW * 2;
constexpr size_t WS_GATES = WS_QKRAW + (size_t)NTOK * QKRAWW * 4;
constexpr size_t WS_SC = WS_GATES;
constexpr size_t WS_AO = WS_GATES + (size_t)NTOK * GLW * 2;
constexpr size_t WS_MTMP = WS_AO + (size_t)NTOK * AOW * 2;
constexpr size_t WS_Z = WS_MTMP;
constexpr size_t WS_MERGED = WS_MTMP + (size_t)NTOK * DM * 4;
constexpr size_t WS_X1 = WS_MERGED + (size_t)NTOK * DM * 2;
constexpr size_t WS_XCUR = WS_X1 + (size_t)NTOK * DM * 4;
constexpr size_t WS_EIDX = WS_XCUR + (size_t)NTOK * DM * 4;
constexpr size_t WS_EGATE = WS_EIDX + (size_t)NTOK * 128 * 4;
constexpr size_t WS_END = WS_EGATE + (size_t)NTOK * 128 * 4;
static_assert(WS_SC + (size_t)NTOK * DM * 4 <= WS_AO, "SC alias must fit in GATES");

__device__ __forceinline__ unsigned cvtpk(float lo, float hi) { return __builtin_bit_cast(unsigned, __builtin_convertvector((f32x2){lo, hi}, bf16x2v)); }
__device__ __forceinline__ float bf_lo(unsigned w) { return __uint_as_float(w << 16); }
__device__ __forceinline__ float bf_hi(unsigned w) { return __uint_as_float(w & 0xffff0000u); }
__device__ __forceinline__ float dot2(unsigned a, unsigned b, float acc) { return __builtin_amdgcn_fdot2_f32_bf16(__builtin_bit_cast(bf16x2v, a), __builtin_bit_cast(bf16x2v, b), acc, false); }
template <int CTRL> __device__ __forceinline__ float dppf(float x) { return __builtin_bit_cast(float, __builtin_amdgcn_mov_dpp(__builtin_bit_cast(int, x), CTRL, 0xf, 0xf, true)); }
template <int CTRL> __device__ __forceinline__ unsigned dppu(unsigned x) { return (unsigned)__builtin_amdgcn_mov_dpp((int)x, CTRL, 0xf, 0xf, true); }
constexpr int XOR1 = 0xB1, XOR2 = 0x4E, HMIR = 0x141, MIR = 0x140;
__device__ __forceinline__ float row16_sum(float x) { x += dppf<XOR1>(x); x += dppf<XOR2>(x); x += dppf<HMIR>(x); x += dppf<MIR>(x); return x; }
__device__ __forceinline__ float xrow_sum(float x) {
    auto s = __builtin_amdgcn_permlane16_swap(__float_as_uint(x), __float_as_uint(x), false, false);
    x = __uint_as_float(s[0]) + __uint_as_float(s[1]);
    auto t = __builtin_amdgcn_permlane32_swap(__float_as_uint(x), __float_as_uint(x), false, false);
    return __uint_as_float(t[0]) + __uint_as_float(t[1]);
}
__device__ __forceinline__ float wave_sum(float x) { return xrow_sum(row16_sum(x)); }
__device__ __forceinline__ int lperm(int v, int src) { return __builtin_amdgcn_ds_bpermute(src << 2, v); }
__device__ __forceinline__ unsigned lperm(unsigned v, int src) { return (unsigned)__builtin_amdgcn_ds_bpermute(src << 2, (int)v); }
__device__ __forceinline__ float lperm(float v, int src) { return __int_as_float(__builtin_amdgcn_ds_bpermute(src << 2, __float_as_int(v))); }
__device__ __forceinline__ float wave_max(float x) {
    x = fmaxf(x, dppf<XOR1>(x)); x = fmaxf(x, dppf<XOR2>(x)); x = fmaxf(x, dppf<HMIR>(x)); x = fmaxf(x, dppf<MIR>(x));
    auto s = __builtin_amdgcn_permlane16_swap(__float_as_uint(x), __float_as_uint(x), false, false); x = fmaxf(__uint_as_float(s[0]), __uint_as_float(s[1]));
    auto t = __builtin_amdgcn_permlane32_swap(__float_as_uint(x), __float_as_uint(x), false, false); return fmaxf(__uint_as_float(t[0]), __uint_as_float(t[1]));
}
__device__ __forceinline__ int row16_isum(int x) { x += (int)dppu<XOR1>((unsigned)x); x += (int)dppu<XOR2>((unsigned)x); x += (int)dppu<HMIR>((unsigned)x); x += (int)dppu<MIR>((unsigned)x); return x; }
__device__ __forceinline__ int xrow_isum(int x) {
    auto s = __builtin_amdgcn_permlane16_swap((unsigned)x, (unsigned)x, false, false); x = (int)s[0] + (int)s[1];
    auto t = __builtin_amdgcn_permlane32_swap((unsigned)x, (unsigned)x, false, false); return (int)t[0] + (int)t[1];
}
__device__ __forceinline__ unsigned pack4_raw(float a, float b, float c, float d) {
    unsigned w = __builtin_amdgcn_cvt_pk_u8_f32(a, 0, 0u); w = __builtin_amdgcn_cvt_pk_u8_f32(b, 1, w); w = __builtin_amdgcn_cvt_pk_u8_f32(c, 2, w); return __builtin_amdgcn_cvt_pk_u8_f32(d, 3, w);
}
__device__ __forceinline__ unsigned pack4_u8(float a, float b, float c, float d) {
    unsigned w = __builtin_amdgcn_cvt_pk_u8_f32(__builtin_rintf(a + 128.f), 0, 0u); w = __builtin_amdgcn_cvt_pk_u8_f32(__builtin_rintf(b + 128.f), 1, w);
    w = __builtin_amdgcn_cvt_pk_u8_f32(__builtin_rintf(c + 128.f), 2, w); return __builtin_amdgcn_cvt_pk_u8_f32(__builtin_rintf(d + 128.f), 3, w);
}
__device__ __forceinline__ float gelu_erf(float v) {
    const float av = fabsf(v), t = __builtin_amdgcn_rcpf(fmaf(av, 0.2316418882f, 1.0f));
    float q = fmaf(t, 0.5307027145f, -0.7265760135f); q = fmaf(q, t, 0.7107068705f); q = fmaf(q, t, -0.142248368f); q = fmaf(q, t, 0.127414796f); q = q * t;
    const float e = __builtin_amdgcn_exp2f(v * v * -0.72134752044f);
    const float m = v * (q * e);
    return v < 0.f ? m : v - m;
}
__device__ __forceinline__ void ld8f(const float* p, float (&v)[8]) { const f32x4 a = *(const f32x4*)p, b = *(const f32x4*)(p + 4); v[0] = a[0]; v[1] = a[1]; v[2] = a[2]; v[3] = a[3]; v[4] = b[0]; v[5] = b[1]; v[6] = b[2]; v[7] = b[3]; }
__device__ __forceinline__ void st8f(float* p, const float (&v)[8]) { *(f32x4*)p = (f32x4){v[0], v[1], v[2], v[3]}; *(f32x4*)(p + 4) = (f32x4){v[4], v[5], v[6], v[7]}; }
__device__ __forceinline__ u32x4 pack8(const float (&v)[8]) { return (u32x4){cvtpk(v[0], v[1]), cvtpk(v[2], v[3]), cvtpk(v[4], v[5]), cvtpk(v[6], v[7])}; }

#define XB_TMO      128
#define XB_XCNT(j)  (256  + 64 * (j))
#define XB_XSUB(j)  (1280 + 64 * (j))
#define XB_XGEN(j)  (2304 + 64 * (j))
#define XB_TOP      3328
#define XB_TOPGEN   3392
#define XCD_BAR_WORDS 3456
#define XB_MODCNT   3520
#define XB_SPIN_CAP (1u << 22)
__device__ __forceinline__ unsigned xb_ld(unsigned* p)              { return __hip_atomic_load(p, __ATOMIC_RELAXED, __HIP_MEMORY_SCOPE_AGENT); }
__device__ __forceinline__ unsigned xb_add(unsigned* p, unsigned v) { return __hip_atomic_fetch_add(p, v, __ATOMIC_RELAXED, __HIP_MEMORY_SCOPE_AGENT); }
__device__ __forceinline__ unsigned xb_xcc_id() { return (unsigned)__builtin_amdgcn_s_getreg((3 << 11) | 20) & 0xFu; }
#define XB_SPIN(cond, bar) do { unsigned _sp = 0; while (cond) { __builtin_amdgcn_s_sleep(1); \
    if ((++_sp & 255u) == 0u) { if (xb_ld(&(bar)[XB_TMO])) break; if (_sp > XB_SPIN_CAP) { atomicAdd(&(bar)[XB_TMO], 1u); break; } } } } while (0)
struct XcdBarrier { unsigned* bar; unsigned x; volatile LAS unsigned* st; };
__device__ __forceinline__ XcdBarrier xcd_barrier_post(unsigned* bar, volatile LAS unsigned* st) {
    XcdBarrier b; b.bar = bar; b.x = xb_xcc_id(); b.st = st;
    if (threadIdx.x == 0) (void)xb_add(&bar[XB_XCNT(b.x)], 1u);
    return b;
}
__device__ __forceinline__ void xcd_barrier_complete(unsigned* bar, unsigned x, unsigned& nloc, unsigned& nx) {
    const unsigned G = gridDim.x * gridDim.y * gridDim.z;
    unsigned sum, cnt, mine, sp = 0u;
    for (;;) {
        sum = 0u; cnt = 0u; mine = 0u;
#pragma unroll
        for (unsigned j = 0; j < 16; ++j) { const unsigned c = xb_ld(&bar[XB_XCNT(j)]); sum += c; cnt += (c > 0u) ? 1u : 0u; mine = (j == x) ? c : mine; }
        if (sum == G) break;
        __builtin_amdgcn_s_sleep(1);
        if ((++sp & 255u) == 0u) { if (xb_ld(&bar[XB_TMO])) break; if (sp > XB_SPIN_CAP) { atomicAdd(&bar[XB_TMO], 1u); break; } }
    }
    nloc = mine > 0u ? mine : 1u; nx = cnt > 0u ? cnt : 1u;
}
__device__ __forceinline__ void xcd_barrier(const XcdBarrier& b) {
    asm volatile("s_waitcnt vmcnt(0)" ::: "memory");
    __syncthreads();
    if (threadIdx.x == 0) {
        unsigned* bar = b.bar;
        __builtin_amdgcn_s_waitcnt(0);
        unsigned nloc = b.st[0], nx = b.st[1];
        if (nloc == 0u) { xcd_barrier_complete(bar, b.x, nloc, nx); b.st[0] = nloc; b.st[1] = nx; }
        const unsigned old = xb_add(&bar[XB_XSUB(b.x)], 1u);
        const unsigned gen = old / nloc;
        if (old + 1u == (gen + 1u) * nloc) {
            __builtin_amdgcn_fence(__ATOMIC_RELEASE, "agent");
            asm volatile("s_waitcnt vmcnt(0)" ::: "memory");
            const unsigned og = xb_add(&bar[XB_TOP], 1u);
            const unsigned tg = og / nx;
            if (og + 1u == (tg + 1u) * nx) xb_add(&bar[XB_TOPGEN], 1u);
            else XB_SPIN(xb_ld(&bar[XB_TOPGEN]) == tg, bar);
            __builtin_amdgcn_fence(__ATOMIC_ACQUIRE, "agent");
            xb_add(&bar[XB_XGEN(b.x)], 1u);
            asm volatile("s_waitcnt vmcnt(0)" ::: "memory");
        } else {
            XB_SPIN(xb_ld(&bar[XB_XGEN(b.x)]) == gen, bar);
            __builtin_amdgcn_fence(__ATOMIC_ACQUIRE, "agent");
            asm volatile("s_waitcnt vmcnt(0)" ::: "memory");
        }
    }
    __syncthreads();
}

struct Frame;
__device__ __forceinline__ void topk_rows(const Frame& F, const float* rows, int pitch, int tok0, int h, int nit);
namespace pg8 {
constexpr int BM = 256, BK = 64, HALF = 128, HTB = HALF * BK * 2, STAGE_BYTES = 8 * HTB, NXCD = 8, WGM = 8;
__host__ __device__ __forceinline__ int lds_byte(int r, int c) { const int st = (r >> 4) * 2 + (c >> 5), rr = r & 15, cc = c & 31, ob = rr * 64 + cc * 2; return st * 1024 + (ob ^ (((ob >> 9) & 1) << 5)); }
__host__ __device__ __forceinline__ void stage_rc(int b, int& R, int& C) { const int st = b / 1024, sb = b % 1024, swz = sb ^ (((sb >> 9) & 1) << 5); R = (st >> 1) * 16 + swz / 64; C = (st & 1) * 32 + (swz % 64) / 2; }
__host__ __device__ __forceinline__ int perm32(int rho) { const int n = rho >> 4, i = rho & 15; return 8 * (i >> 2) + 4 * n + (i & 3); }
struct Unit { int pm, pn, koff, nt, aux; };
struct Gemm { const bf16_t* A; const bf16_t* Bt; int lda, ldb; };
struct TileOrder {
    int nM, nN, nwg;
    __device__ void init(int M, int N) { nM = M / BM; nN = N / BM; nwg = nM * nN; }
    __device__ bool tile(long L, int& pm, int& pn) const {
        if (L >= nwg) return false;
        int wgid = (int)L; { const int q = nwg / NXCD, r = nwg % NXCD, xcd = wgid % NXCD, off = wgid / NXCD; wgid = (xcd < r ? xcd * (q + 1) : r * (q + 1) + (xcd - r) * q) + off; }
        const int nig = WGM * nN, gid = wgid / nig, fm = gid * WGM, gsz = (nM - fm) < WGM ? (nM - fm) : WGM;
        pm = fm + ((wgid % nig) % gsz); pn = (wgid % nig) / gsz; return true;
    }
};
struct SchedSimple {
    TileOrder T; int G, c, nt;
    __device__ void init(int M, int N, int K, int G_, int c_) { T.init(M, N); G = G_; c = c_; nt = K / BK; }
    __device__ bool next(int i, Unit& u) const { if (!T.tile((long)i * G + c, u.pm, u.pn)) return false; u.koff = 0; u.nt = nt; u.aux = 0; return true; }
};
struct SchedG1 {
    SchedSimple S0; int x, j; bool bal;
    __device__ void init(int M, int N, int K, int G_, int c_) { S0.init(M, N, K, G_, c_); bal = (G_ == 256 && M == 32 * BM && N == 45 * BM); x = c_ & 7; j = c_ >> 3; }
    __device__ bool next(int i, Unit& u) const {
        if (!bal) return S0.next(i, u);
        int o;
        if (j < 20) { if (i >= 6) return false; o = i * 20 + j; }
        else { const int jb = j - 20, no = jb < 4 ? 4 : 3;
            if (i >= 5) return false;
            o = i < no ? 120 + i * 12 + jb : 160 + (jb < 4 ? jb : 4 + (jb - 4) * 2 + (i - no)); }
        if (o < 160) { u.pn = 5 + (o >> 2); u.pm = 4 * x + (o & 3); } else { u.pn = (o - 160) >> 2; u.pm = 4 * x + ((o - 160) & 3); }
        u.koff = 0; u.nt = S0.nt; u.aux = 0; return true;
    }
};
template <class Epi, class Sched>
__device__ __forceinline__ void gemm_phase(LAS unsigned char* lds, const Gemm g, const Sched& S, const Epi& E) {
    int tid = threadIdx.x; asm volatile("" : "+v"(tid));
    const int wid = __builtin_amdgcn_readfirstlane(tid >> 6), lane = tid & 63, wr = wid >> 2, wc = wid & 3, fr = lane & 15, fq = lane >> 4;
    unsigned voffA[2], voffB[2];
#pragma unroll
    for (int i = 0; i < 2; ++i) { int R, C; stage_rc(tid * 16 + i * 8192, R, C); const int Rb = Epi::PERM ? ((R & ~31) + perm32(R & 31)) : R;
        voffA[i] = (unsigned)(R * g.lda + C) * 2u; voffB[i] = (unsigned)(Rb * g.ldb + C) * 2u; }
    const size_t kstep = (size_t)(BK * 2);
    const size_t hstepA = (size_t)HALF * g.lda * 2, hstepB = (size_t)HALF * g.ldb * 2;
    const unsigned ldsw = (unsigned)wid * 1024u;
    const int aoff = lds_byte(wr * 64 + fr, fq * 8), boff = lds_byte(wc * 32 + fr, fq * 8);
#define PG8_SA(b, h) (((b) * 2 + (h)) * HTB)
#define PG8_SB(b, h) ((4 + (b) * 2 + (h)) * HTB)
#define PG8_STAGE(bufoff, gbase, voff) do { _Pragma("unroll") for (int _i = 0; _i < 2; ++_i) \
        __builtin_amdgcn_global_load_lds((const unsigned*)((const char*)(gbase) + (voff)[_i]), (LAS unsigned*)(lds + (bufoff) + ldsw + _i * 8192), 16, 0, 0); } while (0)
#define PG8_LDA(dst, b, h) do { _Pragma("unroll") for (int m = 0; m < 4; ++m) _Pragma("unroll") for (int k = 0; k < 2; ++k) dst[m][k] = *(const LAS bf16x8*)(lds + PG8_SA(b, h) + aoff + m * 2048 + k * 1024); } while (0)
#define PG8_LDB(dst, b, h) do { _Pragma("unroll") for (int n = 0; n < 2; ++n) _Pragma("unroll") for (int k = 0; k < 2; ++k) dst[n][k] = *(const LAS bf16x8*)(lds + PG8_SB(b, h) + boff + n * 2048 + k * 1024); } while (0)
#define PG8_MMA(ai, bj, At, Bt) do { __builtin_amdgcn_s_setprio(1); _Pragma("unroll") for (int m = 0; m < 4; ++m) _Pragma("unroll") for (int n = 0; n < 2; ++n) _Pragma("unroll") for (int k = 0; k < 2; ++k) \
        acc[ai][bj][m][n] = Epi::mma(Bt[n][k], At[m][k], acc[ai][bj][m][n]); __builtin_amdgcn_s_setprio(0); } while (0)
#define PG8_WAIT_V(n) asm volatile("s_waitcnt vmcnt(" #n ")" ::: "memory")
#define PG8_WAIT_L(n) asm volatile("s_waitcnt lgkmcnt(" #n ")" ::: "memory")
#define PG8_BAR __builtin_amdgcn_s_barrier()
#define PG8_SCHED __builtin_amdgcn_sched_barrier(0)
    Unit cur, nxt; int ui = 0;
    if (!S.next(0, cur)) return;
    typedef typename Epi::acc_t acc_t;
    acc_t acc[2][2][4][2];
#pragma unroll
    for (int a = 0; a < 2; ++a)
#pragma unroll
        for (int b = 0; b < 2; ++b)
#pragma unroll
            for (int m = 0; m < 4; ++m)
#pragma unroll
                for (int n = 0; n < 2; ++n) acc[a][b][m][n] = (acc_t){0, 0, 0, 0};
    bf16x8 At[4][2], B0[2][2], B1[2][2];
    const char* cA = (const char*)g.A + ((size_t)cur.pm * BM * g.lda + cur.koff) * 2; const char* cB = (const char*)g.Bt + ((size_t)cur.pn * BM * g.ldb + cur.koff) * 2;
    PG8_STAGE(PG8_SB(0, 0), cB, voffB); PG8_STAGE(PG8_SA(0, 0), cA, voffA); PG8_STAGE(PG8_SB(0, 1), cB + hstepB, voffB); PG8_STAGE(PG8_SA(0, 1), cA + hstepA, voffA);
    if (wr == 1) PG8_BAR;
    PG8_WAIT_V(4); PG8_BAR;
    PG8_STAGE(PG8_SB(1, 0), cB + kstep, voffB); PG8_STAGE(PG8_SA(1, 0), cA + kstep, voffA); PG8_STAGE(PG8_SB(1, 1), cB + hstepB + kstep, voffB);
    PG8_WAIT_V(6); PG8_BAR;
    for (;;) {
        const bool has_next = S.next(ui + 1, nxt);
        const char* nA = has_next ? (const char*)g.A + ((size_t)nxt.pm * BM * g.lda + nxt.koff) * 2 : cA; const char* nB = has_next ? (const char*)g.Bt + ((size_t)nxt.pn * BM * g.ldb + nxt.koff) * 2 : cB;
        const int nt = cur.nt;
        for (int t = 0; t < nt; t += 2) {
            if constexpr (Epi::HAS_MID) { if (E.mid_at(t)) E.mid(acc, cur, t, wr, wc, fr, fq); }
            const bool last = (t == nt - 2);
            const char* a1 = cA + (size_t)(t + 1) * kstep;
            const char* a2 = last ? nA : cA + (size_t)(t + 2) * kstep; const char* b2 = last ? nB : cB + (size_t)(t + 2) * kstep;
            const char* a3 = a2 + kstep; const char* b3 = b2 + kstep;
            PG8_LDB(B0, 0, 0); PG8_SCHED; PG8_LDA(At, 0, 0); PG8_STAGE(PG8_SA(1, 1), a1 + hstepA, voffA);
            PG8_WAIT_L(8); PG8_BAR; PG8_WAIT_L(0); PG8_MMA(0, 0, At, B0); PG8_BAR; PG8_SCHED;
            PG8_LDB(B1, 0, 1); PG8_STAGE(PG8_SB(0, 0), b2, voffB);
            PG8_BAR; PG8_WAIT_L(0); PG8_MMA(0, 1, At, B1); PG8_BAR;
            PG8_LDA(At, 0, 1); PG8_STAGE(PG8_SA(0, 0), a2, voffA);
            PG8_BAR; PG8_WAIT_L(0); PG8_MMA(1, 0, At, B0); PG8_BAR; PG8_SCHED;
            PG8_STAGE(PG8_SB(0, 1), b2 + hstepB, voffB);
            PG8_WAIT_V(6); PG8_BAR; PG8_MMA(1, 1, At, B1); PG8_BAR;
            PG8_LDB(B0, 1, 0); PG8_SCHED; PG8_LDA(At, 1, 0); PG8_STAGE(PG8_SA(0, 1), a2 + hstepA, voffA);
            PG8_WAIT_L(8); PG8_BAR; PG8_WAIT_L(0); PG8_MMA(0, 0, At, B0); PG8_BAR; PG8_SCHED;
            PG8_LDB(B1, 1, 1); PG8_STAGE(PG8_SB(1, 0), b3, voffB);
            PG8_BAR; PG8_WAIT_L(0); PG8_MMA(0, 1, At, B1); PG8_BAR;
            PG8_LDA(At, 1, 1); PG8_STAGE(PG8_SA(1, 0), a3, voffA);
            PG8_BAR; PG8_WAIT_L(0); PG8_MMA(1, 0, At, B0); PG8_BAR; PG8_SCHED;
            PG8_STAGE(PG8_SB(1, 1), b3 + hstepB, voffB);
            PG8_WAIT_V(6); PG8_BAR; PG8_MMA(1, 1, At, B1); PG8_BAR;
        }
        if constexpr (Epi::AFTER_DRAIN) { if (has_next) E(acc, cur, wr, wc, fr, fq); } else E(acc, cur, wr, wc, fr, fq);
        if (!has_next) break;
#pragma unroll
        for (int a = 0; a < 2; ++a)
#pragma unroll
            for (int b = 0; b < 2; ++b)
#pragma unroll
                for (int m = 0; m < 4; ++m)
#pragma unroll
                    for (int n = 0; n < 2; ++n) acc[a][b][m][n] = (acc_t){0, 0, 0, 0};
        cur = nxt; cA = nA; cB = nB; ++ui;
    }
    PG8_WAIT_V(0);
    if (wr == 0) PG8_BAR;
    PG8_BAR;
    if constexpr (Epi::AFTER_DRAIN) E.fused(acc, cur, wr, wc, fr, fq);
#undef PG8_SA
#undef PG8_SB
#undef PG8_STAGE
#undef PG8_LDA
#undef PG8_LDB
#undef PG8_MMA
#undef PG8_WAIT_V
#undef PG8_WAIT_L
#undef PG8_BAR
#undef PG8_SCHED
}

struct EpiG1 {
    static constexpr bool PERM = true; static constexpr bool HAS_MID = false; static constexpr bool AFTER_DRAIN = false;
    typedef f32x4 acc_t;
    static __device__ __forceinline__ f32x4 mma(bf16x8 b, bf16x8 a, f32x4 c) {
        const i32x4 bb = __builtin_bit_cast(i32x4, b), aa = __builtin_bit_cast(i32x4, a);
        const i32x8 B8 = {bb[0], bb[1], bb[2], bb[3], 0, 0, 0, 0}, A8 = {aa[0], aa[1], aa[2], aa[3], 0, 0, 0, 0};
        return __builtin_amdgcn_mfma_scale_f32_16x16x128_f8f6f4(B8, A8, c, 4, 4, 0, 0x7F7F7F7F, 0, 0x7F7F7F7F);
    }
    float* qkraw; bf16_t* qkvb; unsigned char* gates; const float* sh; const float* sw;
    __device__ __forceinline__ void operator()(const f32x4 (&acc)[2][2][4][2], const Unit& u, int wr, int wc, int fr, int fq) const {
        const int row0 = u.pm * BM + wr * 64 + fr, colt = wc * 32 + 8 * fq, pn = u.pn;
        f32x4 cw[2][2];
#pragma unroll
        for (int bj = 0; bj < 2; ++bj) { cw[bj][0] = *(const f32x4*)(sw + pn * BM + bj * HALF + colt); cw[bj][1] = *(const f32x4*)(sw + pn * BM + bj * HALF + colt + 4); }
        f32x4 cwl[2][2];
#pragma unroll
        for (int bj = 0; bj < 2; ++bj) { cwl[bj][0] = cw[bj][0] * -LOG2E; cwl[bj][1] = cw[bj][1] * -LOG2E; }
#pragma unroll
        for (int ai = 0; ai < 2; ++ai)
#pragma unroll
            for (int m = 0; m < 4; ++m) {
                const size_t row = (size_t)(row0 + ai * HALF + m * 16);
                const float rs = sh[row];
                if (pn >= 21) {
                    unsigned w[4];
#pragma unroll
                    for (int bj = 0; bj < 2; ++bj) { const f32x4 v0 = acc[ai][bj][m][0] * cwl[bj][0] * rs, v1 = acc[ai][bj][m][1] * cwl[bj][1] * rs; float sg[8];
#pragma unroll
                        for (int j = 0; j < 4; ++j) { sg[j] = __builtin_rintf(__builtin_amdgcn_rcpf(fmaf(__builtin_amdgcn_exp2f(v0[j]), 1.0f / 255.0f, 1.0f / 255.0f))); sg[4 + j] = __builtin_rintf(__builtin_amdgcn_rcpf(fmaf(__builtin_amdgcn_exp2f(v1[j]), 1.0f / 255.0f, 1.0f / 255.0f))); }
                        w[2 * bj] = pack4_raw(sg[0], sg[1], sg[2], sg[3]); w[2 * bj + 1] = pack4_raw(sg[4], sg[5], sg[6], sg[7]); }
                    *(u32x4*)(gates + row * GLW + (pn - 21) * BM + (wc * 4 + fq) * 16) = (u32x4){w[0], w[1], w[2], w[3]};
                } else {
#pragma unroll
                for (int bj = 0; bj < 2; ++bj) {
                    const f32x4 v0 = acc[ai][bj][m][0] * cw[bj][0] * rs, v1 = acc[ai][bj][m][1] * cw[bj][1] * rs;
                    const int col = pn * BM + bj * HALF + colt;
                    if (pn < 5) { float* p = qkraw + row * QKRAWW + col; *(f32x4*)p = v0; *(f32x4*)(p + 4) = v1; }
                    else { u32x4 w; w.x = cvtpk(v0[0], v0[1]); w.y = cvtpk(v0[2], v0[3]); w.z = cvtpk(v1[0], v1[1]); w.w = cvtpk(v1[2], v1[3]); *(u32x4*)(qkvb + row * QKVW + col) = w; }
                }
                }
            }
    }
};
struct EpiG2 {
    static constexpr bool PERM = true; static constexpr bool HAS_MID = true; static constexpr bool AFTER_DRAIN = false;
    typedef f32x4 acc_t;
    static __device__ __forceinline__ f32x4 mma(bf16x8 b, bf16x8 a, f32x4 c) { return __builtin_amdgcn_mfma_f32_16x16x32_bf16(b, a, c, 0, 0, 0); }
    const unsigned char* gates; bf16_t* merged; const float* lse; float* wtab;
    static __device__ __forceinline__ float gb(unsigned w, int k) { return fmaxf((float)((w >> (8 * k)) & 0xffu), 0.25f); }
    __device__ __forceinline__ bool mid_at(int t) const { return t >= 16 && t <= 28; }
    __device__ __forceinline__ void mid(f32x4 (&acc)[2][2][4][2], const Unit& u, int t, int, int, int, int) const {
        int tz = threadIdx.x; asm volatile("" : "+v"(tz));
        const int wid = tz >> 6, lane = tz & 63, wr = wid >> 2, wc = wid & 3, fr = lane & 15, fq = lane >> 4;
        float* tab = wtab + wid * 768;
        if (t == 16) {
#pragma unroll
            for (int k = 0; k < 4; ++k) { const int p = lane + 64 * k, ti = p >> 1, hg = p & 1, row = (ti >> 6) * HALF + wr * 64 + ((ti >> 4) & 3) * 16 + (ti & 15), tok = u.pm * BM + row, bb = tok / SEQ, sq = tok % SEQ;
                const float a0 = lse[(size_t)hg * NTOK + (size_t)bb * SEQ + sq], a1 = lse[(size_t)(2 + hg) * NTOK + ((size_t)(bb * 4 + (sq & 3))) * (SEQ / 4) + (sq >> 2)], a2 = lse[(size_t)(4 + hg) * NTOK + ((size_t)(bb * 16 + (sq & 15))) * (SEQ / 16) + (sq >> 4)];
                const float mx = fmaxf(a0, fmaxf(a1, a2)); const float e0 = __builtin_amdgcn_exp2f((a0 - mx) * LOG2E), e1 = __builtin_amdgcn_exp2f((a1 - mx) * LOG2E), e2 = __builtin_amdgcn_exp2f((a2 - mx) * LOG2E);
                const float inv = 1.0f / (e0 + e1 + e2); tab[ti * 6 + hg] = fmaxf(e0 * inv, 1e-30f); tab[ti * 6 + 2 + hg] = fmaxf(e1 * inv, 1e-30f); tab[ti * 6 + 4 + hg] = fmaxf(e2 * inv, 1e-30f); }
            asm volatile("s_waitcnt lgkmcnt(0)" ::: "memory");
        }
        {   const int h = (t - 16) >> 1;
#pragma unroll
            for (int ai = 0; ai < 2; ++ai)
#pragma unroll
                for (int m = 0; m < 4; ++m) { const float* e = tab + ((ai * 4 + m) * 16 + fr) * 6;
                    const float rf = h == 0 ? __builtin_amdgcn_rcpf(e[0]) : (h == 6 ? e[5] : e[h - 1] * __builtin_amdgcn_rcpf(e[h]));
#pragma unroll
                    for (int bj = 0; bj < 2; ++bj) { acc[ai][bj][m][0] *= rf; acc[ai][bj][m][1] *= rf; } }
            if (t != 16 && t != 28) return;
        }
        const int row0 = u.pm * BM + wr * 64 + fr, gcol = u.pn * BM + (wc * 4 + fq) * 16, br = t == 16 ? 0 : 1;
#pragma unroll
        for (int ai = 0; ai < 2; ++ai)
#pragma unroll
            for (int m = 0; m < 4; ++m) {
                const size_t row = (size_t)(row0 + ai * HALF + m * 16);
                const u32x4 gaq = *(const u32x4*)(gates + row * GLW + br * DM + gcol), gnq = *(const u32x4*)(gates + row * GLW + (br + 1) * DM + gcol);
#pragma unroll
                for (int bj = 0; bj < 2; ++bj) {
                    const unsigned gax = bj ? gaq.z : gaq.x, gay = bj ? gaq.w : gaq.y, gnx = bj ? gnq.z : gnq.x, gny = bj ? gnq.w : gnq.y;
                    const float a0 = br == 0 ? (float)(gax & 0xffu) : gb(gax, 0), a1 = br == 0 ? (float)((gax >> 8) & 0xffu) : gb(gax, 1), a2 = br == 0 ? (float)((gax >> 16) & 0xffu) : gb(gax, 2), a3 = br == 0 ? (float)(gax >> 24) : gb(gax, 3);
                    const float a4 = br == 0 ? (float)(gay & 0xffu) : gb(gay, 0), a5 = br == 0 ? (float)((gay >> 8) & 0xffu) : gb(gay, 1), a6 = br == 0 ? (float)((gay >> 16) & 0xffu) : gb(gay, 2), a7 = br == 0 ? (float)(gay >> 24) : gb(gay, 3);
                    acc[ai][bj][m][0] *= (f32x4){a0 * __builtin_amdgcn_rcpf(gb(gnx, 0)), a1 * __builtin_amdgcn_rcpf(gb(gnx, 1)), a2 * __builtin_amdgcn_rcpf(gb(gnx, 2)), a3 * __builtin_amdgcn_rcpf(gb(gnx, 3))};
                    acc[ai][bj][m][1] *= (f32x4){a4 * __builtin_amdgcn_rcpf(gb(gny, 0)), a5 * __builtin_amdgcn_rcpf(gb(gny, 1)), a6 * __builtin_amdgcn_rcpf(gb(gny, 2)), a7 * __builtin_amdgcn_rcpf(gb(gny, 3))};
                }
            }
    }
    __device__ __forceinline__ void operator()(const f32x4 (&acc)[2][2][4][2], const Unit& u, int wr, int wc, int fr, int fq) const {
        const int row0 = u.pm * BM + wr * 64 + fr, colt = u.pn * BM + wc * 32 + 8 * fq, gcol = u.pn * BM + (wc * 4 + fq) * 16;
        constexpr float K = 1.0f / 255.0f;
#pragma unroll
        for (int ai = 0; ai < 2; ++ai)
#pragma unroll
            for (int m = 0; m < 4; ++m) {
                const size_t row = (size_t)(row0 + ai * HALF + m * 16);
                const u32x4 gq = *(const u32x4*)(gates + row * GLW + 2 * DM + gcol);
#pragma unroll
                for (int bj = 0; bj < 2; ++bj) {
                    const int col = colt + bj * HALF;
                    const unsigned gx = bj ? gq.z : gq.x, gy = bj ? gq.w : gq.y;
                    const f32x4 v0 = acc[ai][bj][m][0], v1 = acc[ai][bj][m][1];
                    const float r[8] = {gb(gx, 0) * K * v0[0], gb(gx, 1) * K * v0[1], gb(gx, 2) * K * v0[2], gb(gx, 3) * K * v0[3], gb(gy, 0) * K * v1[0], gb(gy, 1) * K * v1[1], gb(gy, 2) * K * v1[2], gb(gy, 3) * K * v1[3]};
                    *(u32x4*)(merged + row * DM + col) = pack8(r);
                }
            }
    }
};
struct EpiG3 {
    static constexpr bool PERM = true; static constexpr bool HAS_MID = false; static constexpr bool AFTER_DRAIN = false;
    typedef f32x4 acc_t;
    static __device__ __forceinline__ f32x4 mma(bf16x8 b, bf16x8 a, f32x4 c) { return __builtin_amdgcn_mfma_f32_16x16x32_bf16(b, a, c, 0, 0, 0); }
    const float* ga  ; bf16_t* y;
    __device__ __forceinline__ void operator()(const f32x4 (&acc)[2][2][4][2], const Unit& u, int wr, int wc, int fr, int fq) const {
        const int row0 = u.pm * BM + wr * 64 + fr, colt = u.pn * BM + wc * 32 + 8 * fq;
        const float* gab = ga + (size_t)((u.pm * BM) / SEQ) * MODW;
        f32x4 gv[2][2];
#pragma unroll
        for (int bj = 0; bj < 2; ++bj) { gv[bj][0] = *(const f32x4*)(gab + colt + bj * HALF) + 1.0f; gv[bj][1] = *(const f32x4*)(gab + colt + bj * HALF + 4) + 1.0f; }
#pragma unroll
        for (int ai = 0; ai < 2; ++ai)
#pragma unroll
            for (int m = 0; m < 4; ++m) { const size_t ro = (size_t)(row0 + ai * HALF + m * 16) * DM + colt;
#pragma unroll
                for (int bj = 0; bj < 2; ++bj) { const f32x4 v0 = gv[bj][0] * acc[ai][bj][m][0], v1 = gv[bj][1] * acc[ai][bj][m][1];
                    u32x4 w; w.x = cvtpk(v0[0], v0[1]); w.y = cvtpk(v0[2], v0[3]); w.z = cvtpk(v1[0], v1[1]); w.w = cvtpk(v1[2], v1[3]);
                    *(u32x4*)(y + ro + bj * HALF) = w; } }
    }
};
struct EpiSC8 {
    static constexpr bool PERM = false; static constexpr bool HAS_MID = false; static constexpr bool AFTER_DRAIN = true;
    typedef i32x4 acc_t;
    static __device__ __forceinline__ i32x4 mma(bf16x8 b, bf16x8 a, i32x4 c) { return __builtin_amdgcn_mfma_i32_16x16x64_i8(__builtin_bit_cast(i32x4, b), __builtin_bit_cast(i32x4, a), c, 0, 0, 0); }
    float* C; const float* sh; const float* sw; const Frame* F; float* tile;
    __device__ __forceinline__ void fused(const i32x4 (&acc)[2][2][4][2], const Unit& u, int wr, int wc, int fr, int fq) const {
        const int col0 = wc * 32 + 4 * fq;
        f32x4 cw[2][2];
#pragma unroll
        for (int bj = 0; bj < 2; ++bj)
#pragma unroll
            for (int n = 0; n < 2; ++n) cw[bj][n] = *(const f32x4*)(sw + u.pn * BM + col0 + bj * HALF + n * 16);
#pragma unroll
        for (int ai = 0; ai < 2; ++ai) {
#pragma unroll
            for (int m = 0; m < 4; ++m) { const int lr = wr * 64 + m * 16 + fr; const float rs = sh[u.pm * BM + ai * HALF + lr];
#pragma unroll
                for (int bj = 0; bj < 2; ++bj)
#pragma unroll
                    for (int n = 0; n < 2; ++n) { const i32x4 a = acc[ai][bj][m][n]; *(f32x4*)(tile + lr * 260 + col0 + bj * HALF + n * 16) = (f32x4){(float)a[0], (float)a[1], (float)a[2], (float)a[3]} * cw[bj][n] * rs; } }
            __syncthreads();
            { int tz = threadIdx.x; asm volatile("" : "+v"(tz)); const int w = __builtin_amdgcn_readfirstlane(tz >> 6);
              topk_rows(*F, tile + (size_t)(w * 16) * 260, 260, u.pm * BM + ai * HALF + w * 16, u.pn, 4); }
            __syncthreads();
        }
    }
    __device__ __forceinline__ void operator()(const i32x4 (&acc)[2][2][4][2], const Unit& u, int wr, int wc, int fr, int fq) const {
        const int row0 = u.pm * BM + wr * 64 + fr, col0 = u.pn * BM + wc * 32 + 4 * fq;
        f32x4 cw[2][2];
#pragma unroll
        for (int bj = 0; bj < 2; ++bj)
#pragma unroll
            for (int n = 0; n < 2; ++n) cw[bj][n] = *(const f32x4*)(sw + col0 + bj * HALF + n * 16);
#pragma unroll
        for (int ai = 0; ai < 2; ++ai)
#pragma unroll
            for (int m = 0; m < 4; ++m) { const int row = row0 + ai * HALF + m * 16; const float rs = sh[row]; float* rowp = C + (size_t)row * DM + col0;
#pragma unroll
                for (int bj = 0; bj < 2; ++bj)
#pragma unroll
                    for (int n = 0; n < 2; ++n) { const i32x4 a = acc[ai][bj][m][n]; *(f32x4*)(rowp + bj * HALF + n * 16) = (f32x4){(float)a[0], (float)a[1], (float)a[2], (float)a[3]} * cw[bj][n] * rs; } }
    }
};
}

namespace att {
constexpr int D = 128, NW = 8, QBLK = 32, KVBLK = 64;
constexpr float SCALE = 0.088388347648318440f;
constexpr float THR = 8.f;
constexpr int SHM_V = KVBLK * D * 2, SHM_K = KVBLK * D * 2, SHM_ATTN = 2 * SHM_V + 2 * SHM_K + NW * 64 * 4;
struct Args {
    const bf16_t* Q; const bf16_t* K; const bf16_t* V; bf16_t* O; float* lse;
    int ldq, ldk, ldo, ldl;
    int kt0, NT;
    int q0, W;
    float slope_l2, m_init, l_init;
};
#define KSWZ(row, colB) ((row) * 256 + ((colB) ^ (((row) & 7) << 4)))
#define SBAR() __builtin_amdgcn_sched_barrier(0)
__device__ __forceinline__ int crow(int r, int hi) { return (r & 3) + 8 * (r >> 2) + 4 * hi; }
template <bool FIRST>
__device__ __forceinline__ void partialSM_dense(f32x16& p0, f32x16& p1, f32x16& negm, float& alpha) {
    float pmax = p0[0];
#pragma unroll
    for (int r = 1; r < 16; ++r) pmax = fmaxf(pmax, p0[r]);
#pragma unroll
    for (int r = 0; r < 16; ++r) pmax = fmaxf(pmax, p1[r]);
    { auto rr = __builtin_amdgcn_permlane32_swap(__float_as_uint(pmax), __float_as_uint(pmax), false, false); pmax = fmaxf(__uint_as_float(rr[0]), __uint_as_float(rr[1])); }
    if (!FIRST && __builtin_expect(__all(pmax <= THR * LOG2E), 1)) { alpha = 1.f; }
    else {
        const float d = FIRST ? pmax : fmaxf(pmax, 0.f);
        alpha = FIRST ? 1.f : __builtin_amdgcn_exp2f(-d); const float nm = negm[0] - d;
#pragma unroll
        for (int r = 0; r < 16; ++r) { p0[r] -= d; p1[r] -= d; negm[r] = nm; }
        asm volatile("" : "+v"(negm));
    }
#pragma unroll
    for (int r = 0; r < 16; ++r) p0[r] = __builtin_amdgcn_exp2f(p0[r]);
}
__device__ __forceinline__ void partialSM_band(f32x16& p0, f32x16& p1, float& m_reg, float& mn, float& alpha, float qrel, int hi, float slope_l2, float Wf) {
    constexpr float C = SCALE * LOG2E;
    const float ninf = -__builtin_inff();
    float pmax = ninf; const float h4 = (float)(4 * hi);
#pragma unroll
    for (int r = 0; r < 16; ++r) { const float kl = (float)((r & 3) + 8 * (r >> 2)) + h4; const float d0 = fabsf(qrel - kl), d1 = fabsf(qrel - (kl + 32.f));
        float t0 = fmaf(p0[r], C, -slope_l2 * d0), t1 = fmaf(p1[r], C, -slope_l2 * d1);
        t0 = d0 <= Wf ? t0 : ninf; t1 = d1 <= Wf ? t1 : ninf; p0[r] = t0; p1[r] = t1; pmax = fmaxf(pmax, fmaxf(t0, t1)); }
    { auto rr = __builtin_amdgcn_permlane32_swap(__float_as_uint(pmax), __float_as_uint(pmax), false, false); pmax = fmaxf(__uint_as_float(rr[0]), __uint_as_float(rr[1])); }
    if (__all(pmax - m_reg <= THR * LOG2E)) { mn = m_reg; alpha = 1.f; }
    else { mn = fmaxf(m_reg, pmax); alpha = __builtin_amdgcn_exp2f(m_reg - mn); m_reg = mn; }
#pragma unroll
    for (int r = 0; r < 16; ++r) p1[r] = p1[r] - mn;
#pragma unroll
    for (int r = 0; r < 16; ++r) p0[r] = __builtin_amdgcn_exp2f(p0[r] - mn);
}
__device__ __forceinline__ void finishSM(f32x16& p0, f32x16& p1, float alpha, float& l_reg, bf16x8& pa0, bf16x8& pa1, bf16x8& pa2, bf16x8& pa3) {
#pragma unroll
    for (int r = 0; r < 16; ++r) p1[r] = __builtin_amdgcn_exp2f(p1[r]);
    float ps = 0;
#pragma unroll
    for (int r = 0; r < 16; ++r) ps += p0[r];
#pragma unroll
    for (int r = 0; r < 16; ++r) ps += p1[r];
    { auto rr = __builtin_amdgcn_permlane32_swap(__float_as_uint(ps), __float_as_uint(ps), false, false); ps = __uint_as_float(rr[0]) + __uint_as_float(rr[1]); }
    l_reg = l_reg * alpha + ps;
#define PK4(P, BASE, OUT) do { unsigned a0 = cvtpk(P[BASE + 0], P[BASE + 1]), a1 = cvtpk(P[BASE + 2], P[BASE + 3]);   \
    unsigned b0 = cvtpk(P[BASE + 4], P[BASE + 5]), b1 = cvtpk(P[BASE + 6], P[BASE + 7]);                              \
    auto r0 = __builtin_amdgcn_permlane32_swap(a0, b0, false, false); auto r1 = __builtin_amdgcn_permlane32_swap(a1, b1, false, false); \
    u32x4 w = {r0[0], r1[0], r0[1], r1[1]}; OUT = *reinterpret_cast<bf16x8*>(&w); } while (0)
    PK4(p0, 0, pa0); PK4(p0, 8, pa1); PK4(p1, 0, pa2); PK4(p1, 8, pa3);
#undef PK4
}
__device__ __forceinline__ void qkt(f32x16& p0, f32x16& p1, const char* Ks, const bf16x8* qr, int r32, int hi) {
    p0 = f32x16{}; p1 = f32x16{};
#pragma unroll
    for (int d0 = 0; d0 < 8; ++d0) { const int cb = (d0 * 16 + hi * 8) * 2;
        const bf16x8 b0 = *reinterpret_cast<const bf16x8*>(Ks + KSWZ(r32, cb));
        const bf16x8 b1 = *reinterpret_cast<const bf16x8*>(Ks + KSWZ(32 + r32, cb));
        p0 = __builtin_amdgcn_mfma_f32_32x32x16_bf16(b0, qr[d0], p0, 0, 0, 0);
        p1 = __builtin_amdgcn_mfma_f32_32x32x16_bf16(b1, qr[d0], p1, 0, 0, 0); }
}
__device__ __forceinline__ void qkt_c(f32x16& p0, f32x16& p1, const char* Ks, const bf16x8* qr, const f32x16& c, int r32, int hi) {
#pragma unroll
    for (int d0 = 0; d0 < 8; ++d0) { const int cb = (d0 * 16 + hi * 8) * 2;
        const bf16x8 b0 = *reinterpret_cast<const bf16x8*>(Ks + KSWZ(r32, cb));
        const bf16x8 b1 = *reinterpret_cast<const bf16x8*>(Ks + KSWZ(32 + r32, cb));
        if (d0 == 0) { p0 = __builtin_amdgcn_mfma_f32_32x32x16_bf16(b0, qr[0], c, 0, 0, 0); p1 = __builtin_amdgcn_mfma_f32_32x32x16_bf16(b1, qr[0], c, 0, 0, 0); }
        else { p0 = __builtin_amdgcn_mfma_f32_32x32x16_bf16(b0, qr[d0], p0, 0, 0, 0); p1 = __builtin_amdgcn_mfma_f32_32x32x16_bf16(b1, qr[d0], p1, 0, 0, 0); } }
}
__device__ __forceinline__ int v_st(int k, int c) { const int kk = (k & ~0xC) | ((k & 4) << 1) | ((k & 8) >> 1); return ((kk >> 3) * 4 + (c >> 5)) * 512 + ((kk & 7) * 32 + (c & 31)) * 2; }
__device__ __forceinline__ int v_rd_base(int lane) { return ((lane & 3) << 3) | (((lane >> 2) & 3) << 6) | (((lane >> 4) & 1) << 5) | (((lane >> 5) & 1) << 8); }
constexpr int v_rd_off(int d0, int ks, int half) { return d0 * 512 + ks * 4096 + half * 2048; }
template <int OFF> __device__ __forceinline__ s16x4 tr_read(int vb) { s16x4 r; asm volatile("ds_read_b64_tr_b16 %0, %1 offset:%2" : "=&v"(r) : "v"(vb), "i"(OFF) : "memory"); return r; }
template <int D0> __device__ __forceinline__ void pv_one(f32x16& od, int vb, bf16x8 pa0, bf16x8 pa1, bf16x8 pa2, bf16x8 pa3) {
    const s16x4 l0 = tr_read<v_rd_off(D0, 0, 0)>(vb), h0 = tr_read<v_rd_off(D0, 0, 1)>(vb), l1 = tr_read<v_rd_off(D0, 1, 0)>(vb), h1 = tr_read<v_rd_off(D0, 1, 1)>(vb);
    const s16x4 l2 = tr_read<v_rd_off(D0, 2, 0)>(vb), h2 = tr_read<v_rd_off(D0, 2, 1)>(vb), l3 = tr_read<v_rd_off(D0, 3, 0)>(vb), h3 = tr_read<v_rd_off(D0, 3, 1)>(vb);
    asm volatile("s_waitcnt lgkmcnt(0)" ::: "memory"); SBAR();
#define PK(L, H) (bf16x8){L[0], L[1], L[2], L[3], H[0], H[1], H[2], H[3]}
    od = __builtin_amdgcn_mfma_f32_32x32x16_bf16(pa0, PK(l0, h0), od, 0, 0, 0);
    od = __builtin_amdgcn_mfma_f32_32x32x16_bf16(pa1, PK(l1, h1), od, 0, 0, 0);
    od = __builtin_amdgcn_mfma_f32_32x32x16_bf16(pa2, PK(l2, h2), od, 0, 0, 0);
    od = __builtin_amdgcn_mfma_f32_32x32x16_bf16(pa3, PK(l3, h3), od, 0, 0, 0);
#undef PK
}
__device__ __forceinline__ void pv_d0(f32x16* o, int vb, bf16x8 pa0, bf16x8 pa1, bf16x8 pa2, bf16x8 pa3) {
    pv_one<0>(o[0], vb, pa0, pa1, pa2, pa3); pv_one<1>(o[1], vb, pa0, pa1, pa2, pa3); pv_one<2>(o[2], vb, pa0, pa1, pa2, pa3); pv_one<3>(o[3], vb, pa0, pa1, pa2, pa3);
}
__device__ __forceinline__ void store_o(const f32x16 (&o)[4], float l_reg, char* lds, bf16_t* O, int ldo) {
    int tz = threadIdx.x; asm volatile("" : "+v"(tz));
    const int wid = tz >> 6, lane = tz & 63, r32 = lane & 31, hi = lane >> 5;
    float* li_l = (float*)(lds + 2 * SHM_V + 2 * SHM_K) + wid * 64;
    if (hi == 0) li_l[r32] = l_reg; asm volatile("s_waitcnt lgkmcnt(0)" ::: "memory");
    float rli[16];
#pragma unroll
    for (int r = 0; r < 16; ++r) rli[r] = __builtin_amdgcn_rcpf(li_l[crow(r, hi)]);
    __syncthreads();
    char* ow = lds + wid * 8192;
#pragma unroll
    for (int r = 0; r < 16; ++r) { const int orow = crow(r, hi);
#pragma unroll
        for (int d0 = 0; d0 < 4; ++d0) *(bf16_t*)(ow + orow * 256 + (d0 * 32 + r32) * 2) = (bf16_t)(cvtpk(o[d0][r] * rli[r], 0.f) & 0xffffu); }
    asm volatile("s_waitcnt lgkmcnt(0)" ::: "memory");
    bf16_t* Ow = O + (wid * QBLK) * ldo;
#pragma unroll
    for (int i = 0; i < 8; ++i) { const int p = i * 64 + lane, row = p >> 4, c16 = p & 15;
        const u32x4 v = *(const u32x4*)(ow + row * 256 + c16 * 16);
        *(u32x4*)(Ow + row * ldo + c16 * 8) = v; }
    __syncthreads();
}
#define RESC(al) do { if (__any((al) < 1.f)) { if (hi == 0) al_l[r32] = (al); asm volatile("s_waitcnt lgkmcnt(0)" ::: "memory"); \
    _Pragma("unroll") for (int d = 0; d < 4; ++d) _Pragma("unroll") for (int r = 0; r < 16; ++r) o[d][r] *= al_l[crow(r, hi)]; } } while (0)
#define SWRITE(b, S) do { *(bf16x8*)(V_lds + (b) * SHM_V + vst0) = S.vs0; *(bf16x8*)(V_lds + (b) * SHM_V + vst1) = S.vs1; const int kc = sc * 2; \
    *(bf16x8*)(K_lds + (b) * SHM_K + KSWZ(sr, kc)) = S.ks0; *(bf16x8*)(K_lds + (b) * SHM_K + KSWZ(32 + sr, kc)) = S.ks1; } while (0)
struct Slot { bf16x8 vs0, vs1, ks0, ks1; };
template <int LDQK, int LDO, int VDELTA>
__device__ __forceinline__ void attn_dense_unit(const bf16_t* Q, const bf16_t* K, bf16_t* O, int NT, char* lds) {
    int tid = threadIdx.x; asm volatile("" : "+v"(tid));
    const int wid = __builtin_amdgcn_readfirstlane(tid >> 6), lane = tid & 63, r32 = lane & 31, hi = lane >> 5;
    char* V_lds = lds; char* K_lds = lds + 2 * SHM_V;
    float* ws = (float*)(lds + 2 * SHM_V + 2 * SHM_K) + wid * 64; float* al_l = ws + 32;
    float l_reg = 0.f; f32x16 o[4] = {}; bf16x8 qr[8]; f32x16 negm = f32x16{}; asm volatile("" : "+v"(negm));
    const bf16_t* Qw = Q + (wid * QBLK + r32) * LDQK + hi * 8;
#pragma unroll
    for (int d0 = 0; d0 < 8; ++d0) qr[d0] = *reinterpret_cast<const bf16x8*>(Qw + d0 * 16);
    const int vb0 = (int)(uintptr_t)V_lds + v_rd_base(lane);
    int koff[2];
#pragma unroll
    for (int q = 0; q < 2; ++q) { const int row = 4 * (2 * wid + q) + (lane >> 4), cb = ((lane & 15) * 16) ^ ((row & 7) << 4); koff[q] = row * LDQK + (cb >> 1); }
    const int vkk = 8 * wid + ((lane & 31) >> 2), vkey = (vkk & ~0xC) | ((vkk & 4) << 1) | ((vkk & 8) >> 1);
    const int voff = vkey * LDQK + (lane >> 5) * 32 + (lane & 3) * 8 + VDELTA;
    LAS unsigned char* Kl = (LAS unsigned char*)K_lds + 2 * wid * 1024; LAS unsigned char* Vl = (LAS unsigned char*)V_lds + 2 * wid * 1024;
#define DMA_K(tile, buf) do { const bf16_t* kt_ = K + (size_t)((tile) < NT ? (tile) : NT - 1) * (KVBLK * LDQK); _Pragma("unroll") for (int q_ = 0; q_ < 2; ++q_) \
        __builtin_amdgcn_global_load_lds((const unsigned*)(kt_ + koff[q_]), (LAS unsigned*)(Kl + (buf) * SHM_K + q_ * 1024), 16, 0, 0); } while (0)
#define DMA_V(tile, buf) do { const bf16_t* vt_ = K + (size_t)((tile) < NT ? (tile) : NT - 1) * (KVBLK * LDQK) + voff; _Pragma("unroll") for (int q_ = 0; q_ < 2; ++q_) \
        __builtin_amdgcn_global_load_lds((const unsigned*)(vt_ + q_ * 64), (LAS unsigned*)(Vl + (buf) * SHM_V + q_ * 1024), 16, 0, 0); } while (0)
#define WBAR4() do { asm volatile("s_waitcnt vmcnt(4)" ::: "memory"); __builtin_amdgcn_s_barrier(); } while (0)
#define XBAR() do { asm volatile("s_waitcnt lgkmcnt(0)" ::: "memory"); __builtin_amdgcn_s_barrier(); } while (0)
    f32x16 pA0, pA1, pB0, pB1; float alA, alB; bf16x8 pa0, pa1, pa2, pa3;
    DMA_K(0, 0); DMA_V(0, 0); DMA_K(1, 1);
    WBAR4();
    qkt_c(pA0, pA1, K_lds, qr, negm, r32, hi); partialSM_dense<true>(pA0, pA1, negm, alA);
    XBAR();
    DMA_V(1, 1); DMA_K(2, 0);
    WBAR4();
#define STEP_E(t) do { SBAR(); qkt_c(pB0, pB1, K_lds + SHM_K, qr, negm, r32, hi); \
        finishSM(pA0, pA1, alA, l_reg, pa0, pa1, pa2, pa3); SBAR(); \
        pv_d0(o, vb0, pa0, pa1, pa2, pa3); partialSM_dense<false>(pB0, pB1, negm, alB); \
        XBAR(); DMA_V((t) + 2, 0); DMA_K((t) + 3, 1); RESC(alB); WBAR4(); } while (0)
#define STEP_O(t) do { SBAR(); qkt_c(pA0, pA1, K_lds, qr, negm, r32, hi); \
        finishSM(pB0, pB1, alB, l_reg, pa0, pa1, pa2, pa3); SBAR(); \
        pv_d0(o, vb0 + (int)SHM_V, pa0, pa1, pa2, pa3); partialSM_dense<false>(pA0, pA1, negm, alA); \
        XBAR(); DMA_V((t) + 2, 1); DMA_K((t) + 3, 0); RESC(alA); WBAR4(); } while (0)
    int t = 0;
    for (; t + 2 < NT; t += 2) { STEP_E(t); STEP_O(t + 1); }
    STEP_E(t);
    finishSM(pB0, pB1, alB, l_reg, pa0, pa1, pa2, pa3); SBAR();
    pv_d0(o, vb0 + (int)SHM_V, pa0, pa1, pa2, pa3);
    asm volatile("s_waitcnt vmcnt(0)" ::: "memory");
    store_o(o, l_reg, lds, O, LDO);
#undef DMA_K
#undef DMA_V
#undef WBAR4
#undef XBAR
#undef STEP_E
#undef STEP_O
}
__device__ __forceinline__ void attn_band_unit(const Args& a, char* lds) {
    int tid = threadIdx.x; asm volatile("" : "+v"(tid));
    const int wid = tid >> 6, lane = tid & 63, r32 = lane & 31, hi = lane >> 5;
    char* V_lds = lds; char* K_lds = lds + 2 * SHM_V;
    float* ws = (float*)(lds + 2 * SHM_V + 2 * SHM_K) + wid * 64; float* li_l = ws; float* al_l = ws + 32;
    float m_reg = a.m_init, l_reg = a.l_init; f32x16 o[4] = {}; bf16x8 qr[8];
    const bf16_t* Qw = a.Q + (wid * QBLK + r32) * a.ldq + hi * 8;
#pragma unroll
    for (int d0 = 0; d0 < 8; ++d0) qr[d0] = *reinterpret_cast<const bf16x8*>(Qw + d0 * 16);
    const int sr = tid >> 4, sc = (tid & 15) * 8, vst0 = v_st(sr, sc), vst1 = v_st(32 + sr, sc);
    const int vb0 = (int)(uintptr_t)V_lds + v_rd_base(lane);
    const char* Kh = (const char*)(a.K + (long)a.kt0 * KVBLK * a.ldk); const char* Vh = (const char*)(a.V + (long)a.kt0 * KVBLK * a.ldk);
    const unsigned so0 = (unsigned)(sr * a.ldk + sc) * 2u, so1 = so0 + (unsigned)(32 * a.ldk) * 2u; const long tstep = (long)KVBLK * a.ldk * 2;
    const float qrel0 = (float)(a.q0 + wid * QBLK + r32 - a.kt0 * KVBLK), Wf = (float)a.W, slope = a.slope_l2;
    Slot st; const int NT = a.NT;
#define SLOAD1(tile) do { const char* vt_ = Vh + (long)(tile) * tstep; const char* kt_ = Kh + (long)(tile) * tstep; \
    st.vs0 = *reinterpret_cast<const bf16x8*>(vt_ + so0); st.vs1 = *reinterpret_cast<const bf16x8*>(vt_ + so1); \
    st.ks0 = *reinterpret_cast<const bf16x8*>(kt_ + so0); st.ks1 = *reinterpret_cast<const bf16x8*>(kt_ + so1); } while (0)
    SLOAD1(0); asm volatile("s_waitcnt vmcnt(0)" ::: "memory"); SWRITE(0, st); __syncthreads();
    for (int j = 0; j < NT; ++j) {
        const int bsel = j & 1;
        if (j + 1 < NT) SLOAD1(j + 1);
        const int kb = (a.kt0 + j) * KVBLK, qlo = a.q0 + __builtin_amdgcn_readfirstlane(wid) * QBLK;
        if (kb <= qlo + QBLK - 1 + a.W && kb + KVBLK - 1 >= qlo - a.W) {
        f32x16 p0, p1; float mn, al; bf16x8 pa0, pa1, pa2, pa3;
        qkt(p0, p1, K_lds + bsel * SHM_K, qr, r32, hi);
        partialSM_band(p0, p1, m_reg, mn, al, qrel0 - (float)(j * KVBLK), hi, slope, Wf);
        RESC(al);
        finishSM(p0, p1, al, l_reg, pa0, pa1, pa2, pa3); SBAR();
        pv_d0(o, vb0 + bsel * (int)SHM_V, pa0, pa1, pa2, pa3);
        }
        if (j + 1 < NT) { asm volatile("s_waitcnt vmcnt(0)" ::: "memory"); if (bsel) { SWRITE(0, st); } else { SWRITE(1, st); } }
        __syncthreads();
    }
    if (a.lse != nullptr && hi == 0) a.lse[(wid * QBLK + r32) * a.ldl] = (m_reg + __builtin_amdgcn_logf(l_reg)) * LN2;
    store_o(o, l_reg, lds, a.O, a.ldo);
#undef SLOAD1
}
#undef RESC
#undef SWRITE
}

struct Args {
    const float* in[20]; float* out; unsigned char* ws; int ph_lo, ph_hi, use_bar, pad;
};
enum { IN_X = 0, IN_C, IN_WMOD, IN_BMOD, IN_WIN, IN_AQG, IN_AKG, IN_CSINK, IN_WPA, IN_WPB, IN_WPC, IN_WO, IN_LN1G, IN_LN1B, IN_PWQ, IN_PKEYS, IN_PU, IN_PV, IN_LN2G, IN_LN2B };
constexpr int LDS_RING = 0, LDS_WTAB = 128 * 1024  , LDS_MISC = 152 * 1024, LDS_BYTES = 153 * 1024;

struct Frame {
    const Args* a; unsigned char* ws; char* lds; int tid, wid, lane, G, bid;
    __device__ __forceinline__ unsigned char* wl(int l, size_t off) const { return ws + WS_W0 + (size_t)l * WL_BYTES + off; }
};

__device__ __forceinline__ void tconv_tile(const float* src, int N, bf16_t* dst, int ldd, int k0, int n0, float* tl, int tid) {
    {   const int r = tid >> 6, c4 = (tid & 63) * 4; f32x4 v[8];
#pragma unroll
        for (int i = 0; i < 8; ++i) v[i] = *(const f32x4*)(src + (size_t)(k0 + r + 8 * i) * N + n0 + c4);
#pragma unroll
        for (int i = 0; i < 8; ++i) { float* p = tl + (r + 8 * i) * 257 + c4; p[0] = v[i][0]; p[1] = v[i][1]; p[2] = v[i][2]; p[3] = v[i][3]; } }
    __syncthreads();
    {   const int n = tid >> 1, kh = (tid & 1) * 32;
#pragma unroll
        for (int q = 0; q < 4; ++q) { float v[8];
#pragma unroll
            for (int j = 0; j < 8; ++j) v[j] = tl[(kh + q * 8 + j) * 257 + n];
            *(u32x4*)(dst + (size_t)(n0 + n) * ldd + k0 + kh + q * 8) = pack8(v); } }
    __syncthreads();
}
__device__ __forceinline__ unsigned fp4_code(float y) {
    const float a = fabsf(y);
    const unsigned c = (a >= 0.25f) + (a >= 0.75f) + (a >= 1.25f) + (a >= 1.75f) + (a >= 2.5f) + (a >= 3.5f) + (a >= 5.0f);
    return c | (y < 0.f ? 8u : 0u);
}
__device__ __forceinline__ unsigned fp4_pack8(const float* v, float inv) {
    unsigned w = 0u;
#pragma unroll
    for (int j = 0; j < 8; ++j) w |= fp4_code(v[j] * inv) << (4 * j);
    return w;
}
__device__ __forceinline__ void store_h_q8(const float (&v)[2][16], unsigned char* hrow, float* shp, int lane) {
    float am = 0.f;
#pragma unroll
    for (int hf = 0; hf < 2; ++hf)
#pragma unroll
        for (int j = 0; j < 16; ++j) am = fmaxf(am, fabsf(v[hf][j]));
    am = wave_max(am); const float sc = am > 0.f ? am * (1.0f / 6.0f) : 1.0f, inv = 1.0f / sc;
#pragma unroll
    for (int hf = 0; hf < 2; ++hf) *(u32x2*)(hrow + hf * 512 + lane * 8) = (u32x2){fp4_pack8(&v[hf][0], inv), fp4_pack8(&v[hf][8], inv)};
    if (lane == 0) *shp = sc;
}

__device__ void phase_c0(const Frame& F) {
    const Args& A = *F.a; const int tid = F.tid, G = F.G, bid = F.bid;
    float* tl = (float*)F.lds;
    if (tid < 8) {
        float* rope = (float*)(F.ws + WS_ROPE);
        for (int e = bid * 8 + tid; e < 64 * 32; e += G * 8) {
            const int pos = e >> 5, i = e & 31;
            double inv = 1.0; for (int k = 0; k < i; ++k) inv *= 0.74989420933245582730;
            const double ang = (double)pos * (double)(float)inv;
            const double kq = __builtin_rint(ang * 0.63661977236758134308);
            const double r = (ang - kq * 1.5707963267948966192) - kq * 6.123233995736766e-17;
            const double r2 = r * r;
            double s = r * (1.0 + r2 * (-1.0 / 6 + r2 * (1.0 / 120 + r2 * (-1.0 / 5040 + r2 * (1.0 / 362880 + r2 * (-1.0 / 39916800 + r2 * (1.0 / 6227020800.0)))))));
            double c = 1.0 + r2 * (-0.5 + r2 * (1.0 / 24 + r2 * (-1.0 / 720 + r2 * (1.0 / 40320 + r2 * (-1.0 / 3628800 + r2 * (1.0 / 479001600.0 + r2 * (-1.0 / 87178291200.0)))))));
            const int q = ((int)kq) & 3;
            const double cs = q == 0 ? c : (q == 1 ? -s : (q == 2 ? -c : s)), sn = q == 0 ? s : (q == 1 ? c : (q == 2 ? -s : -c));
            rope[e] = (float)cs; rope[2048 + e] = (float)sn;
        }
    }
    for (int u = bid; u < 256; u += G) {
        const int gc0 = u * 96, l = gc0 / MODW, n0 = gc0 % MODW;
        const float* wm = A.in[IN_WMOD] + (size_t)l * DM * MODW; const float* cv = A.in[IN_C];
        const int rr = tid / 24, cq = tid % 24;
        f32x4 a0 = {0.f, 0.f, 0.f, 0.f}, a1 = {0.f, 0.f, 0.f, 0.f};
        if (rr < 21) {
            for (int k = rr; k < DM; k += 14 * 21) { f32x4 w[14];
#pragma unroll
                for (int i = 0; i < 14; ++i) { const int kk = k + 21 * i < DM ? k + 21 * i : DM - 1; w[i] = __builtin_nontemporal_load((const f32x4*)(wm + (size_t)kk * MODW + n0 + cq * 4)); }
#pragma unroll
                for (int i = 0; i < 14; ++i) { const bool ok = k + 21 * i < DM; const int kk = ok ? k + 21 * i : DM - 1; const float c0 = ok ? cv[kk] : 0.f, c1 = ok ? cv[DM + kk] : 0.f; a0 += w[i] * c0; a1 += w[i] * c1; } }
        }
        float* red = tl;
        if (rr < 21) { *(f32x4*)(red + (rr * 2 + 0) * 96 + cq * 4) = a0; *(f32x4*)(red + (rr * 2 + 1) * 96 + cq * 4) = a1; }
        __syncthreads();
        if (tid < 192) { const int b = tid / 96, n = tid % 96; float s = 0.f; for (int r = 0; r < 21; ++r) s += red[(r * 2 + b) * 96 + n];
            ((float*)(F.ws + WS_MOD))[((size_t)l * NBATCH + b) * MODW + n0 + n] = s + A.in[IN_BMOD][(size_t)l * MODW + n0 + n]; }
        __syncthreads();
    }
    {
        int mine = 0; for (int u = bid; u < 43; u += G) ++mine;
        if (mine > 0) { asm volatile("s_waitcnt vmcnt(0)" ::: "memory"); __syncthreads();
            if (tid == 0) { __builtin_amdgcn_fence(__ATOMIC_RELEASE, "agent"); asm volatile("s_waitcnt vmcnt(0)" ::: "memory"); (void)xb_add((unsigned*)(F.ws + WS_CTL) + XB_MODCNT, (unsigned)mine); } }
    }
    for (int u0 = bid; u0 < DEPTH * 16 * 8; u0 += G) {
        const int u = G == 256 ? (((u0 & 7) | ((u0 >> 6) << 3)) << 3) | ((u0 >> 3) & 7) : u0;
        const int l = u >> 7, hp = (u >> 3) & 15, kb = u & 7, p = hp & 1;
        const float* keys = A.in[IN_PKEYS] + ((size_t)(l * 2 + p) * 128) * 128; const float* wq = A.in[IN_PWQ] + (size_t)l * DM * DM;
        unsigned char* dst = F.wl(l, WL_WQK) + (size_t)(hp * 128 + kb * 16) * DM; float* swq = (float*)F.wl(l, WL_SWQK) + hp * 128 + kb * 16;
        float* red = (float*)F.lds; unsigned char* bt = (unsigned char*)F.lds + 1024;
        const int lane = F.lane, w = F.wid, li = lane & 15, lg = lane >> 4;
        f32x4 af[8];
#pragma unroll
        for (int blk = 0; blk < 8; ++blk) af[blk] = *(const f32x4*)(keys + (size_t)(kb * 16 + li) * 128 + blk * 16 + lg * 4);
        f32x4 bv[2][8]; f32x4 acc[16];
        const float* wrow = wq + (size_t)(w * 256 + li) * DM + hp * 128 + lg * 4;
#pragma unroll
        for (int blk = 0; blk < 8; ++blk) bv[0][blk] = *(const f32x4*)(wrow + blk * 16);
#pragma unroll
        for (int db = 0; db < 16; ++db) {
            const int cur = db & 1;
            if (db + 1 < 16) {
#pragma unroll
                for (int blk = 0; blk < 8; ++blk) bv[cur ^ 1][blk] = *(const f32x4*)(wrow + (size_t)(db + 1) * 16 * DM + blk * 16); }
            f32x4 a = {0.f, 0.f, 0.f, 0.f};
#pragma unroll
            for (int blk = 0; blk < 8; ++blk)
#pragma unroll
                for (int s2 = 0; s2 < 4; ++s2) a = __builtin_amdgcn_mfma_f32_16x16x4f32(af[blk][s2], bv[cur][blk][s2], a, 0, 0, 0);
            acc[db] = a;
        }
        float am[4] = {0.f, 0.f, 0.f, 0.f};
#pragma unroll
        for (int db = 0; db < 16; ++db)
#pragma unroll
            for (int r = 0; r < 4; ++r) am[r] = fmaxf(am[r], fabsf(acc[db][r]));
#pragma unroll
        for (int r = 0; r < 4; ++r) { float x = am[r]; x = fmaxf(x, dppf<XOR1>(x)); x = fmaxf(x, dppf<XOR2>(x)); x = fmaxf(x, dppf<HMIR>(x)); x = fmaxf(x, dppf<MIR>(x)); am[r] = x; }
        if (li == 0) {
#pragma unroll
            for (int r = 0; r < 4; ++r) red[w * 16 + lg * 4 + r] = am[r]; }
        __syncthreads();
        float inv[4];
#pragma unroll
        for (int r = 0; r < 4; ++r) { float x = 0.f;
#pragma unroll
            for (int ww = 0; ww < 8; ++ww) x = fmaxf(x, red[ww * 16 + lg * 4 + r]);
            const float sc = x > 0.f ? x * (1.0f / 127.0f) : 1.0f; inv[r] = 1.0f / sc;
            if (w == 0 && li == 0) swq[lg * 4 + r] = sc; }
#pragma unroll
        for (int db = 0; db < 16; ++db)
#pragma unroll
            for (int r = 0; r < 4; ++r) bt[(lg * 4 + r) * DM + w * 256 + db * 16 + li] = (unsigned char)((int)__builtin_rintf(acc[db][r] * inv[r]) & 0xff);
        __syncthreads();
#pragma unroll
        for (int q = 0; q < 4; ++q) { const int pc = q * NTHREADS + tid, k = pc >> 7, c16 = (pc & 127) * 16;
            *(u32x4*)(dst + (size_t)k * DM + c16) = *(const u32x4*)(bt + k * DM + c16); }
        __syncthreads();
    }
    for (int it = bid; it < DEPTH * 608; it += G) {
        const int l = it / 608; int r = it % 608 + 1440;
        const float* src; int N; bf16_t* dst; int ldd, koff, nkt;
        if (r < 1568) { r -= 1440; src = A.in[IN_WPA] + (size_t)l * 1024 * DM; N = DM; dst = (bf16_t*)F.wl(l, WL_WP); ldd = AOW; koff = AO_A; nkt = 16; }
        else if (r < 1664) { r -= 1568; src = A.in[IN_WPB] + (size_t)l * 768 * DM; N = DM; dst = (bf16_t*)F.wl(l, WL_WP); ldd = AOW; koff = AO_B; nkt = 12; }
        else if (r < 1792) { r -= 1664; src = A.in[IN_WPC] + (size_t)l * 1024 * DM; N = DM; dst = (bf16_t*)F.wl(l, WL_WP); ldd = AOW; koff = AO_C; nkt = 16; }
        else { r -= 1792; src = A.in[IN_WO] + (size_t)l * DM * DM; N = DM; dst = (bf16_t*)F.wl(l, WL_WO); ldd = DM; koff = 0; nkt = 32; }
        const int kt = r % nkt, ntile = r / nkt;
        tconv_tile(src, N, dst + koff, ldd, kt * 64, ntile * 256, tl, tid);
    }
    {
        const int lane = F.lane, wbase = bid * 32 + F.wid * 4;
        auto rowof = [&](int i) { return (i >> 2) * (G * 32) + wbase + (i & 3); };
        auto ldrow = [&](f32x4 (&v)[8], int rw) {
            if (rw < 4 * NEXP) { const int which = rw / NEXP, e = rw % NEXP;
                const float* src = A.in[(which & 1) ? IN_PV : IN_PU] + ((size_t)(which >> 1) * NEXP + e) * DM;
#pragma unroll
                for (int i = 0; i < 8; ++i) v[i] = __builtin_nontemporal_load((const f32x4*)(src + i * 256 + lane * 4)); } };
        auto cvrow = [&](const f32x4 (&v)[8], int rw) {
            if (rw >= 4 * NEXP) return;
            const int which = rw / NEXP, e = rw % NEXP, l = which >> 1, tb = which & 1;
            float am = 0.f, sq = 0.f;
#pragma unroll
            for (int i = 0; i < 8; ++i)
#pragma unroll
                for (int j = 0; j < 4; ++j) { am = fmaxf(am, fabsf(v[i][j])); sq = fmaf(v[i][j], v[i][j], sq); }
            am = wave_max(am); sq = wave_sum(sq);
            const float st = fminf(am * (1.0f / 7.5f), 0.3352f * __builtin_sqrtf(sq * (1.0f / DM)));
            const float sc = st > 0.f ? st : 1.0f, inv = 1.0f / sc;
            unsigned wd[4];
#pragma unroll
            for (int d = 0; d < 4; ++d) { float bq[4];
#pragma unroll
                for (int j = 0; j < 4; ++j) { const float lo = fminf(fmaxf(__builtin_floorf(v[2 * d][j] * inv) + 8.f, 0.f), 15.f), hi = fminf(fmaxf(__builtin_floorf(v[2 * d + 1][j] * inv) + 8.f, 0.f), 15.f); bq[j] = fmaf(hi >= 8.f ? hi - 8.f : hi + 8.f, 16.f, lo); }
                wd[d] = pack4_raw(bq[0], bq[1], bq[2], bq[3]); }
            *(u32x4*)(F.wl(l, tb ? WL_VB : WL_UB) + (size_t)e * (DM / 2) + lane * 16) = (u32x4){wd[0], wd[1], wd[2], wd[3]};
            if (lane == 0) ((float*)F.wl(l, tb ? WL_SV : WL_SU))[e] = sc; };
        const int nrw = ((4 * NEXP + G * 32 - 1) / (G * 32)) * 4;
        f32x4 va[8], vb[8];
        ldrow(va, rowof(0));
        for (int i = 0; i < nrw; i += 2) {
            ldrow(vb, rowof(i + 1));
            cvrow(va, rowof(i));
            if (i + 2 < nrw) ldrow(va, rowof(i + 2));
            cvrow(vb, rowof(i + 1));
        }
    }
    for (int u = G - 1 - bid; u < DEPTH * 360; u += G) {
        const int l = u / 360, n0 = (u % 360) * 32, g = tid & 7, kb = tid >> 3;
        const float* src = A.in[IN_WIN] + ((size_t)l * DM + kb * 32) * INW + n0 + g * 4;
        f32x4 v[32];
#pragma unroll
        for (int i = 0; i < 32; ++i) v[i] = __builtin_nontemporal_load((const f32x4*)(src + (size_t)i * INW));
        f32x4 m = {0.f, 0.f, 0.f, 0.f};
#pragma unroll
        for (int i = 0; i < 32; ++i) { m[0] = fmaxf(m[0], fabsf(v[i][0])); m[1] = fmaxf(m[1], fabsf(v[i][1])); m[2] = fmaxf(m[2], fabsf(v[i][2])); m[3] = fmaxf(m[3], fabsf(v[i][3])); }
#pragma unroll
        for (int j = 0; j < 4; ++j) { float x = m[j]; x = fmaxf(x, lperm(x, F.lane ^ 8)); x = fmaxf(x, lperm(x, F.lane ^ 16)); x = fmaxf(x, lperm(x, F.lane ^ 32)); m[j] = x; }
        float* red = tl;
        if (F.lane < 8) *(f32x4*)(red + F.wid * 32 + g * 4) = m;
        __syncthreads();
#pragma unroll
        for (int ww = 0; ww < 8; ++ww) { const f32x4 o = *(const f32x4*)(red + ww * 32 + g * 4); m[0] = fmaxf(m[0], o[0]); m[1] = fmaxf(m[1], o[1]); m[2] = fmaxf(m[2], o[2]); m[3] = fmaxf(m[3], o[3]); }
        unsigned char* dst = F.wl(l, WL_WIN) + (size_t)(n0 + g * 4) * (DM / 2) + kb * 16;
#pragma unroll
        for (int j = 0; j < 4; ++j) {
            const float sc = m[j] > 0.f ? m[j] * (1.0f / 6.0f) : 1.0f, inv = 1.0f / sc; unsigned w[4];
#pragma unroll
            for (int q = 0; q < 4; ++q) { float e8[8];
#pragma unroll
                for (int jj = 0; jj < 8; ++jj) e8[jj] = v[q * 8 + jj][j];
                w[q] = fp4_pack8(e8, inv); }
            *(u32x4*)(dst + (size_t)j * (DM / 2)) = (u32x4){w[0], w[1], w[2], w[3]};
            if (kb == 0) ((float*)F.wl(l, WL_SWIN))[n0 + g * 4 + j] = sc;
        }
        __syncthreads();
    }
    if (tid == 0) { unsigned* ctl = (unsigned*)(F.ws + WS_CTL); XB_SPIN(xb_ld(&ctl[XB_MODCNT]) < 43u, ctl); __builtin_amdgcn_fence(__ATOMIC_ACQUIRE, "agent"); }
    __syncthreads();
    {
    const float* x = A.in[IN_X]; const float* mod = (const float*)(F.ws + WS_MOD);
    for (int tt = F.bid * 32 + F.wid * 4; tt < NTOK; tt += F.G * 32) for (int t = tt; t < tt + 4; ++t) {
        const int b = t / SEQ; float v[2][16];
#pragma unroll
        for (int hf = 0; hf < 2; ++hf)
#pragma unroll
            for (int q = 0; q < 2; ++q) { const int c = hf * 1024 + F.lane * 16 + q * 8; float xv[8], sh[8], sc[8]; ld8f(x + (size_t)t * DM + c, xv); ld8f(mod + (size_t)b * MODW + c, sh); ld8f(mod + (size_t)b * MODW + DM + c, sc);
#pragma unroll
                for (int j = 0; j < 8; ++j) v[hf][q * 8 + j] = fmaf(xv[j], 1.0f + sc[j], sh[j]); }
        store_h_q8(v, F.ws + WS_H + (size_t)t * (DM / 2), (float*)(F.ws + WS_SH) + t, F.lane);
    }
    }
}


__device__ __forceinline__ void norm_rope_tile(const Frame& F, int l, int pm, int pn) {
    const float* raw = (const float*)(F.ws + WS_QKRAW); bf16_t* qkvb = (bf16_t*)(F.ws + WS_QKVB); const float* rope = (const float*)(F.ws + WS_ROPE);
    const int lane = F.lane, i = lane & 31; const bool isq = pn < 4;
    const float qs = isq ? att::SCALE * LOG2E : 1.0f;
    const float g0 = F.a->in[isq ? IN_AQG : IN_AKG][l * HD + lane] * qs, g1 = F.a->in[isq ? IN_AQG : IN_AKG][l * HD + 64 + lane] * qs;
    for (int q0 = F.wid * 64; q0 < F.wid * 64 + 64; q0 += 4) {
        float x0[4], x1[4], cr[4], sr[4], cc[4], sn[4];
#pragma unroll
        for (int k = 0; k < 4; ++k) { const int q = q0 + k, t = pm * 256 + (q >> 1), hh = pn * 2 + (q & 1), s = t % SEQ, pr = s >> 6, pc = s & 63;
            const float* src = raw + (size_t)t * QKRAWW + hh * HD; x0[k] = src[lane]; x1[k] = src[64 + lane];
            cr[k] = rope[pr * 32 + i]; sr[k] = rope[2048 + pr * 32 + i]; cc[k] = rope[pc * 32 + i]; sn[k] = rope[2048 + pc * 32 + i]; }
#pragma unroll
        for (int k = 0; k < 4; ++k) { const int q = q0 + k, t = pm * 256 + (q >> 1), hh = pn * 2 + (q & 1);
            const float ss = wave_sum(x0[k] * x0[k] + x1[k] * x1[k]);
            const float rs = __builtin_amdgcn_rsqf(ss * (1.0f / HD) + QK_EPS);
            const float a0 = x0[k] * rs * g0, a1 = x1[k] * rs * g1;
            const float y0 = lperm(a0, lane ^ 32), y1 = lperm(a1, lane ^ 32);
            const float o0 = lane < 32 ? a0 * cr[k] - y0 * sr[k] : a0 * cr[k] + y0 * sr[k];
            const float o1 = lane < 32 ? a1 * cc[k] - y1 * sn[k] : a1 * cc[k] + y1 * sn[k];
            bf16_t* dst = qkvb + (size_t)t * QKVW + hh * HD;
            dst[lane] = (bf16_t)(cvtpk(o0, 0.f) & 0xffffu); dst[64 + lane] = (bf16_t)(cvtpk(o1, 0.f) & 0xffffu); }
    }
}
__device__ __forceinline__ void band_range(int q0, int W, int L, int& kt0, int& NT) {
    int lo = q0 - W; if (lo < 0) lo = 0; int hi = q0 + 256 + W; if (hi > L) hi = L;
    const int t0 = lo >> 6, t1 = (hi + 63) >> 6;
    kt0 = t0; NT = t1 - t0;
}
__device__ __forceinline__ void attn_c_args(const Frame& F, int l, int u, att::Args& a) {
    const int qb = u & 15, h = (u >> 4) & 7, b = u >> 7, kvh = h >> 2;
    bf16_t* qkvb = (bf16_t*)(F.ws + WS_QKVB); bf16_t* ao = (bf16_t*)(F.ws + WS_AO);
    const size_t t0 = (size_t)b * SEQ;
    a.Q = qkvb + (t0 + qb * 256) * QKVW + COL_QC + h * HD; a.K = qkvb + t0 * QKVW + COL_KC + kvh * HD; a.V = qkvb + t0 * QKVW + COL_VC + kvh * HD;
    a.O = ao + (t0 + qb * 256) * AOW + AO_C + h * HD; a.lse = nullptr; a.ldq = QKVW; a.ldk = QKVW; a.ldo = AOW; a.ldl = 0;
    a.q0 = qb * 256; a.W = 128; band_range(a.q0, a.W, SEQ, a.kt0, a.NT);
    a.slope_l2 = __builtin_amdgcn_exp2f(-(float)(h + 1)) * LOG2E;
    a.m_init = F.a->in[IN_CSINK][l * 8 + h] * LOG2E; a.l_init = 1.0f;
}
__device__ __forceinline__ void attn_b_args(const Frame& F, int u, att::Args& a) {
    const int g = u >> 6, v = u & 63;
    const int r = g == 0 ? 1 : (g == 1 ? 4 : 16), sub = SEQ / r;
    int b, c, hg, qb;
    if (g == 0) { qb = v & 15; hg = (v >> 4) & 1; b = v >> 5; c = 0; }
    else if (g == 1) { qb = v & 3; c = (v >> 2) & 3; hg = (v >> 4) & 1; b = v >> 5; }
    else { qb = 0; c = v & 15; hg = (v >> 4) & 1; b = v >> 5; }
    const int head = g * 2 + hg;
    bf16_t* qkvb = (bf16_t*)(F.ws + WS_QKVB); bf16_t* ao = (bf16_t*)(F.ws + WS_AO); float* lse = (float*)(F.ws + WS_LSEB);
    const size_t t0 = (size_t)b * SEQ + c;
    a.ldq = r * QKVW; a.ldk = r * QKVW; a.ldo = r * AOW; a.ldl = 1;
    a.Q = qkvb + t0 * QKVW + COL_QB + head * HD + (size_t)(qb * 256) * a.ldq; a.K = qkvb + t0 * QKVW + COL_KB + head * HD; a.V = qkvb + t0 * QKVW + COL_VB + head * HD;
    a.O = ao + t0 * AOW + AO_B + head * HD + (size_t)(qb * 256) * a.ldo; a.lse = lse + (size_t)head * NTOK + ((size_t)(b * r + c)) * sub + qb * 256;
    a.q0 = qb * 256; a.W = 64; band_range(a.q0, a.W, sub, a.kt0, a.NT);
    a.slope_l2 = __builtin_amdgcn_exp2f(-8.0f * (float)(head + 1) / 6.0f) * (float)r * LOG2E;
    a.m_init = -1e30f; a.l_init = 0.f;
}
__device__ __forceinline__ void attn_a_unit(const Frame& F, int u) {
    const int xs = u & 7, idx = u >> 3, b = xs >> 2, kvh = (xs >> 1) & 1, h = kvh * 4 + (xs & 1) * 2 + (idx >> 4), qb = idx & 15;
    bf16_t* qkvb = (bf16_t*)(F.ws + WS_QKVB); bf16_t* ao = (bf16_t*)(F.ws + WS_AO);
    const size_t t0 = (size_t)b * SEQ;
    att::attn_dense_unit<QKVW, AOW, COL_VA - COL_KA>(qkvb + (t0 + qb * 256) * QKVW + COL_QA + h * HD, qkvb + t0 * QKVW + COL_KA + kvh * HD,
                                    ao + (t0 + qb * 256) * AOW + AO_A + h * HD, SEQ / 64, F.lds);
}
__device__ void phase_att(const Frame& F, int l) {
    for (int u = F.bid; u < 256; u += F.G) attn_a_unit(F, u);
    for (int u = F.bid; u < 256 + 192; u += F.G) { att::Args a; if (u < 256) attn_c_args(F, l, u, a); else attn_b_args(F, u - 256, a); att::attn_band_unit(a, F.lds); }
}

__device__ void phase_ln1(const Frame& F, int l) {
    const bf16_t* yb = (const bf16_t*)(F.ws + WS_Z); const float* xin = l == 0 ? F.a->in[IN_X] : (const float*)(F.ws + WS_XCUR); bf16_t* x1 = (bf16_t*)(F.ws + WS_X1); unsigned char* h2 = F.ws + WS_H2; float* sh2 = (float*)(F.ws + WS_SH2);
    const float* g = F.a->in[IN_LN1G] + (size_t)l * DM; const float* bb = F.a->in[IN_LN1B] + (size_t)l * DM;
    const float* mod = (const float*)(F.ws + WS_MOD) + (size_t)l * NBATCH * MODW;
    LAS float* pl = (LAS float*)F.lds;
    for (int tt = F.bid * 32 + F.wid * 4; tt < NTOK; tt += F.G * 32) {
      {   const int bq = tt / SEQ, c = F.tid * 4;
          __syncthreads();
          *(LAS f32x4*)(pl + c) = *(const f32x4*)(g + c); *(LAS f32x4*)(pl + 2048 + c) = *(const f32x4*)(bb + c);
          *(LAS f32x4*)(pl + 4096 + c) = *(const f32x4*)(mod + (size_t)bq * MODW + 4 * DM + c) + 1.0f; *(LAS f32x4*)(pl + 6144 + c) = *(const f32x4*)(mod + (size_t)bq * MODW + 3 * DM + c);
          __syncthreads(); }
      for (int t = tt; t < tt + 4; ++t) {
        float v[4][8]; float s = 0.f;
#pragma unroll
        for (int i = 0; i < 4; ++i) { const size_t o = (size_t)t * DM + i * 512 + F.lane * 8; ld8f(xin + o, v[i]); const u32x4 yw = *(const u32x4*)(yb + o);
            const float yy[8] = {bf_lo(yw.x), bf_hi(yw.x), bf_lo(yw.y), bf_hi(yw.y), bf_lo(yw.z), bf_hi(yw.z), bf_lo(yw.w), bf_hi(yw.w)};
#pragma unroll
            for (int j = 0; j < 8; ++j) { v[i][j] = fmaf(ALPHA, v[i][j], yy[j]); s += v[i][j]; } }
        const float mean = wave_sum(s) * (1.0f / DM); float q = 0.f;
#pragma unroll
        for (int i = 0; i < 4; ++i)
#pragma unroll
            for (int j = 0; j < 8; ++j) { v[i][j] -= mean; q += v[i][j] * v[i][j]; }
        const float rstd = __builtin_amdgcn_rsqf(wave_sum(q) * (1.0f / DM) + LN_EPS);
        float hmax = 0.f;
#pragma unroll
        for (int i = 0; i < 4; ++i) { const int c = i * 512 + F.lane * 8; float gg[8], be[8], sh[8], sc[8];
            { const f32x4 a0 = *(const LAS f32x4*)(pl + c), a1 = *(const LAS f32x4*)(pl + c + 4), b0 = *(const LAS f32x4*)(pl + 2048 + c), b1 = *(const LAS f32x4*)(pl + 2048 + c + 4);
              const f32x4 c0 = *(const LAS f32x4*)(pl + 4096 + c), c1 = *(const LAS f32x4*)(pl + 4096 + c + 4), d0 = *(const LAS f32x4*)(pl + 6144 + c), d1 = *(const LAS f32x4*)(pl + 6144 + c + 4);
#pragma unroll
              for (int j = 0; j < 4; ++j) { gg[j] = a0[j]; gg[4 + j] = a1[j]; be[j] = b0[j]; be[4 + j] = b1[j]; sc[j] = c0[j]; sc[4 + j] = c1[j]; sh[j] = d0[j]; sh[4 + j] = d1[j]; } }
#pragma unroll
            for (int j = 0; j < 8; ++j) v[i][j] = fmaf(v[i][j] * rstd, gg[j], be[j]);
            *(u32x4*)(x1 + (size_t)t * DM + c) = pack8(v[i]);
#pragma unroll
            for (int j = 0; j < 8; ++j) { v[i][j] = fmaf(v[i][j], sc[j], sh[j]); hmax = fmaxf(hmax, fabsf(v[i][j])); } }
        hmax = wave_max(hmax); const float hs = hmax > 0.f ? hmax * (1.0f / 127.0f) : 1.0f, hi = 1.0f / hs;
#pragma unroll
        for (int i = 0; i < 4; ++i) *(u32x2*)(h2 + (size_t)t * DM + i * 512 + F.lane * 8) = (u32x2){pack4_u8(v[i][0] * hi, v[i][1] * hi, v[i][2] * hi, v[i][3] * hi) ^ 0x80808080u, pack4_u8(v[i][4] * hi, v[i][5] * hi, v[i][6] * hi, v[i][7] * hi) ^ 0x80808080u};
        if (F.lane == 0) sh2[t] = hs;
    }
    }
}

__device__ __forceinline__ unsigned row16_umax(unsigned x) { x = max(x, dppu<XOR1>(x)); x = max(x, dppu<XOR2>(x)); x = max(x, dppu<HMIR>(x)); x = max(x, dppu<MIR>(x)); return x; }
__device__ __forceinline__ unsigned fsort(float v) { const unsigned f = __float_as_uint(v); return (f & 0x80000000u) ? ~f : (f | 0x80000000u); }
__device__ __forceinline__ void topk_rows(const Frame& F, const float* rows, int pitch, int tok0, int h, int nit) {
    int* eidx = (int*)(F.ws + WS_EIDX); float* egate = (float*)(F.ws + WS_EGATE);
    const int lane = F.lane, row = lane >> 4, l15 = lane & 15, rbase = lane & 48;
#pragma unroll 1
    for (int it = 0; it < nit; ++it) {
        const int t0 = tok0 + it * 4;
        float sval[2]; int sidx[2];
#pragma unroll
        for (int ps = 0; ps < 2; ++ps) {
            const int tok = t0 + 2 * ps + (row >> 1), p = row & 1;
            const float* src = rows + (size_t)(tok - tok0) * pitch + p * 128;
            const f32x4 va = *(const f32x4*)(src + l15 * 8), vb = *(const f32x4*)(src + l15 * 8 + 4);
            unsigned k[8];
#pragma unroll
            for (int j = 0; j < 4; ++j) { k[j] = (fsort(va[j]) & ~127u) | (unsigned)(127 - (l15 * 8 + j)); k[4 + j] = (fsort(vb[j]) & ~127u) | (unsigned)(127 - (l15 * 8 + 4 + j)); }
#define CE(i, j) do { const unsigned hi_ = max(k[i], k[j]), lo_ = min(k[i], k[j]); k[i] = hi_; k[j] = lo_; } while (0)
            CE(0, 1); CE(2, 3); CE(4, 5); CE(6, 7); CE(0, 2); CE(1, 3); CE(4, 6); CE(5, 7); CE(1, 2); CE(5, 6);
            CE(0, 4); CE(1, 5); CE(2, 6); CE(3, 7); CE(2, 4); CE(3, 5); CE(1, 2); CE(3, 4); CE(5, 6);
#undef CE
            unsigned sel = 0u;
#pragma unroll
            for (int r = 0; r < 16; ++r) {
                const unsigned m = row16_umax(k[0]); const bool win = k[0] == m;
#pragma unroll
                for (int j = 0; j < 7; ++j) k[j] = win ? k[j + 1] : k[j];
                k[7] = win ? 0u : k[7];
                sel = l15 == r ? m : sel;
            }
            sidx[ps] = 127 - (int)(sel & 127u); sval[ps] = src[sidx[ps]];
        }
        const int srcx = ((row & 1) * 2) * 16 + l15, srcy = srcx + 16;
        const float xv0 = lperm(sval[0], srcx), xv1 = lperm(sval[1], srcx), yv0 = lperm(sval[0], srcy), yv1 = lperm(sval[1], srcy);
        const int xi0 = lperm(sidx[0], srcx), xi1 = lperm(sidx[1], srcx), yi0 = lperm(sidx[0], srcy), yi1 = lperm(sidx[1], srcy);
        const float v1 = row < 2 ? xv0 : xv1, yv = row < 2 ? yv0 : yv1; const int i1 = row < 2 ? xi0 : xi1, yi = row < 2 ? yi0 : yi1;
        const unsigned long long CI0 = 0x0c87654322110000ull, CJ0 = 0x000000004040c840ull, CCN = 0x0442223414444444ull;
        const int ci0 = (int)(CI0 >> (4 * l15)) & 15, cj0 = (int)(CJ0 >> (4 * l15)) & 15, ccn = (int)(CCN >> (4 * l15)) & 15; const bool ccol = l15 >= 13;
        unsigned kq[4];
#pragma unroll
        for (int q = 0; q < 4; ++q) { const int ii = ci0 + (ccol ? q : 0), jj = cj0 + (ccol ? 0 : q);
            const float sm = lperm(v1, rbase + ii) + lperm(yv, rbase + (jj & 15));
            kq[q] = q < ccn ? ((fsort(sm) & ~63u) | (unsigned)(l15 * 4 + q)) : 0u; }
#define CE4(i, j) do { const unsigned hi_ = max(kq[i], kq[j]), lo_ = min(kq[i], kq[j]); kq[i] = hi_; kq[j] = lo_; } while (0)
        CE4(0, 1); CE4(2, 3); CE4(0, 2); CE4(1, 3); CE4(1, 2);
#undef CE4
        unsigned rec = 0u;
#pragma unroll
        for (int r = 0; r < 16; ++r) {
            const unsigned m = row16_umax(kq[0]); const bool win = kq[0] == m;
            kq[0] = win ? kq[1] : kq[0]; kq[1] = win ? kq[2] : kq[1]; kq[2] = win ? kq[3] : kq[2]; kq[3] = win ? 0u : kq[3];
            rec = l15 == r ? m : rec;
        }
        const int wl = (int)(rec >> 2) & 15, wq = (int)rec & 3; const bool wcol = wl >= 13;
        const int wi = ((int)(CI0 >> (4 * wl)) & 15) + (wcol ? wq : 0), wj = ((int)(CJ0 >> (4 * wl)) & 15) + (wcol ? 0 : wq);
        const float rec_s = lperm(v1, rbase + wi) + lperm(yv, rbase + wj);
        const int rec_e = lperm(i1, rbase + wi) * 128 + lperm(yi, rbase + wj);
        float smax = rec_s; smax = fmaxf(smax, dppf<XOR1>(smax)); smax = fmaxf(smax, dppf<XOR2>(smax)); smax = fmaxf(smax, dppf<HMIR>(smax)); smax = fmaxf(smax, dppf<MIR>(smax));
        const float e = __builtin_amdgcn_exp2f((rec_s - smax) * LOG2E);
        const float tot = row16_sum(e);
        const size_t o = ((size_t)h * NTOK + (t0 + row)) * 16 + l15;
        eidx[o] = rec_e; egate[o] = e / tot;
    }
}

__device__ void topk_tile(const Frame& F, int pm, int h) {
    const int tok0 = pm * 256 + F.wid * 32;
    topk_rows(F, (const float*)(F.ws + WS_SC) + (size_t)tok0 * DM + h * 256, DM, tok0, h, 8);
}

__device__ void phase_pe(const Frame& F, int l) {
    const unsigned char* U4 = F.wl(l, WL_UB); const unsigned char* V4 = F.wl(l, WL_VB);
    const float* SU = (const float*)F.wl(l, WL_SU); const float* SV = (const float*)F.wl(l, WL_SV);
    const unsigned char* h2 = F.ws + WS_H2; const float* sh2 = (const float*)(F.ws + WS_SH2); const bf16_t* x1 = (const bf16_t*)(F.ws + WS_X1);
    const int* eidx = (const int*)(F.ws + WS_EIDX); const float* egate = (const float*)(F.ws + WS_EGATE);
    const float* mod = (const float*)(F.ws + WS_MOD) + (size_t)l * NBATCH * MODW;
    const float* modn = (const float*)(F.ws + WS_MOD) + (size_t)(l + 1) * NBATCH * MODW;
    const float* g = F.a->in[IN_LN2G] + (size_t)l * DM; const float* bb = F.a->in[IN_LN2B] + (size_t)l * DM;
    const bool last = (l == DEPTH - 1);
    float* xo = last ? F.a->out : (float*)(F.ws + WS_XCUR);
    const int lane = F.lane, l15 = lane & 15;
    LAS float* pl = (LAS float*)((LAS unsigned char*)F.lds + 16384);
    for (int tt = F.bid * 32 + F.wid * 4; tt < NTOK; tt += F.G * 32) {
      {   const int bq = tt / SEQ, c = F.tid * 4;
          __syncthreads();
          *(LAS f32x4*)(pl + c) = *(const f32x4*)(mod + (size_t)bq * MODW + 5 * DM + c) + 1.0f; *(LAS f32x4*)(pl + 2048 + c) = *(const f32x4*)(g + c); *(LAS f32x4*)(pl + 4096 + c) = *(const f32x4*)(bb + c);
          if (!last) { *(LAS f32x4*)(pl + 6144 + c) = *(const f32x4*)(modn + (size_t)bq * MODW + DM + c) + 1.0f; *(LAS f32x4*)(pl + 8192 + c) = *(const f32x4*)(modn + (size_t)bq * MODW + c); }
          __syncthreads(); }
      constexpr int NTK = 4;
      for (int t = tt; t < tt + 4; t += NTK) {
        __syncthreads();
        unsigned hq[NTK][8]; float sh[NTK]; int hsum[NTK];
        int e0[NTK], e1[NTK]; float g0[NTK], g1[NTK];
#pragma unroll
        for (int tk = 0; tk < NTK; ++tk) {
            sh[tk] = sh2[t + tk]; int hsE = 0, hsO = 0;
#pragma unroll
            for (int i = 0; i < 8; ++i) { hq[tk][i] = *(const unsigned*)(h2 + (size_t)(t + tk) * DM + i * 256 + lane * 4); if (i & 1) hsO = __builtin_amdgcn_sdot4((int)hq[tk][i], 0x01010101, hsO, false); else hsE = __builtin_amdgcn_sdot4((int)hq[tk][i], 0x01010101, hsE, false); }
            hsum[tk] = xrow_isum(row16_isum(8 * hsO - 120 * hsE));
            const size_t eo0 = ((size_t)(lane >> 4) * NTOK + (t + tk)) * 16 + l15, eo1 = eo0 + (size_t)4 * NTOK * 16;
            e0[tk] = eidx[eo0]; e1[tk] = eidx[eo1]; g0[tk] = egate[eo0]; g1[tk] = egate[eo1];
        }
#pragma unroll
        for (int tk = 0; tk < NTK; ++tk) {
            LAS unsigned* cnt = (LAS unsigned*)F.lds + F.wid * 512; LAS int* sid = (LAS int*)(cnt + 64); LAS float* sgt = (LAS float*)(cnt + 192);
            cnt[lane] = 0u;
            const int b0 = e0[tk] >> 8, b1 = e1[tk] >> 8;
            const unsigned p0 = __atomic_fetch_add(cnt + b0, 1u, __ATOMIC_RELAXED), p1 = __atomic_fetch_add(cnt + b1, 1u, __ATOMIC_RELAXED);
            const unsigned c = cnt[lane]; unsigned inc = c;
            inc += (unsigned)__builtin_amdgcn_update_dpp(0, (int)inc, 0x111, 0xf, 0xf, false); inc += (unsigned)__builtin_amdgcn_update_dpp(0, (int)inc, 0x112, 0xf, 0xf, false);
            inc += (unsigned)__builtin_amdgcn_update_dpp(0, (int)inc, 0x114, 0xf, 0xf, false); inc += (unsigned)__builtin_amdgcn_update_dpp(0, (int)inc, 0x118, 0xf, 0xf, false);
            inc += (unsigned)__builtin_amdgcn_update_dpp(0, (int)inc, 0x142, 0xa, 0xf, false); inc += (unsigned)__builtin_amdgcn_update_dpp(0, (int)inc, 0x143, 0xc, 0xf, false);
            cnt[lane] = inc - c;
            const unsigned d0 = cnt[b0] + p0, d1 = cnt[b1] + p1;
            sid[d0] = e0[tk]; sgt[d0] = g0[tk]; sid[d1] = e1[tk]; sgt[d1] = g1[tk];
            e0[tk] = sid[lane]; e1[tk] = sid[64 + lane]; g0[tk] = sgt[lane]; g1[tk] = sgt[64 + lane];
            asm volatile("s_waitcnt lgkmcnt(0)" ::: "memory");
        }
        int dA[NTK], dB[NTK]; float su0[NTK], su1[NTK], sv0[NTK], sv1[NTK];
#pragma unroll
        for (int tk = 0; tk < NTK; ++tk) { dA[tk] = 0; dB[tk] = 0; su0[tk] = SU[e0[tk]]; su1[tk] = SU[e1[tk]]; sv0[tk] = SV[e0[tk]]; sv1[tk] = SV[e1[tk]]; }
#pragma unroll 1
        for (int gi = 0; gi < 8; ++gi) {
#pragma unroll
          for (int tk = 0; tk < NTK; ++tk) {
            int stage = 0;
            u32x4 ub[16];
#pragma unroll
            for (int k = 0; k < 16; ++k) { const int slot = gi * 16 + k; const int e = __builtin_amdgcn_readlane(slot < 64 ? e0[tk] : e1[tk], slot & 63);
                ub[k] = *(const u32x4*)(U4 + (size_t)e * (DM / 2) + lane * 16); }
#pragma unroll
            for (int k = 0; k < 16; ++k) { int a0 = 0, a1 = 0; const unsigned w[4] = {ub[k].x, ub[k].y, ub[k].z, ub[k].w};
#pragma unroll
                for (int d = 0; d < 4; ++d) { a0 = __builtin_amdgcn_sdot4((int)(w[d] & 0x0F0F0F0Fu), (int)hq[tk][2 * d], a0, false); a1 = __builtin_amdgcn_sdot4((int)(w[d] & 0xF0F0F0F0u), (int)hq[tk][2 * d + 1], a1, false); }
                const int rs = row16_isum((a0 << 4) + a1);
                stage = (l15 == k) ? rs : stage; }
            const int dsum = xrow_isum(stage);
            const bool mine = (lane >> 4) == (gi & 3);
            if (gi < 4) dA[tk] = mine ? dsum : dA[tk]; else dB[tk] = mine ? dsum : dB[tk];
            asm volatile("" ::: "memory");
          }
        }
        LAS unsigned* cf = (LAS unsigned*)((LAS unsigned char*)F.lds + 57344 + F.wid * 1024);
#pragma unroll
        for (int tk = 0; tk < NTK; ++tk) {
            const float aA = g0[tk] * gelu_erf((float)(dA[tk] + hsum[tk]) * (0.0625f * su0[tk] * sh[tk])) * sv0[tk];
            const float aB = g1[tk] * gelu_erf((float)(dB[tk] + hsum[tk]) * (0.0625f * su1[tk] * sh[tk])) * sv1[tk];
            const float amx = wave_max(fmaxf(fabsf(aA), fabsf(aB)));
            const float sa_ = amx > 0.f ? amx * (1.0f / 127.0f) : 1.0f, sai = 1.0f / sa_;
            const int qA = (int)__builtin_rintf(aA * sai), qB = (int)__builtin_rintf(aB * sai);
            const int qsum_ = xrow_isum(row16_isum(qA + qB));
            const unsigned pkA_ = ((unsigned)dppu<0x00>((unsigned)qA) & 0xffu) | (((unsigned)dppu<0x55>((unsigned)qA) & 0xffu) << 8) | (((unsigned)dppu<0xAA>((unsigned)qA) & 0xffu) << 16) | ((unsigned)dppu<0xFF>((unsigned)qA) << 24);
            const unsigned pkB_ = ((unsigned)dppu<0x00>((unsigned)qB) & 0xffu) | (((unsigned)dppu<0x55>((unsigned)qB) & 0xffu) << 8) | (((unsigned)dppu<0xAA>((unsigned)qB) & 0xffu) << 16) | ((unsigned)dppu<0xFF>((unsigned)qB) << 24);
            if ((lane & 3) == 0) { cf[tk * 32 + (lane >> 2)] = pkA_; cf[tk * 32 + 16 + (lane >> 2)] = pkB_; }
            if (lane == 0) { cf[128 + tk] = __float_as_uint(sa_); cf[132 + tk] = (unsigned)qsum_; }
        }
        asm volatile("s_waitcnt lgkmcnt(0)" ::: "memory");
        {   constexpr int pr = 0;
        int yi[NTK][8][4];
#pragma unroll
        for (int tk = 0; tk < NTK; ++tk)
#pragma unroll
            for (int i = 0; i < 8; ++i)
#pragma unroll
                for (int j = 0; j < 4; ++j) yi[tk][i][j] = 0;
#pragma unroll 1
        for (int sb = 0; sb < 128; sb += 16) {
#pragma unroll
          for (int tk = 0; tk < NTK; ++tk) {
            u32x4 vb[16]; unsigned a4[4];
#pragma unroll
            for (int k = 0; k < 16; ++k) { const int slot = sb + k; const int e = __builtin_amdgcn_readlane(slot < 64 ? e0[pr + tk] : e1[pr + tk], slot & 63);
                vb[k] = *(const u32x4*)(V4 + (size_t)e * (DM / 2) + lane * 16); }
            { const u32x4 cq = *(const LAS u32x4*)(cf + (pr + tk) * 32 + (sb >> 2)); a4[0] = cq.x; a4[1] = cq.y; a4[2] = cq.z; a4[3] = cq.w; }
#pragma unroll
            for (int qd = 0; qd < 4; ++qd) {
#pragma unroll
                for (int d = 0; d < 4; ++d) {
                    const unsigned w1 = vb[4 * qd][d], w2 = vb[4 * qd + 1][d], w3 = vb[4 * qd + 2][d], w4 = vb[4 * qd + 3][d];
                    const unsigned p01 = __builtin_amdgcn_perm(w2, w1, 0x05010400u), p01h = __builtin_amdgcn_perm(w2, w1, 0x07030602u), p23 = __builtin_amdgcn_perm(w4, w3, 0x05010400u), p23h = __builtin_amdgcn_perm(w4, w3, 0x07030602u);
                    const unsigned t4[4] = {__builtin_amdgcn_perm(p23, p01, 0x05040100u), __builtin_amdgcn_perm(p23, p01, 0x07060302u), __builtin_amdgcn_perm(p23h, p01h, 0x05040100u), __builtin_amdgcn_perm(p23h, p01h, 0x07060302u)};
#pragma unroll
                    for (int j = 0; j < 4; ++j) {
                        yi[tk][2 * d][j] = __builtin_amdgcn_sdot4((int)(t4[j] & 0x0F0F0F0Fu), (int)a4[qd], yi[tk][2 * d][j], false);
                        yi[tk][2 * d + 1][j] = __builtin_amdgcn_sdot4((int)(t4[j] & 0xF0F0F0F0u), (int)a4[qd], yi[tk][2 * d + 1][j], false); }
                }
            }
            asm volatile("" ::: "memory");
          }
        }
#pragma unroll
        for (int tk = 0; tk < NTK; ++tk) {
        const int tq = t + pr + tk;
        float z[8][4]; float s = 0.f; const int qs_ = (int)cf[132 + pr + tk]; const float sa_ = __uint_as_float(cf[128 + pr + tk]); const int ybias = 15 * qs_; const float sah = 0.5f * sa_, sa16 = 0.0625f * sa_;
#pragma unroll
        for (int i = 0; i < 8; ++i) { const int c = i * 256 + lane * 4; const u32x2 xr = __builtin_nontemporal_load((const u32x2*)(x1 + (size_t)tq * DM + c)); const f32x4 xv = {bf_lo(xr.x), bf_hi(xr.x), bf_lo(xr.y), bf_hi(xr.y)}, gf1 = *(const LAS f32x4*)(pl + c);
#pragma unroll
            for (int j = 0; j < 4; ++j) { const float yy = (i & 1) ? sa16 * (float)(yi[tk][i][j] + 8 * qs_) : sah * (float)(2 * yi[tk][i][j] - ybias); const float zz = fmaf(ALPHA, xv[j], gf1[j] * yy); z[i][j] = zz; s += zz; } }
        const float mean = wave_sum(s) * (1.0f / DM); float qv = 0.f;
#pragma unroll
        for (int i = 0; i < 8; ++i)
#pragma unroll
            for (int j = 0; j < 4; ++j) { z[i][j] -= mean; qv += z[i][j] * z[i][j]; }
        const float rstd = __builtin_amdgcn_rsqf(wave_sum(qv) * (1.0f / DM) + LN_EPS);
        float hmax = 0.f;
#pragma unroll
        for (int i = 0; i < 8; ++i) { const int c = i * 256 + lane * 4; const f32x4 gg = *(const LAS f32x4*)(pl + 2048 + c), be = *(const LAS f32x4*)(pl + 4096 + c); f32x4 o4;
#pragma unroll
            for (int j = 0; j < 4; ++j) o4[j] = fmaf(z[i][j] * rstd, gg[j], be[j]);
            __builtin_nontemporal_store(o4, (f32x4*)(xo + (size_t)tq * DM + c));
            if (!last) { const f32x4 shv = *(const LAS f32x4*)(pl + 8192 + c), sc1 = *(const LAS f32x4*)(pl + 6144 + c);
#pragma unroll
                for (int j = 0; j < 4; ++j) { z[i][j] = fmaf(o4[j], sc1[j], shv[j]); hmax = fmaxf(hmax, fabsf(z[i][j])); } } }
        if (!last) {
            hmax = wave_max(hmax); const float hs = hmax > 0.f ? hmax * (1.0f / 6.0f) : 1.0f, hi = 1.0f / hs;
            unsigned char* hrow = F.ws + WS_H + (size_t)tq * (DM / 2);
#pragma unroll
            for (int i = 0; i < 8; ++i) *(unsigned short*)(hrow + i * 128 + lane * 2) = (unsigned short)(fp4_code(z[i][0] * hi) | (fp4_code(z[i][1] * hi) << 4) | (fp4_code(z[i][2] * hi) << 8) | (fp4_code(z[i][3] * hi) << 12));
            if (lane == 0) ((float*)(F.ws + WS_SH))[tq] = hs;
        }
        }
        }
    }
    }
}

constexpr int NPL = 7;
constexpr int N_PHASES = 1 + NPL * DEPTH;
__global__ void __launch_bounds__(NTHREADS, 2) mk_fwd(Args args) {
    extern __shared__ __attribute__((aligned(16))) unsigned char lds_raw[];
    Frame F; F.a = &args; F.ws = args.ws; F.lds = (char*)lds_raw; F.tid = threadIdx.x; F.lane = F.tid & 63; F.wid = __builtin_amdgcn_readfirstlane(F.tid >> 6); F.G = gridDim.x; F.bid = blockIdx.x;
    LAS unsigned char* ldsl = (LAS unsigned char*)lds_raw;
    volatile LAS unsigned* misc = (volatile LAS unsigned*)(ldsl + LDS_MISC);
    if (F.tid < 64) misc[F.tid] = 0u;
    __syncthreads();
    XcdBarrier bar; bar.bar = (unsigned*)(args.ws + WS_CTL); bar.x = 0; bar.st = misc;
    if (args.use_bar) bar = xcd_barrier_post((unsigned*)(args.ws + WS_CTL), misc);
    const int lo = args.ph_lo, hi = args.ph_hi;
#define REFRAME() do { int tz_ = threadIdx.x; asm volatile("" : "+v"(tz_)); F.tid = tz_; F.lane = tz_ & 63; F.wid = __builtin_amdgcn_readfirstlane(tz_ >> 6); } while (0)
#ifndef MK_PHMASK
#define MK_PHMASK 0x3ff
#endif
#define PHJ(j) ((MK_PHMASK >> (j)) & 1)
#ifndef MK_DUP
#define MK_DUP 0
#endif
#define DUPJ(j) ((MK_DUP >> (j)) & 1)
#define IN(k) (lo <= (k) && (k) < hi)
#define SEAM(k) do { if (args.use_bar && IN((k) + 1)) xcd_barrier(bar); } while (0)
    if (PHJ(0) && IN(0)) { REFRAME(); phase_c0(F); if (DUPJ(0)) { __syncthreads(); phase_c0(F); } SEAM(0); }
    for (int l = 0; l < DEPTH; ++l) {
        const int pb = 1 + NPL * l;
        if (PHJ(2) && IN(pb + 0)) {
            REFRAME();
            pg8::Gemm g{(const bf16_t*)(F.ws + WS_H), (const bf16_t*)F.wl(l, WL_WIN), DM / 4, DM / 4}; pg8::SchedG1 S; S.init(NTOK, INW, DM / 4, F.G, F.bid);
            pg8::EpiG1 E{(float*)(F.ws + WS_QKRAW), (bf16_t*)(F.ws + WS_QKVB), (unsigned char*)(F.ws + WS_GATES), (const float*)(F.ws + WS_SH), (const float*)F.wl(l, WL_SWIN)};
            pg8::gemm_phase(ldsl + LDS_RING, g, S, E); if (DUPJ(2)) pg8::gemm_phase(ldsl + LDS_RING, g, S, E);
            asm volatile("s_waitcnt vmcnt(0)" ::: "memory"); __syncthreads(); REFRAME();
            pg8::Unit u; for (int i = 0; S.next(i, u); ++i) if (u.pn < 5) norm_rope_tile(F, l, u.pm, u.pn);
            SEAM(pb + 0);
        }
        if (PHJ(3) && IN(pb + 1)) { REFRAME(); phase_att(F, l); if (DUPJ(3)) phase_att(F, l); SEAM(pb + 1); }
        if (PHJ(4) && IN(pb + 2)) {
            REFRAME();
            pg8::Gemm g{(const bf16_t*)(F.ws + WS_AO), (const bf16_t*)F.wl(l, WL_WP), AOW, AOW}; pg8::SchedSimple S; S.init(NTOK, DM, AOW, F.G, F.bid);
            pg8::EpiG2 E{(const unsigned char*)(F.ws + WS_GATES), (bf16_t*)(F.ws + WS_MERGED), (const float*)(F.ws + WS_LSEB), (float*)(F.lds + LDS_WTAB)};
            pg8::gemm_phase(ldsl + LDS_RING, g, S, E); if (DUPJ(5)) pg8::gemm_phase(ldsl + LDS_RING, g, S, E); SEAM(pb + 2);
        }
        if (PHJ(5) && IN(pb + 3)) {
            REFRAME();
            pg8::Gemm g{(const bf16_t*)(F.ws + WS_MERGED), (const bf16_t*)F.wl(l, WL_WO), DM, DM}; pg8::SchedSimple S; S.init(NTOK, DM, DM, F.G, F.bid);
            pg8::EpiG3 E{(const float*)(F.ws + WS_MOD) + (size_t)l * NBATCH * MODW + 2 * DM, (bf16_t*)(F.ws + WS_Z)};
            pg8::gemm_phase(ldsl + LDS_RING, g, S, E); if (DUPJ(6)) pg8::gemm_phase(ldsl + LDS_RING, g, S, E); SEAM(pb + 3);
        }
        if (PHJ(6) && IN(pb + 4)) { REFRAME(); phase_ln1(F, l); if (DUPJ(7)) phase_ln1(F, l); SEAM(pb + 4); }
        if (PHJ(7) && IN(pb + 5)) {
            REFRAME();
            pg8::Gemm g{(const bf16_t*)(F.ws + WS_H2), (const bf16_t*)F.wl(l, WL_WQK), DM / 2, DM / 2}; pg8::SchedSimple S; S.init(NTOK, DM, DM / 2, F.G, F.bid);
            pg8::EpiSC8 E{(float*)(F.ws + WS_SC), (const float*)(F.ws + WS_SH2), (const float*)F.wl(l, WL_SWQK), &F, (float*)F.lds};
            pg8::gemm_phase(ldsl + LDS_RING, g, S, E);
            asm volatile("s_waitcnt vmcnt(0)" ::: "memory"); __syncthreads(); REFRAME();
            pg8::Unit u, un; for (int i = 0; S.next(i, u); ++i) if (S.next(i + 1, un)) topk_tile(F, u.pm, u.pn);
            if (DUPJ(9)) { __syncthreads(); pg8::gemm_phase(ldsl + LDS_RING, g, S, E); }
            SEAM(pb + 5);
        }
        if (PHJ(8) && IN(pb + 6)) { REFRAME(); phase_pe(F, l); if (DUPJ(10)) phase_pe(F, l); SEAM(pb + 6); }
    }
#undef IN
#undef SEAM
}

extern "C" void kernel_launch(void* const* d_in, const int* in_sizes, int n_in, void* d_out, int out_size, void* d_ws, size_t ws_size, hipStream_t stream) {
    static int grid = 0;
    if (grid == 0) {
        if (n_in != 20 || out_size != NTOK * DM || ws_size < WS_END) { fprintf(stderr, "kernel_launch: unexpected shapes: n_in %d out %d ws %zu (need %zu)\n", n_in, out_size, ws_size, (size_t)WS_END); grid = -1; return; }
        int dev = 0, cus = 0, per_cu = 0;
        if (hipGetDevice(&dev) != hipSuccess || hipDeviceGetAttribute(&cus, hipDeviceAttributeMultiprocessorCount, dev) != hipSuccess) { grid = -1; return; }
        if (hipFuncSetAttribute((const void*)mk_fwd, hipFuncAttributeMaxDynamicSharedMemorySize, LDS_BYTES) != hipSuccess) { fprintf(stderr, "kernel_launch: hipFuncSetAttribute failed\n"); grid = -1; return; }
        if (hipOccupancyMaxActiveBlocksPerMultiprocessor(&per_cu, (const void*)mk_fwd, NTHREADS, LDS_BYTES) != hipSuccess || per_cu < 1) { fprintf(stderr, "kernel_launch: occupancy query reports %d\n", per_cu); (void)hipGetLastError(); }
        grid = cus;
    }
    if (grid < 0) return;
    (void)hipMemsetAsync((char*)d_ws + WS_CTL, 0, CTL_BYTES, stream);
    Args a{};
    for (int i = 0; i < 20; ++i) a.in[i] = (const float*)d_in[i];
    a.out = (float*)d_out; a.ws = (unsigned char*)d_ws; a.pad = 0;
#if MK_ONE_LAUNCH
    a.ph_lo = 0; a.ph_hi = N_PHASES; a.use_bar = 1;
    hipLaunchKernelGGL(mk_fwd, dim3(grid), dim3(NTHREADS), LDS_BYTES, stream, a);
#else
    for (int p = 0; p < N_PHASES; ++p) { a.ph_lo = p; a.ph_hi = p + 1; a.use_bar = 0; hipLaunchKernelGGL(mk_fwd, dim3(grid), dim3(NTHREADS), LDS_BYTES, stream, a); }
#endif
    const hipError_t le = hipPeekAtLastError();
    if (le != hipSuccess) fprintf(stderr, "kernel_launch: launch failed: %s\n", hipGetErrorName(le));
}
```

```cpp
#include <hip/hip_runtime.h>
#include <hip/hip_bf16.h>
#include <cstdio>
#include <cstdint>

#ifndef MK_ONE_LAUNCH
#define MK_ONE_LAUNCH 1
#endif

#define LAS __attribute__((address_space(3)))
typedef unsigned short bf16_t;
typedef short bf16x8 __attribute__((ext_vector_type(8)));
typedef short s16x4 __attribute__((ext_vector_type(4)));
typedef float f32x2 __attribute__((ext_vector_type(2)));
typedef float f32x4 __attribute__((ext_vector_type(4)));
typedef float f32x16 __attribute__((ext_vector_type(16)));
typedef unsigned u32x2 __attribute__((ext_vector_type(2)));
typedef unsigned u32x4 __attribute__((ext_vector_type(4)));
typedef __bf16 bf16x2v __attribute__((ext_vector_type(2)));
typedef int i32x4 __attribute__((ext_vector_type(4)));
typedef int i32x8 __attribute__((ext_vector_type(8)));

constexpr int DM = 2048, NBATCH = 2, SEQ = 4096, NTOK = NBATCH * SEQ, DEPTH = 2, HD = 128;
constexpr int INW = 11520, QKVW = 5376, GLW = 6144, QKRAWW = 1280, AOW = 2816, MODW = 6 * DM;
constexpr int COL_QA = 0, COL_KA = 1024, COL_VA = 1280, COL_QB = 1536, COL_KB = 2304, COL_VB = 3072, COL_QC = 3840, COL_KC = 4864, COL_VC = 5120;
constexpr int AO_A = 0, AO_B = 1024, AO_C = 1792;
constexpr int NEXP = 16384, PEER_HK = 128;
constexpr float LN_EPS = 1e-5f, QK_EPS = 1e-6f, ALPHA = 1.4142135623730951f, LOG2E = 1.4426950408889634f, LN2 = 0.6931471805599453f;
constexpr int NTHREADS = 512, NWAVES = 8;

constexpr size_t al256(size_t x) { return (x + 255) / 256 * 256; }
constexpr size_t WS_CTL = 0;
constexpr size_t CTL_BYTES = 65536;
constexpr size_t WS_MOD = WS_CTL + CTL_BYTES;
constexpr size_t WS_ROPE = WS_MOD + al256((size_t)DEPTH * NBATCH * MODW * 4);
constexpr size_t WS_LSEB = WS_ROPE + 64 * 32 * 2 * 4;
constexpr size_t WS_W0 = WS_LSEB + (size_t)NTOK * 8 * 4;
constexpr size_t WL_WIN = 0;
constexpr size_t WL_SWIN = WL_WIN + (size_t)INW * DM / 2;
constexpr size_t WL_WP = WL_SWIN + al256((size_t)INW * 4);
constexpr size_t WL_WO = WL_WP + (size_t)DM * AOW * 2;
constexpr size_t WL_WQK = WL_WO + (size_t)DM * DM * 2;
constexpr size_t WL_SWQK = WL_WQK + (size_t)DM * DM;
constexpr size_t WL_UB = WL_SWQK + (size_t)DM * 4;
constexpr size_t WL_VB = WL_UB + (size_t)NEXP * DM / 2;
constexpr size_t WL_SU = WL_VB + (size_t)NEXP * DM / 2;
constexpr size_t WL_SV = WL_SU + (size_t)NEXP * 4;
constexpr size_t WL_BYTES = WL_SV + (size_t)NEXP * 4;
constexpr size_t WS_H = WS_W0 + DEPTH * WL_BYTES;
constexpr size_t WS_SH = WS_H + (size_t)NTOK * DM / 2;
constexpr size_t WS_H2 = WS_SH + (size_t)NTOK * 4;
constexpr size_t WS_SH2 = WS_H2 + (size_t)NTOK * DM;
constexpr size_t WS_QKVB = WS_SH2 + (size_t)NTOK * 4;
constexpr size_t WS_QKRAW = WS_QKVB + (size_t)NTOK * QKVW * 2;
constexpr size_t WS_GATES = WS_QKRAW + (size_t)NTOK * QKRAWW * 4;
constexpr size_t WS_SC = WS_GATES;
constexpr size_t WS_AO = WS_GATES + (size_t)NTOK * GLW * 2;
constexpr size_t WS_MTMP = WS_AO + (size_t)NTOK * AOW * 2;
constexpr size_t WS_Z = WS_MTMP;
constexpr size_t WS_MERGED = WS_MTMP + (size_t)NTOK * DM * 4;
constexpr size_t WS_X1 = WS_MERGED + (size_t)NTOK * DM * 2;
constexpr size_t WS_XCUR = WS_X1 + (size_t)NTOK * DM * 4;
constexpr size_t WS_EIDX = WS_XCUR + (size_t)NTOK * DM * 4;
constexpr size_t WS_EGATE = WS_EIDX + (size_t)NTOK * 128 * 4;
constexpr size_t WS_END = WS_EGATE + (size_t)NTOK * 128 * 4;
static_assert(WS_SC + (size_t)NTOK * DM * 4 <= WS_AO, "SC alias must fit in GATES");

__device__ __forceinline__ unsigned cvtpk(float lo, float hi) { return __builtin_bit_cast(unsigned, __builtin_convertvector((f32x2){lo, hi}, bf16x2v)); }
__device__ __forceinline__ float bf_lo(unsigned w) { return __uint_as_float(w << 16); }
__device__ __forceinline__ float bf_hi(unsigned w) { return __uint_as_float(w & 0xffff0000u); }
__device__ __forceinline__ float dot2(unsigned a, unsigned b, float acc) { return __builtin_amdgcn_fdot2_f32_bf16(__builtin_bit_cast(bf16x2v, a), __builtin_bit_cast(bf16x2v, b), acc, false); }
template <int CTRL> __device__ __forceinline__ float dppf(float x) { return __builtin_bit_cast(float, __builtin_amdgcn_mov_dpp(__builtin_bit_cast(int, x), CTRL, 0xf, 0xf, true)); }
template <int CTRL> __device__ __forceinline__ unsigned dppu(unsigned x) { return (unsigned)__builtin_amdgcn_mov_dpp((int)x, CTRL, 0xf, 0xf, true); }
constexpr int XOR1 = 0xB1, XOR2 = 0x4E, HMIR = 0x141, MIR = 0x140;
__device__ __forceinline__ float row16_sum(float x) { x += dppf<XOR1>(x); x += dppf<XOR2>(x); x += dppf<HMIR>(x); x += dppf<MIR>(x); return x; }
__device__ __forceinline__ float xrow_sum(float x) {
    auto s = __builtin_amdgcn_permlane16_swap(__float_as_uint(x), __float_as_uint(x), false, false);
    x = __uint_as_float(s[0]) + __uint_as_float(s[1]);
    auto t = __builtin_amdgcn_permlane32_swap(__float_as_uint(x), __float_as_uint(x), false, false);
    return __uint_as_float(t[0]) + __uint_as_float(t[1]);
}
__device__ __forceinline__ float wave_sum(float x) { return xrow_sum(row16_sum(x)); }
__device__ __forceinline__ int lperm(int v, int src) { return __builtin_amdgcn_ds_bpermute(src << 2, v); }
__device__ __forceinline__ unsigned lperm(unsigned v, int src) { return (unsigned)__builtin_amdgcn_ds_bpermute(src << 2, (int)v); }
__device__ __forceinline__ float lperm(float v, int src) { return __int_as_float(__builtin_amdgcn_ds_bpermute(src << 2, __float_as_int(v))); }
__device__ __forceinline__ float wave_max(float x) {
    x = fmaxf(x, dppf<XOR1>(x)); x = fmaxf(x, dppf<XOR2>(x)); x = fmaxf(x, dppf<HMIR>(x)); x = fmaxf(x, dppf<MIR>(x));
    auto s = __builtin_amdgcn_permlane16_swap(__float_as_uint(x), __float_as_uint(x), false, false); x = fmaxf(__uint_as_float(s[0]), __uint_as_float(s[1]));
    auto t = __builtin_amdgcn_permlane32_swap(__float_as_uint(x), __float_as_uint(x), false, false); return fmaxf(__uint_as_float(t[0]), __uint_as_float(t[1]));
}
__device__ __forceinline__ int row16_isum(int x) { x += (int)dppu<XOR1>((unsigned)x); x += (int)dppu<XOR2>((unsigned)x); x += (int)dppu<HMIR>((unsigned)x); x += (int)dppu<MIR>((unsigned)x); return x; }
__device__ __forceinline__ int xrow_isum(int x) {
    auto s = __builtin_amdgcn_permlane16_swap((unsigned)x, (unsigned)x, false, false); x = (int)s[0] + (int)s[1];
    auto t = __builtin_amdgcn_permlane32_swap((unsigned)x, (unsigned)x, false, false); return (int)t[0] + (int)t[1];
}
__device__ __forceinline__ unsigned pack4_raw(float a, float b, float c, float d) {
    unsigned w = __builtin_amdgcn_cvt_pk_u8_f32(a, 0, 0u); w = __builtin_amdgcn_cvt_pk_u8_f32(b, 1, w); w = __builtin_amdgcn_cvt_pk_u8_f32(c, 2, w); return __builtin_amdgcn_cvt_pk_u8_f32(d, 3, w);
}
__device__ __forceinline__ unsigned pack4_u8(float a, float b, float c, float d) {
    unsigned w = __builtin_amdgcn_cvt_pk_u8_f32(__builtin_rintf(a + 128.f), 0, 0u); w = __builtin_amdgcn_cvt_pk_u8_f32(__builtin_rintf(b + 128.f), 1, w);
    w = __builtin_amdgcn_cvt_pk_u8_f32(__builtin_rintf(c + 128.f), 2, w); return __builtin_amdgcn_cvt_pk_u8_f32(__builtin_rintf(d + 128.f), 3, w);
}
__device__ __forceinline__ float gelu_erf(float v) {
    const float av = fabsf(v), t = __builtin_amdgcn_rcpf(fmaf(av, 0.2316418882f, 1.0f));
    float q = fmaf(t, 0.5307027145f, -0.7265760135f); q = fmaf(q, t, 0.7107068705f); q = fmaf(q, t, -0.142248368f); q = fmaf(q, t, 0.127414796f); q = q * t;
    const float e = __builtin_amdgcn_exp2f(v * v * -0.72134752044f);
    const float m = v * (q * e);
    return v < 0.f ? m : v - m;
}
__device__ __forceinline__ void ld8f(const float* p, float (&v)[8]) { const f32x4 a = *(const f32x4*)p, b = *(const f32x4*)(p + 4); v[0] = a[0]; v[1] = a[1]; v[2] = a[2]; v[3] = a[3]; v[4] = b[0]; v[5] = b[1]; v[6] = b[2]; v[7] = b[3]; }
__device__ __forceinline__ void st8f(float* p, const float (&v)[8]) { *(f32x4*)p = (f32x4){v[0], v[1], v[2], v[3]}; *(f32x4*)(p + 4) = (f32x4){v[4], v[5], v[6], v[7]}; }
__device__ __forceinline__ u32x4 pack8(const float (&v)[8]) { return (u32x4){cvtpk(v[0], v[1]), cvtpk(v[2], v[3]), cvtpk(v[4], v[5]), cvtpk(v[6], v[7])}; }

#define XB_TMO      128
#define XB_XCNT(j)  (256  + 64 * (j))
#define XB_XSUB(j)  (1280 + 64 * (j))
#define XB_XGEN(j)  (2304 + 64 * (j))
#define XB_TOP      3328
#define XB_TOPGEN   3392
#define XCD_BAR_WORDS 3456
#define XB_MODCNT   3520
#define XB_SPIN_CAP (1u << 22)
__device__ __forceinline__ unsigned xb_ld(unsigned* p)              { return __hip_atomic_load(p, __ATOMIC_RELAXED, __HIP_MEMORY_SCOPE_AGENT); }
__device__ __forceinline__ unsigned xb_add(unsigned* p, unsigned v) { return __hip_atomic_fetch_add(p, v, __ATOMIC_RELAXED, __HIP_MEMORY_SCOPE_AGENT); }
__device__ __forceinline__ unsigned xb_xcc_id() { return (unsigned)__builtin_amdgcn_s_getreg((3 << 11) | 20) & 0xFu; }
#define XB_SPIN(cond, bar) do { unsigned _sp = 0; while (cond) { __builtin_amdgcn_s_sleep(1); \
    if ((++_sp & 255u) == 0u) { if (xb_ld(&(bar)[XB_TMO])) break; if (_sp > XB_SPIN_CAP) { atomicAdd(&(bar)[XB_TMO], 1u); break; } } } } while (0)
struct XcdBarrier { unsigned* bar; unsigned x; volatile LAS unsigned* st; };
__device__ __forceinline__ XcdBarrier xcd_barrier_post(unsigned* bar, volatile LAS unsigned* st) {
    XcdBarrier b; b.bar = bar; b.x = xb_xcc_id(); b.st = st;
    if (threadIdx.x == 0) (void)xb_add(&bar[XB_XCNT(b.x)], 1u);
    return b;
}
__device__ __forceinline__ void xcd_barrier_complete(unsigned* bar, unsigned x, unsigned& nloc, unsigned& nx) {
    const unsigned G = gridDim.x * gridDim.y * gridDim.z;
    unsigned sum, cnt, mine, sp = 0u;
    for (;;) {
        sum = 0u; cnt = 0u; mine = 0u;
#pragma unroll
        for (unsigned j = 0; j < 16; ++j) { const unsigned c = xb_ld(&bar[XB_XCNT(j)]); sum += c; cnt += (c > 0u) ? 1u : 0u; mine = (j == x) ? c : mine; }
        if (sum == G) break;
        __builtin_amdgcn_s_sleep(1);
        if ((++sp & 255u) == 0u) { if (xb_ld(&bar[XB_TMO])) break; if (sp > XB_SPIN_CAP) { atomicAdd(&bar[XB_TMO], 1u); break; } }
    }
    nloc = mine > 0u ? mine : 1u; nx = cnt > 0u ? cnt : 1u;
}
__device__ __forceinline__ void xcd_barrier(const XcdBarrier& b) {
    asm volatile("s_waitcnt vmcnt(0)" ::: "memory");
    __syncthreads();
    if (threadIdx.x == 0) {
        unsigned* bar = b.bar;
        __builtin_amdgcn_s_waitcnt(0);
        unsigned nloc = b.st[0], nx = b.st[1];
        if (nloc == 0u) { xcd_barrier_complete(bar, b.x, nloc, nx); b.st[0] = nloc; b.st[1] = nx; }
        const unsigned old = xb_add(&bar[XB_XSUB(b.x)], 1u);
        const unsigned gen = old / nloc;
        if (old + 1u == (gen + 1u) * nloc) {
            __builtin_amdgcn_fence(__ATOMIC_RELEASE, "agent");
            asm volatile("s_waitcnt vmcnt(0)" ::: "memory");
            const unsigned og = xb_add(&bar[XB_TOP], 1u);
            const unsigned tg = og / nx;
            if (og + 1u == (tg + 1u) * nx) xb_add(&bar[XB_TOPGEN], 1u);
            else XB_SPIN(xb_ld(&bar[XB_TOPGEN]) == tg, bar);
            __builtin_amdgcn_fence(__ATOMIC_ACQUIRE, "agent");
            xb_add(&bar[XB_XGEN(b.x)], 1u);
            asm volatile("s_waitcnt vmcnt(0)" ::: "memory");
        } else {
            XB_SPIN(xb_ld(&bar[XB_XGEN(b.x)]) == gen, bar);
            __builtin_amdgcn_fence(__ATOMIC_ACQUIRE, "agent");
            asm volatile("s_waitcnt vmcnt(0)" ::: "memory");
        }
    }
    __syncthreads();
}

struct Frame;
__device__ __forceinline__ void topk_rows(const Frame& F, const float* rows, int pitch, int tok0, int h, int nit);
namespace pg8 {
constexpr int BM = 256, BK = 64, HALF = 128, HTB = HALF * BK * 2, STAGE_BYTES = 8 * HTB, NXCD = 8, WGM = 8;
__host__ __device__ __forceinline__ int lds_byte(int r, int c) { const int st = (r >> 4) * 2 + (c >> 5), rr = r & 15, cc = c & 31, ob = rr * 64 + cc * 2; return st * 1024 + (ob ^ (((ob >> 9) & 1) << 5)); }
__host__ __device__ __forceinline__ void stage_rc(int b, int& R, int& C) { const int st = b / 1024, sb = b % 1024, swz = sb ^ (((sb >> 9) & 1) << 5); R = (st >> 1) * 16 + swz / 64; C = (st & 1) * 32 + (swz % 64) / 2; }
__host__ __device__ __forceinline__ int perm32(int rho) { const int n = rho >> 4, i = rho & 15; return 8 * (i >> 2) + 4 * n + (i & 3); }
struct Unit { int pm, pn, koff, nt, aux; };
struct Gemm { const bf16_t* A; const bf16_t* Bt; int lda, ldb; };
struct TileOrder {
    int nM, nN, nwg;
    __device__ void init(int M, int N) { nM = M / BM; nN = N / BM; nwg = nM * nN; }
    __device__ bool tile(long L, int& pm, int& pn) const {
        if (L >= nwg) return false;
        int wgid = (int)L; { const int q = nwg / NXCD, r = nwg % NXCD, xcd = wgid % NXCD, off = wgid / NXCD; wgid = (xcd < r ? xcd * (q + 1) : r * (q + 1) + (xcd - r) * q) + off; }
        const int nig = WGM * nN, gid = wgid / nig, fm = gid * WGM, gsz = (nM - fm) < WGM ? (nM - fm) : WGM;
        pm = fm + ((wgid % nig) % gsz); pn = (wgid % nig) / gsz; return true;
    }
};
struct SchedSimple {
    TileOrder T; int G, c, nt;
    __device__ void init(int M, int N, int K, int G_, int c_) { T.init(M, N); G = G_; c = c_; nt = K / BK; }
    __device__ bool next(int i, Unit& u) const { if (!T.tile((long)i * G + c, u.pm, u.pn)) return false; u.koff = 0; u.nt = nt; u.aux = 0; return true; }
};
struct SchedG1 {
    SchedSimple S0; int x, j; bool bal;
    __device__ void init(int M, int N, int K, int G_, int c_) { S0.init(M, N, K, G_, c_); bal = (G_ == 256 && M == 32 * BM && N == 45 * BM); x = c_ & 7; j = c_ >> 3; }
    __device__ bool next(int i, Unit& u) const {
        if (!bal) return S0.next(i, u);
        int o;
        if (j < 20) { if (i >= 6) return false; o = i * 20 + j; }
        else { const int jb = j - 20, no = jb < 4 ? 4 : 3;
            if (i >= 5) return false;
            o = i < no ? 120 + i * 12 + jb : 160 + (jb < 4 ? jb : 4 + (jb - 4) * 2 + (i - no)); }
        if (o < 160) { u.pn = 5 + (o >> 2); u.pm = 4 * x + (o & 3); } else { u.pn = (o - 160) >> 2; u.pm = 4 * x + ((o - 160) & 3); }
        u.koff = 0; u.nt = S0.nt; u.aux = 0; return true;
    }
};
template <class Epi, class Sched>
__device__ __forceinline__ void gemm_phase(LAS unsigned char* lds, const Gemm g, const Sched& S, const Epi& E) {
    int tid = threadIdx.x; asm volatile("" : "+v"(tid));
    const int wid = __builtin_amdgcn_readfirstlane(tid >> 6), lane = tid & 63, wr = wid >> 2, wc = wid & 3, fr = lane & 15, fq = lane >> 4;
    unsigned voffA[2], voffB[2];
#pragma unroll
    for (int i = 0; i < 2; ++i) { int R, C; stage_rc(tid * 16 + i * 8192, R, C); const int Rb = Epi::PERM ? ((R & ~31) + perm32(R & 31)) : R;
        voffA[i] = (unsigned)(R * g.lda + C) * 2u; voffB[i] = (unsigned)(Rb * g.ldb + C) * 2u; }
    const size_t kstep = (size_t)(BK * 2);
    const size_t hstepA = (size_t)HALF * g.lda * 2, hstepB = (size_t)HALF * g.ldb * 2;
    const unsigned ldsw = (unsigned)wid * 1024u;
    const int aoff = lds_byte(wr * 64 + fr, fq * 8), boff = lds_byte(wc * 32 + fr, fq * 8);
#define PG8_SA(b, h) (((b) * 2 + (h)) * HTB)
#define PG8_SB(b, h) ((4 + (b) * 2 + (h)) * HTB)
#define PG8_STAGE(bufoff, gbase, voff) do { _Pragma("unroll") for (int _i = 0; _i < 2; ++_i) \
        __builtin_amdgcn_global_load_lds((const unsigned*)((const char*)(gbase) + (voff)[_i]), (LAS unsigned*)(lds + (bufoff) + ldsw + _i * 8192), 16, 0, 0); } while (0)
#define PG8_LDA(dst, b, h) do { _Pragma("unroll") for (int m = 0; m < 4; ++m) _Pragma("unroll") for (int k = 0; k < 2; ++k) dst[m][k] = *(const LAS bf16x8*)(lds + PG8_SA(b, h) + aoff + m * 2048 + k * 1024); } while (0)
#define PG8_LDB(dst, b, h) do { _Pragma("unroll") for (int n = 0; n < 2; ++n) _Pragma("unroll") for (int k = 0; k < 2; ++k) dst[n][k] = *(const LAS bf16x8*)(lds + PG8_SB(b, h) + boff + n * 2048 + k * 1024); } while (0)
#define PG8_MMA(ai, bj, At, Bt) do { __builtin_amdgcn_s_setprio(1); _Pragma("unroll") for (int m = 0; m < 4; ++m) _Pragma("unroll") for (int n = 0; n < 2; ++n) _Pragma("unroll") for (int k = 0; k < 2; ++k) \
        acc[ai][bj][m][n] = Epi::mma(Bt[n][k], At[m][k], acc[ai][bj][m][n]); __builtin_amdgcn_s_setprio(0); } while (0)
#define PG8_WAIT_V(n) asm volatile("s_waitcnt vmcnt(" #n ")" ::: "memory")
#define PG8_WAIT_L(n) asm volatile("s_waitcnt lgkmcnt(" #n ")" ::: "memory")
#define PG8_BAR __builtin_amdgcn_s_barrier()
#define PG8_SCHED __builtin_amdgcn_sched_barrier(0)
    Unit cur, nxt; int ui = 0;
    if (!S.next(0, cur)) return;
    typedef typename Epi::acc_t acc_t;
    acc_t acc[2][2][4][2];
#pragma unroll
    for (int a = 0; a < 2; ++a)
#pragma unroll
        for (int b = 0; b < 2; ++b)
#pragma unroll
            for (int m = 0; m < 4; ++m)
#pragma unroll
                for (int n = 0; n < 2; ++n) acc[a][b][m][n] = (acc_t){0, 0, 0, 0};
    bf16x8 At[4][2], B0[2][2], B1[2][2];
    const char* cA = (const char*)g.A + ((size_t)cur.pm * BM * g.lda + cur.koff) * 2; const char* cB = (const char*)g.Bt + ((size_t)cur.pn * BM * g.ldb + cur.koff) * 2;
    PG8_STAGE(PG8_SB(0, 0), cB, voffB); PG8_STAGE(PG8_SA(0, 0), cA, voffA); PG8_STAGE(PG8_SB(0, 1), cB + hstepB, voffB); PG8_STAGE(PG8_SA(0, 1), cA + hstepA, voffA);
    if (wr == 1) PG8_BAR;
    PG8_WAIT_V(4); PG8_BAR;
    PG8_STAGE(PG8_SB(1, 0), cB + kstep, voffB); PG8_STAGE(PG8_SA(1, 0), cA + kstep, voffA); PG8_STAGE(PG8_SB(1, 1), cB + hstepB + kstep, voffB);
    PG8_WAIT_V(6); PG8_BAR;
    for (;;) {
        const bool has_next = S.next(ui + 1, nxt);
        const char* nA = has_next ? (const char*)g.A + ((size_t)nxt.pm * BM * g.lda + nxt.koff) * 2 : cA; const char* nB = has_next ? (const char*)g.Bt + ((size_t)nxt.pn * BM * g.ldb + nxt.koff) * 2 : cB;
        const int nt = cur.nt;
        for (int t = 0; t < nt; t += 2) {
            if constexpr (Epi::HAS_MID) { if (E.mid_at(t)) E.mid(acc, cur, t, wr, wc, fr, fq); }
            const bool last = (t == nt - 2);
            const char* a1 = cA + (size_t)(t + 1) * kstep;
            const char* a2 = last ? nA : cA + (size_t)(t + 2) * kstep; const char* b2 = last ? nB : cB + (size_t)(t + 2) * kstep;
            const char* a3 = a2 + kstep; const char* b3 = b2 + kstep;
            PG8_LDB(B0, 0, 0); PG8_SCHED; PG8_LDA(At, 0, 0); PG8_STAGE(PG8_SA(1, 1), a1 + hstepA, voffA);
            PG8_WAIT_L(8); PG8_BAR; PG8_WAIT_L(0); PG8_MMA(0, 0, At, B0); PG8_BAR; PG8_SCHED;
            PG8_LDB(B1, 0, 1); PG8_STAGE(PG8_SB(0, 0), b2, voffB);
            PG8_BAR; PG8_WAIT_L(0); PG8_MMA(0, 1, At, B1); PG8_BAR;
            PG8_LDA(At, 0, 1); PG8_STAGE(PG8_SA(0, 0), a2, voffA);
            PG8_BAR; PG8_WAIT_L(0); PG8_MMA(1, 0, At, B0); PG8_BAR; PG8_SCHED;
            PG8_STAGE(PG8_SB(0, 1), b2 + hstepB, voffB);
            PG8_WAIT_V(6); PG8_BAR; PG8_MMA(1, 1, At, B1); PG8_BAR;
            PG8_LDB(B0, 1, 0); PG8_SCHED; PG8_LDA(At, 1, 0); PG8_STAGE(PG8_SA(0, 1), a2 + hstepA, voffA);
            PG8_WAIT_L(8); PG8_BAR; PG8_WAIT_L(0); PG8_MMA(0, 0, At, B0); PG8_BAR; PG8_SCHED;
            PG8_LDB(B1, 1, 1); PG8_STAGE(PG8_SB(1, 0), b3, voffB);
            PG8_BAR; PG8_WAIT_L(0); PG8_MMA(0, 1, At, B1); PG8_BAR;
            PG8_LDA(At, 1, 1); PG8_STAGE(PG8_SA(1, 0), a3, voffA);
            PG8_BAR; PG8_WAIT_L(0); PG8_MMA(1, 0, At, B0); PG8_BAR; PG8_SCHED;
            PG8_STAGE(PG8_SB(1, 1), b3 + hstepB, voffB);
            PG8_WAIT_V(6); PG8_BAR; PG8_MMA(1, 1, At, B1); PG8_BAR;
        }
        if constexpr (Epi::AFTER_DRAIN) { if (has_next) E(acc, cur, wr, wc, fr, fq); } else E(acc, cur, wr, wc, fr, fq);
        if (!has_next) break;
#pragma unroll
        for (int a = 0; a < 2; ++a)
#pragma unroll
            for (int b = 0; b < 2; ++b)
#pragma unroll
                for (int m = 0; m < 4; ++m)
#pragma unroll
                    for (int n = 0; n < 2; ++n) acc[a][b][m][n] = (acc_t){0, 0, 0, 0};
        cur = nxt; cA = nA; cB = nB; ++ui;
    }
    PG8_WAIT_V(0);
    if (wr == 0) PG8_BAR;
    PG8_BAR;
    if constexpr (Epi::AFTER_DRAIN) E.fused(acc, cur, wr, wc, fr, fq);
#undef PG8_SA
#undef PG8_SB
#undef PG8_STAGE
#undef PG8_LDA
#undef PG8_LDB
#undef PG8_MMA
#undef PG8_WAIT_V
#undef PG8_WAIT_L
#undef PG8_BAR
#undef PG8_SCHED
}

struct EpiG1 {
    static constexpr bool PERM = true; static constexpr bool HAS_MID = false; static constexpr bool AFTER_DRAIN = false;
    typedef f32x4 acc_t;
    static __device__ __forceinline__ f32x4 mma(bf16x8 b, bf16x8 a, f32x4 c) {
        const i32x4 bb = __builtin_bit_cast(i32x4, b), aa = __builtin_bit_cast(i32x4, a);
        const i32x8 B8 = {bb[0], bb[1], bb[2], bb[3], 0, 0, 0, 0}, A8 = {aa[0], aa[1], aa[2], aa[3], 0, 0, 0, 0};
        return __builtin_amdgcn_mfma_scale_f32_16x16x128_f8f6f4(B8, A8, c, 4, 4, 0, 0x7F7F7F7F, 0, 0x7F7F7F7F);
    }
    float* qkraw; bf16_t* qkvb; unsigned char* gates; const float* sh; const float* sw;
    __device__ __forceinline__ void operator()(const f32x4 (&acc)[2][2][4][2], const Unit& u, int wr, int wc, int fr, int fq) const {
        const int row0 = u.pm * BM + wr * 64 + fr, colt = wc * 32 + 8 * fq, pn = u.pn;
        f32x4 cw[2][2];
#pragma unroll
        for (int bj = 0; bj < 2; ++bj) { cw[bj][0] = *(const f32x4*)(sw + pn * BM + bj * HALF + colt); cw[bj][1] = *(const f32x4*)(sw + pn * BM + bj * HALF + colt + 4); }
        f32x4 cwl[2][2];
#pragma unroll
        for (int bj = 0; bj < 2; ++bj) { cwl[bj][0] = cw[bj][0] * -LOG2E; cwl[bj][1] = cw[bj][1] * -LOG2E; }
#pragma unroll
        for (int ai = 0; ai < 2; ++ai)
#pragma unroll
            for (int m = 0; m < 4; ++m) {
                const size_t row = (size_t)(row0 + ai * HALF + m * 16);
                const float rs = sh[row];
                if (pn >= 21) {
                    unsigned w[4];
#pragma unroll
                    for (int bj = 0; bj < 2; ++bj) { const f32x4 v0 = acc[ai][bj][m][0] * cwl[bj][0] * rs, v1 = acc[ai][bj][m][1] * cwl[bj][1] * rs; float sg[8];
#pragma unroll
                        for (int j = 0; j < 4; ++j) { sg[j] = __builtin_rintf(__builtin_amdgcn_rcpf(fmaf(__builtin_amdgcn_exp2f(v0[j]), 1.0f / 255.0f, 1.0f / 255.0f))); sg[4 + j] = __builtin_rintf(__builtin_amdgcn_rcpf(fmaf(__builtin_amdgcn_exp2f(v1[j]), 1.0f / 255.0f, 1.0f / 255.0f))); }
                        w[2 * bj] = pack4_raw(sg[0], sg[1], sg[2], sg[3]); w[2 * bj + 1] = pack4_raw(sg[4], sg[5], sg[6], sg[7]); }
                    *(u32x4*)(gates + row * GLW + (pn - 21) * BM + (wc * 4 + fq) * 16) = (u32x4){w[0], w[1], w[2], w[3]};
                } else {
#pragma unroll
                for (int bj = 0; bj < 2; ++bj) {
                    const f32x4 v0 = acc[ai][bj][m][0] * cw[bj][0] * rs, v1 = acc[ai][bj][m][1] * cw[bj][1] * rs;
                    const int col = pn * BM + bj * HALF + colt;
                    if (pn < 5) { float* p = qkraw + row * QKRAWW + col; *(f32x4*)p = v0; *(f32x4*)(p + 4) = v1; }
                    else { u32x4 w; w.x = cvtpk(v0[0], v0[1]); w.y = cvtpk(v0[2], v0[3]); w.z = cvtpk(v1[0], v1[1]); w.w = cvtpk(v1[2], v1[3]); *(u32x4*)(qkvb + row * QKVW + col) = w; }
                }
                }
            }
    }
};
struct EpiG2 {
    static constexpr bool PERM = true; static constexpr bool HAS_MID = true; static constexpr bool AFTER_DRAIN = false;
    typedef f32x4 acc_t;
    static __device__ __forceinline__ f32x4 mma(bf16x8 b, bf16x8 a, f32x4 c) { return __builtin_amdgcn_mfma_f32_16x16x32_bf16(b, a, c, 0, 0, 0); }
    const unsigned char* gates; bf16_t* merged; const float* lse; float* wtab;
    static __device__ __forceinline__ float gb(unsigned w, int k) { return fmaxf((float)((w >> (8 * k)) & 0xffu), 0.25f); }
    __device__ __forceinline__ bool mid_at(int t) const { return t >= 16 && t <= 28; }
    __device__ __forceinline__ void mid(f32x4 (&acc)[2][2][4][2], const Unit& u, int t, int, int, int, int) const {
        int tz = threadIdx.x; asm volatile("" : "+v"(tz));
        const int wid = tz >> 6, lane = tz & 63, wr = wid >> 2, wc = wid & 3, fr = lane & 15, fq = lane >> 4;
        float* tab = wtab + wid * 768;
        if (t == 16) {
#pragma unroll
            for (int k = 0; k < 4; ++k) { const int p = lane + 64 * k, ti = p >> 1, hg = p & 1, row = (ti >> 6) * HALF + wr * 64 + ((ti >> 4) & 3) * 16 + (ti & 15), tok = u.pm * BM + row, bb = tok / SEQ, sq = tok % SEQ;
                const float a0 = lse[(size_t)hg * NTOK + (size_t)bb * SEQ + sq], a1 = lse[(size_t)(2 + hg) * NTOK + ((size_t)(bb * 4 + (sq & 3))) * (SEQ / 4) + (sq >> 2)], a2 = lse[(size_t)(4 + hg) * NTOK + ((size_t)(bb * 16 + (sq & 15))) * (SEQ / 16) + (sq >> 4)];
                const float mx = fmaxf(a0, fmaxf(a1, a2)); const float e0 = __builtin_amdgcn_exp2f((a0 - mx) * LOG2E), e1 = __builtin_amdgcn_exp2f((a1 - mx) * LOG2E), e2 = __builtin_amdgcn_exp2f((a2 - mx) * LOG2E);
                const float inv = 1.0f / (e0 + e1 + e2); tab[ti * 6 + hg] = fmaxf(e0 * inv, 1e-30f); tab[ti * 6 + 2 + hg] = fmaxf(e1 * inv, 1e-30f); tab[ti * 6 + 4 + hg] = fmaxf(e2 * inv, 1e-30f); }
            asm volatile("s_waitcnt lgkmcnt(0)" ::: "memory");
        }
        {   const int h = (t - 16) >> 1;
#pragma unroll
            for (int ai = 0; ai < 2; ++ai)
#pragma unroll
                for (int m = 0; m < 4; ++m) { const float* e = tab + ((ai * 4 + m) * 16 + fr) * 6;
                    const float rf = h == 0 ? __builtin_amdgcn_rcpf(e[0]) : (h == 6 ? e[5] : e[h - 1] * __builtin_amdgcn_rcpf(e[h]));
#pragma unroll
                    for (int bj = 0; bj < 2; ++bj) { acc[ai][bj][m][0] *= rf; acc[ai][bj][m][1] *= rf; } }
            if (t != 16 && t != 28) return;
        }
        const int row0 = u.pm * BM + wr * 64 + fr, gcol = u.pn * BM + (wc * 4 + fq) * 16, br = t == 16 ? 0 : 1;
#pragma unroll
        for (int ai = 0; ai < 2; ++ai)
#pragma unroll
            for (int m = 0; m < 4; ++m) {
                const size_t row = (size_t)(row0 + ai * HALF + m * 16);
                const u32x4 gaq = *(const u32x4*)(gates + row * GLW + br * DM + gcol), gnq = *(const u32x4*)(gates + row * GLW + (br + 1) * DM + gcol);
#pragma unroll
                for (int bj = 0; bj < 2; ++bj) {
                    const unsigned gax = bj ? gaq.z : gaq.x, gay = bj ? gaq.w : gaq.y, gnx = bj ? gnq.z : gnq.x, gny = bj ? gnq.w : gnq.y;
                    const float a0 = br == 0 ? (float)(gax & 0xffu) : gb(gax, 0), a1 = br == 0 ? (float)((gax >> 8) & 0xffu) : gb(gax, 1), a2 = br == 0 ? (float)((gax >> 16) & 0xffu) : gb(gax, 2), a3 = br == 0 ? (float)(gax >> 24) : gb(gax, 3);
                    const float a4 = br == 0 ? (float)(gay & 0xffu) : gb(gay, 0), a5 = br == 0 ? (float)((gay >> 8) & 0xffu) : gb(gay, 1), a6 = br == 0 ? (float)((gay >> 16) & 0xffu) : gb(gay, 2), a7 = br == 0 ? (float)(gay >> 24) : gb(gay, 3);
                    acc[ai][bj][m][0] *= (f32x4){a0 * __builtin_amdgcn_rcpf(gb(gnx, 0)), a1 * __builtin_amdgcn_rcpf(gb(gnx, 1)), a2 * __builtin_amdgcn_rcpf(gb(gnx, 2)), a3 * __builtin_amdgcn_rcpf(gb(gnx, 3))};
                    acc[ai][bj][m][1] *= (f32x4){a4 * __builtin_amdgcn_rcpf(gb(gny, 0)), a5 * __builtin_amdgcn_rcpf(gb(gny, 1)), a6 * __builtin_amdgcn_rcpf(gb(gny, 2)), a7 * __builtin_amdgcn_rcpf(gb(gny, 3))};
                }
            }
    }
    __device__ __forceinline__ void operator()(const f32x4 (&acc)[2][2][4][2], const Unit& u, int wr, int wc, int fr, int fq) const {
        const int row0 = u.pm * BM + wr * 64 + fr, colt = u.pn * BM + wc * 32 + 8 * fq, gcol = u.pn * BM + (wc * 4 + fq) * 16;
        constexpr float K = 1.0f / 255.0f;
#pragma unroll
        for (int ai = 0; ai < 2; ++ai)
#pragma unroll
            for (int m = 0; m < 4; ++m) {
                const size_t row = (size_t)(row0 + ai * HALF + m * 16);
                const u32x4 gq = *(const u32x4*)(gates + row * GLW + 2 * DM + gcol);
#pragma unroll
                for (int bj = 0; bj < 2; ++bj) {
                    const int col = colt + bj * HALF;
                    const unsigned gx = bj ? gq.z : gq.x, gy = bj ? gq.w : gq.y;
                    const f32x4 v0 = acc[ai][bj][m][0], v1 = acc[ai][bj][m][1];
                    const float r[8] = {gb(gx, 0) * K * v0[0], gb(gx, 1) * K * v0[1], gb(gx, 2) * K * v0[2], gb(gx, 3) * K * v0[3], gb(gy, 0) * K * v1[0], gb(gy, 1) * K * v1[1], gb(gy, 2) * K * v1[2], gb(gy, 3) * K * v1[3]};
                    *(u32x4*)(merged + row * DM + col) = pack8(r);
                }
            }
    }
};
struct EpiG3 {
    static constexpr bool PERM = true; static constexpr bool HAS_MID = false; static constexpr bool AFTER_DRAIN = false;
    typedef f32x4 acc_t;
    static __device__ __forceinline__ f32x4 mma(bf16x8 b, bf16x8 a, f32x4 c) { return __builtin_amdgcn_mfma_f32_16x16x32_bf16(b, a, c, 0, 0, 0); }
    const float* ga  ; bf16_t* y;
    __device__ __forceinline__ void operator()(const f32x4 (&acc)[2][2][4][2], const Unit& u, int wr, int wc, int fr, int fq) const {
        const int row0 = u.pm * BM + wr * 64 + fr, colt = u.pn * BM + wc * 32 + 8 * fq;
        const float* gab = ga + (size_t)((u.pm * BM) / SEQ) * MODW;
        f32x4 gv[2][2];
#pragma unroll
        for (int bj = 0; bj < 2; ++bj) { gv[bj][0] = *(const f32x4*)(gab + colt + bj * HALF) + 1.0f; gv[bj][1] = *(const f32x4*)(gab + colt + bj * HALF + 4) + 1.0f; }
#pragma unroll
        for (int ai = 0; ai < 2; ++ai)
#pragma unroll
            for (int m = 0; m < 4; ++m) { const size_t ro = (size_t)(row0 + ai * HALF + m * 16) * DM + colt;
#pragma unroll
                for (int bj = 0; bj < 2; ++bj) { const f32x4 v0 = gv[bj][0] * acc[ai][bj][m][0], v1 = gv[bj][1] * acc[ai][bj][m][1];
                    u32x4 w; w.x = cvtpk(v0[0], v0[1]); w.y = cvtpk(v0[2], v0[3]); w.z = cvtpk(v1[0], v1[1]); w.w = cvtpk(v1[2], v1[3]);
                    *(u32x4*)(y + ro + bj * HALF) = w; } }
    }
};
struct EpiSC8 {
    static constexpr bool PERM = false; static constexpr bool HAS_MID = false; static constexpr bool AFTER_DRAIN = true;
    typedef i32x4 acc_t;
    static __device__ __forceinline__ i32x4 mma(bf16x8 b, bf16x8 a, i32x4 c) { return __builtin_amdgcn_mfma_i32_16x16x64_i8(__builtin_bit_cast(i32x4, b), __builtin_bit_cast(i32x4, a), c, 0, 0, 0); }
    float* C; const float* sh; const float* sw; const Frame* F; float* tile;
    __device__ __forceinline__ void fused(const i32x4 (&acc)[2][2][4][2], const Unit& u, int wr, int wc, int fr, int fq) const {
        const int col0 = wc * 32 + 4 * fq;
        f32x4 cw[2][2];
#pragma unroll
        for (int bj = 0; bj < 2; ++bj)
#pragma unroll
            for (int n = 0; n < 2; ++n) cw[bj][n] = *(const f32x4*)(sw + u.pn * BM + col0 + bj * HALF + n * 16);
#pragma unroll
        for (int ai = 0; ai < 2; ++ai) {
#pragma unroll
            for (int m = 0; m < 4; ++m) { const int lr = wr * 64 + m * 16 + fr; const float rs = sh[u.pm * BM + ai * HALF + lr];
#pragma unroll
                for (int bj = 0; bj < 2; ++bj)
#pragma unroll
                    for (int n = 0; n < 2; ++n) { const i32x4 a = acc[ai][bj][m][n]; *(f32x4*)(tile + lr * 260 + col0 + bj * HALF + n * 16) = (f32x4){(float)a[0], (float)a[1], (float)a[2], (float)a[3]} * cw[bj][n] * rs; } }
            __syncthreads();
            { int tz = threadIdx.x; asm volatile("" : "+v"(tz)); const int w = __builtin_amdgcn_readfirstlane(tz >> 6);
              topk_rows(*F, tile + (size_t)(w * 16) * 260, 260, u.pm * BM + ai * HALF + w * 16, u.pn, 4); }
            __syncthreads();
        }
    }
    __device__ __forceinline__ void operator()(const i32x4 (&acc)[2][2][4][2], const Unit& u, int wr, int wc, int fr, int fq) const {
        const int row0 = u.pm * BM + wr * 64 + fr, col0 = u.pn * BM + wc * 32 + 4 * fq;
        f32x4 cw[2][2];
#pragma unroll
        for (int bj = 0; bj < 2; ++bj)
#pragma unroll
            for (int n = 0; n < 2; ++n) cw[bj][n] = *(const f32x4*)(sw + col0 + bj * HALF + n * 16);
#pragma unroll
        for (int ai = 0; ai < 2; ++ai)
#pragma unroll
            for (int m = 0; m < 4; ++m) { const int row = row0 + ai * HALF + m * 16; const float rs = sh[row]; float* rowp = C + (size_t)row * DM + col0;
#pragma unroll
                for (int bj = 0; bj < 2; ++bj)
#pragma unroll
                    for (int n = 0; n < 2; ++n) { const i32x4 a = acc[ai][bj][m][n]; *(f32x4*)(rowp + bj * HALF + n * 16) = (f32x4){(float)a[0], (float)a[1], (float)a[2], (float)a[3]} * cw[bj][n] * rs; } }
    }
};
}

namespace att {
constexpr int D = 128, NW = 8, QBLK = 32, KVBLK = 64;
constexpr float SCALE = 0.088388347648318440f;
constexpr float THR = 8.f;
constexpr int SHM_V = KVBLK * D * 2, SHM_K = KVBLK * D * 2, SHM_ATTN = 2 * SHM_V + 2 * SHM_K + NW * 64 * 4;
struct Args {
    const bf16_t* Q; const bf16_t* K; const bf16_t* V; bf16_t* O; float* lse;
    int ldq, ldk, ldo, ldl;
    int kt0, NT;
    int q0, W;
    float slope_l2, m_init, l_init;
};
#define KSWZ(row, colB) ((row) * 256 + ((colB) ^ (((row) & 7) << 4)))
#define SBAR() __builtin_amdgcn_sched_barrier(0)
__device__ __forceinline__ int crow(int r, int hi) { return (r & 3) + 8 * (r >> 2) + 4 * hi; }
template <bool FIRST>
__device__ __forceinline__ void partialSM_dense(f32x16& p0, f32x16& p1, f32x16& negm, float& alpha) {
    float pmax = p0[0];
#pragma unroll
    for (int r = 1; r < 16; ++r) pmax = fmaxf(pmax, p0[r]);
#pragma unroll
    for (int r = 0; r < 16; ++r) pmax = fmaxf(pmax, p1[r]);
    { auto rr = __builtin_amdgcn_permlane32_swap(__float_as_uint(pmax), __float_as_uint(pmax), false, false); pmax = fmaxf(__uint_as_float(rr[0]), __uint_as_float(rr[1])); }
    if (!FIRST && __builtin_expect(__all(pmax <= THR * LOG2E), 1)) { alpha = 1.f; }
    else {
        const float d = FIRST ? pmax : fmaxf(pmax, 0.f);
        alpha = FIRST ? 1.f : __builtin_amdgcn_exp2f(-d); const float nm = negm[0] - d;
#pragma unroll
        for (int r = 0; r < 16; ++r) { p0[r] -= d; p1[r] -= d; negm[r] = nm; }
        asm volatile("" : "+v"(negm));
    }
#pragma unroll
    for (int r = 0; r < 16; ++r) p0[r] = __builtin_amdgcn_exp2f(p0[r]);
}
__device__ __forceinline__ void partialSM_band(f32x16& p0, f32x16& p1, float& m_reg, float& mn, float& alpha, float qrel, int hi, float slope_l2, float Wf) {
    constexpr float C = SCALE * LOG2E;
    const float ninf = -__builtin_inff();
    float pmax = ninf; const float h4 = (float)(4 * hi);
#pragma unroll
    for (int r = 0; r < 16; ++r) { const float kl = (float)((r & 3) + 8 * (r >> 2)) + h4; const float d0 = fabsf(qrel - kl), d1 = fabsf(qrel - (kl + 32.f));
        float t0 = fmaf(p0[r], C, -slope_l2 * d0), t1 = fmaf(p1[r], C, -slope_l2 * d1);
        t0 = d0 <= Wf ? t0 : ninf; t1 = d1 <= Wf ? t1 : ninf; p0[r] = t0; p1[r] = t1; pmax = fmaxf(pmax, fmaxf(t0, t1)); }
    { auto rr = __builtin_amdgcn_permlane32_swap(__float_as_uint(pmax), __float_as_uint(pmax), false, false); pmax = fmaxf(__uint_as_float(rr[0]), __uint_as_float(rr[1])); }
    if (__all(pmax - m_reg <= THR * LOG2E)) { mn = m_reg; alpha = 1.f; }
    else { mn = fmaxf(m_reg, pmax); alpha = __builtin_amdgcn_exp2f(m_reg - mn); m_reg = mn; }
#pragma unroll
    for (int r = 0; r < 16; ++r) p1[r] = p1[r] - mn;
#pragma unroll
    for (int r = 0; r < 16; ++r) p0[r] = __builtin_amdgcn_exp2f(p0[r] - mn);
}
__device__ __forceinline__ void finishSM(f32x16& p0, f32x16& p1, float alpha, float& l_reg, bf16x8& pa0, bf16x8& pa1, bf16x8& pa2, bf16x8& pa3) {
#pragma unroll
    for (int r = 0; r < 16; ++r) p1[r] = __builtin_amdgcn_exp2f(p1[r]);
    float ps = 0;
#pragma unroll
    for (int r = 0; r < 16; ++r) ps += p0[r];
#pragma unroll
    for (int r = 0; r < 16; ++r) ps += p1[r];
    { auto rr = __builtin_amdgcn_permlane32_swap(__float_as_uint(ps), __float_as_uint(ps), false, false); ps = __uint_as_float(rr[0]) + __uint_as_float(rr[1]); }
    l_reg = l_reg * alpha + ps;
#define PK4(P, BASE, OUT) do { unsigned a0 = cvtpk(P[BASE + 0], P[BASE + 1]), a1 = cvtpk(P[BASE + 2], P[BASE + 3]);   \
    unsigned b0 = cvtpk(P[BASE + 4], P[BASE + 5]), b1 = cvtpk(P[BASE + 6], P[BASE + 7]);                              \
    auto r0 = __builtin_amdgcn_permlane32_swap(a0, b0, false, false); auto r1 = __builtin_amdgcn_permlane32_swap(a1, b1, false, false); \
    u32x4 w = {r0[0], r1[0], r0[1], r1[1]}; OUT = *reinterpret_cast<bf16x8*>(&w); } while (0)
    PK4(p0, 0, pa0); PK4(p0, 8, pa1); PK4(p1, 0, pa2); PK4(p1, 8, pa3);
#undef PK4
}
__device__ __forceinline__ void qkt(f32x16& p0, f32x16& p1, const char* Ks, const bf16x8* qr, int r32, int hi) {
    p0 = f32x16{}; p1 = f32x16{};
#pragma unroll
    for (int d0 = 0; d0 < 8; ++d0) { const int cb = (d0 * 16 + hi * 8) * 2;
        const bf16x8 b0 = *reinterpret_cast<const bf16x8*>(Ks + KSWZ(r32, cb));
        const bf16x8 b1 = *reinterpret_cast<const bf16x8*>(Ks + KSWZ(32 + r32, cb));
        p0 = __builtin_amdgcn_mfma_f32_32x32x16_bf16(b0, qr[d0], p0, 0, 0, 0);
        p1 = __builtin_amdgcn_mfma_f32_32x32x16_bf16(b1, qr[d0], p1, 0, 0, 0); }
}
__device__ __forceinline__ void qkt_c(f32x16& p0, f32x16& p1, const char* Ks, const bf16x8* qr, const f32x16& c, int r32, int hi) {
#pragma unroll
    for (int d0 = 0; d0 < 8; ++d0) { const int cb = (d0 * 16 + hi * 8) * 2;
        const bf16x8 b0 = *reinterpret_cast<const bf16x8*>(Ks + KSWZ(r32, cb));
        const bf16x8 b1 = *reinterpret_cast<const bf16x8*>(Ks + KSWZ(32 + r32, cb));
        if (d0 == 0) { p0 = __builtin_amdgcn_mfma_f32_32x32x16_bf16(b0, qr[0], c, 0, 0, 0); p1 = __builtin_amdgcn_mfma_f32_32x32x16_bf16(b1, qr[0], c, 0, 0, 0); }
        else { p0 = __builtin_amdgcn_mfma_f32_32x32x16_bf16(b0, qr[d0], p0, 0, 0, 0); p1 = __builtin_amdgcn_mfma_f32_32x32x16_bf16(b1, qr[d0], p1, 0, 0, 0); } }
}
__device__ __forceinline__ int v_st(int k, int c) { const int kk = (k & ~0xC) | ((k & 4) << 1) | ((k & 8) >> 1); return ((kk >> 3) * 4 + (c >> 5)) * 512 + ((kk & 7) * 32 + (c & 31)) * 2; }
__device__ __forceinline__ int v_rd_base(int lane) { return ((lane & 3) << 3) | (((lane >> 2) & 3) << 6) | (((lane >> 4) & 1) << 5) | (((lane >> 5) & 1) << 8); }
constexpr int v_rd_off(int d0, int ks, int half) { return d0 * 512 + ks * 4096 + half * 2048; }
template <int OFF> __device__ __forceinline__ s16x4 tr_read(int vb) { s16x4 r; asm volatile("ds_read_b64_tr_b16 %0, %1 offset:%2" : "=&v"(r) : "v"(vb), "i"(OFF) : "memory"); return r; }
template <int D0> __device__ __forceinline__ void pv_one(f32x16& od, int vb, bf16x8 pa0, bf16x8 pa1, bf16x8 pa2, bf16x8 pa3) {
    const s16x4 l0 = tr_read<v_rd_off(D0, 0, 0)>(vb), h0 = tr_read<v_rd_off(D0, 0, 1)>(vb), l1 = tr_read<v_rd_off(D0, 1, 0)>(vb), h1 = tr_read<v_rd_off(D0, 1, 1)>(vb);
    const s16x4 l2 = tr_read<v_rd_off(D0, 2, 0)>(vb), h2 = tr_read<v_rd_off(D0, 2, 1)>(vb), l3 = tr_read<v_rd_off(D0, 3, 0)>(vb), h3 = tr_read<v_rd_off(D0, 3, 1)>(vb);
    asm volatile("s_waitcnt lgkmcnt(0)" ::: "memory"); SBAR();
#define PK(L, H) (bf16x8){L[0], L[1], L[2], L[3], H[0], H[1], H[2], H[3]}
    od = __builtin_amdgcn_mfma_f32_32x32x16_bf16(pa0, PK(l0, h0), od, 0, 0, 0);
    od = __builtin_amdgcn_mfma_f32_32x32x16_bf16(pa1, PK(l1, h1), od, 0, 0, 0);
    od = __builtin_amdgcn_mfma_f32_32x32x16_bf16(pa2, PK(l2, h2), od, 0, 0, 0);
    od = __builtin_amdgcn_mfma_f32_32x32x16_bf16(pa3, PK(l3, h3), od, 0, 0, 0);
#undef PK
}
__device__ __forceinline__ void pv_d0(f32x16* o, int vb, bf16x8 pa0, bf16x8 pa1, bf16x8 pa2, bf16x8 pa3) {
    pv_one<0>(o[0], vb, pa0, pa1, pa2, pa3); pv_one<1>(o[1], vb, pa0, pa1, pa2, pa3); pv_one<2>(o[2], vb, pa0, pa1, pa2, pa3); pv_one<3>(o[3], vb, pa0, pa1, pa2, pa3);
}
__device__ __forceinline__ void store_o(const f32x16 (&o)[4], float l_reg, char* lds, bf16_t* O, int ldo) {
    int tz = threadIdx.x; asm volatile("" : "+v"(tz));
    const int wid = tz >> 6, lane = tz & 63, r32 = lane & 31, hi = lane >> 5;
    float* li_l = (float*)(lds + 2 * SHM_V + 2 * SHM_K) + wid * 64;
    if (hi == 0) li_l[r32] = l_reg; asm volatile("s_waitcnt lgkmcnt(0)" ::: "memory");
    float rli[16];
#pragma unroll
    for (int r = 0; r < 16; ++r) rli[r] = __builtin_amdgcn_rcpf(li_l[crow(r, hi)]);
    __syncthreads();
    char* ow = lds + wid * 8192;
#pragma unroll
    for (int r = 0; r < 16; ++r) { const int orow = crow(r, hi);
#pragma unroll
        for (int d0 = 0; d0 < 4; ++d0) *(bf16_t*)(ow + orow * 256 + (d0 * 32 + r32) * 2) = (bf16_t)(cvtpk(o[d0][r] * rli[r], 0.f) & 0xffffu); }
    asm volatile("s_waitcnt lgkmcnt(0)" ::: "memory");
    bf16_t* Ow = O + (wid * QBLK) * ldo;
#pragma unroll
    for (int i = 0; i < 8; ++i) { const int p = i * 64 + lane, row = p >> 4, c16 = p & 15;
        const u32x4 v = *(const u32x4*)(ow + row * 256 + c16 * 16);
        *(u32x4*)(Ow + row * ldo + c16 * 8) = v; }
    __syncthreads();
}
#define RESC(al) do { if (__any((al) < 1.f)) { if (hi == 0) al_l[r32] = (al); asm volatile("s_waitcnt lgkmcnt(0)" ::: "memory"); \
    _Pragma("unroll") for (int d = 0; d < 4; ++d) _Pragma("unroll") for (int r = 0; r < 16; ++r) o[d][r] *= al_l[crow(r, hi)]; } } while (0)
#define SWRITE(b, S) do { *(bf16x8*)(V_lds + (b) * SHM_V + vst0) = S.vs0; *(bf16x8*)(V_lds + (b) * SHM_V + vst1) = S.vs1; const int kc = sc * 2; \
    *(bf16x8*)(K_lds + (b) * SHM_K + KSWZ(sr, kc)) = S.ks0; *(bf16x8*)(K_lds + (b) * SHM_K + KSWZ(32 + sr, kc)) = S.ks1; } while (0)
struct Slot { bf16x8 vs0, vs1, ks0, ks1; };
template <int LDQK, int LDO, int VDELTA>
__device__ __forceinline__ void attn_dense_unit(const bf16_t* Q, const bf16_t* K, bf16_t* O, int NT, char* lds) {
    int tid = threadIdx.x; asm volatile("" : "+v"(tid));
    const int wid = __builtin_amdgcn_readfirstlane(tid >> 6), lane = tid & 63, r32 = lane & 31, hi = lane >> 5;
    char* V_lds = lds; char* K_lds = lds + 2 * SHM_V;
    float* ws = (float*)(lds + 2 * SHM_V + 2 * SHM_K) + wid * 64; float* al_l = ws + 32;
    float l_reg = 0.f; f32x16 o[4] = {}; bf16x8 qr[8]; f32x16 negm = f32x16{}; asm volatile("" : "+v"(negm));
    const bf16_t* Qw = Q + (wid * QBLK + r32) * LDQK + hi * 8;
#pragma unroll
    for (int d0 = 0; d0 < 8; ++d0) qr[d0] = *reinterpret_cast<const bf16x8*>(Qw + d0 * 16);
    const int vb0 = (int)(uintptr_t)V_lds + v_rd_base(lane);
    int koff[2];
#pragma unroll
    for (int q = 0; q < 2; ++q) { const int row = 4 * (2 * wid + q) + (lane >> 4), cb = ((lane & 15) * 16) ^ ((row & 7) << 4); koff[q] = row * LDQK + (cb >> 1); }
    const int vkk = 8 * wid + ((lane & 31) >> 2), vkey = (vkk & ~0xC) | ((vkk & 4) << 1) | ((vkk & 8) >> 1);
    const int voff = vkey * LDQK + (lane >> 5) * 32 + (lane & 3) * 8 + VDELTA;
    LAS unsigned char* Kl = (LAS unsigned char*)K_lds + 2 * wid * 1024; LAS unsigned char* Vl = (LAS unsigned char*)V_lds + 2 * wid * 1024;
#define DMA_K(tile, buf) do { const bf16_t* kt_ = K + (size_t)((tile) < NT ? (tile) : NT - 1) * (KVBLK * LDQK); _Pragma("unroll") for (int q_ = 0; q_ < 2; ++q_) \
        __builtin_amdgcn_global_load_lds((const unsigned*)(kt_ + koff[q_]), (LAS unsigned*)(Kl + (buf) * SHM_K + q_ * 1024), 16, 0, 0); } while (0)
#define DMA_V(tile, buf) do { const bf16_t* vt_ = K + (size_t)((tile) < NT ? (tile) : NT - 1) * (KVBLK * LDQK) + voff; _Pragma("unroll") for (int q_ = 0; q_ < 2; ++q_) \
        __builtin_amdgcn_global_load_lds((const unsigned*)(vt_ + q_ * 64), (LAS unsigned*)(Vl + (buf) * SHM_V + q_ * 1024), 16, 0, 0); } while (0)
#define WBAR4() do { asm volatile("s_waitcnt vmcnt(4)" ::: "memory"); __builtin_amdgcn_s_barrier(); } while (0)
#define XBAR() do { asm volatile("s_waitcnt lgkmcnt(0)" ::: "memory"); __builtin_amdgcn_s_barrier(); } while (0)
    f32x16 pA0, pA1, pB0, pB1; float alA, alB; bf16x8 pa0, pa1, pa2, pa3;
    DMA_K(0, 0); DMA_V(0, 0); DMA_K(1, 1);
    WBAR4();
    qkt_c(pA0, pA1, K_lds, qr, negm, r32, hi); partialSM_dense<true>(pA0, pA1, negm, alA);
    XBAR();
    DMA_V(1, 1); DMA_K(2, 0);
    WBAR4();
#define STEP_E(t) do { SBAR(); qkt_c(pB0, pB1, K_lds + SHM_K, qr, negm, r32, hi); \
        finishSM(pA0, pA1, alA, l_reg, pa0, pa1, pa2, pa3); SBAR(); \
        pv_d0(o, vb0, pa0, pa1, pa2, pa3); partialSM_dense<false>(pB0, pB1, negm, alB); \
        XBAR(); DMA_V((t) + 2, 0); DMA_K((t) + 3, 1); RESC(alB); WBAR4(); } while (0)
#define STEP_O(t) do { SBAR(); qkt_c(pA0, pA1, K_lds, qr, negm, r32, hi); \
        finishSM(pB0, pB1, alB, l_reg, pa0, pa1, pa2, pa3); SBAR(); \
        pv_d0(o, vb0 + (int)SHM_V, pa0, pa1, pa2, pa3); partialSM_dense<false>(pA0, pA1, negm, alA); \
        XBAR(); DMA_V((t) + 2, 1); DMA_K((t) + 3, 0); RESC(alA); WBAR4(); } while (0)
    int t = 0;
    for (; t + 2 < NT; t += 2) { STEP_E(t); STEP_O(t + 1); }
    STEP_E(t);
    finishSM(pB0, pB1, alB, l_reg, pa0, pa1, pa2, pa3); SBAR();
    pv_d0(o, vb0 + (int)SHM_V, pa0, pa1, pa2, pa3);
    asm volatile("s_waitcnt vmcnt(0)" ::: "memory");
    store_o(o, l_reg, lds, O, LDO);
#undef DMA_K
#undef DMA_V
#undef WBAR4
#undef XBAR
#undef STEP_E
#undef STEP_O
}
__device__ __forceinline__ void attn_band_unit(const Args& a, char* lds) {
    int tid = threadIdx.x; asm volatile("" : "+v"(tid));
    const int wid = tid >> 6, lane = tid & 63, r32 = lane & 31, hi = lane >> 5;
    char* V_lds = lds; char* K_lds = lds + 2 * SHM_V;
    float* ws = (float*)(lds + 2 * SHM_V + 2 * SHM_K) + wid * 64; float* li_l = ws; float* al_l = ws + 32;
    float m_reg = a.m_init, l_reg = a.l_init; f32x16 o[4] = {}; bf16x8 qr[8];
    const bf16_t* Qw = a.Q + (wid * QBLK + r32) * a.ldq + hi * 8;
#pragma unroll
    for (int d0 = 0; d0 < 8; ++d0) qr[d0] = *reinterpret_cast<const bf16x8*>(Qw + d0 * 16);
    const int sr = tid >> 4, sc = (tid & 15) * 8, vst0 = v_st(sr, sc), vst1 = v_st(32 + sr, sc);
    const int vb0 = (int)(uintptr_t)V_lds + v_rd_base(lane);
    const char* Kh = (const char*)(a.K + (long)a.kt0 * KVBLK * a.ldk); const char* Vh = (const char*)(a.V + (long)a.kt0 * KVBLK * a.ldk);
    const unsigned so0 = (unsigned)(sr * a.ldk + sc) * 2u, so1 = so0 + (unsigned)(32 * a.ldk) * 2u; const long tstep = (long)KVBLK * a.ldk * 2;
    const float qrel0 = (float)(a.q0 + wid * QBLK + r32 - a.kt0 * KVBLK), Wf = (float)a.W, slope = a.slope_l2;
    Slot st; const int NT = a.NT;
#define SLOAD1(tile) do { const char* vt_ = Vh + (long)(tile) * tstep; const char* kt_ = Kh + (long)(tile) * tstep; \
    st.vs0 = *reinterpret_cast<const bf16x8*>(vt_ + so0); st.vs1 = *reinterpret_cast<const bf16x8*>(vt_ + so1); \
    st.ks0 = *reinterpret_cast<const bf16x8*>(kt_ + so0); st.ks1 = *reinterpret_cast<const bf16x8*>(kt_ + so1); } while (0)
    SLOAD1(0); asm volatile("s_waitcnt vmcnt(0)" ::: "memory"); SWRITE(0, st); __syncthreads();
    for (int j = 0; j < NT; ++j) {
        const int bsel = j & 1;
        if (j + 1 < NT) SLOAD1(j + 1);
        const int kb = (a.kt0 + j) * KVBLK, qlo = a.q0 + __builtin_amdgcn_readfirstlane(wid) * QBLK;
        if (kb <= qlo + QBLK - 1 + a.W && kb + KVBLK - 1 >= qlo - a.W) {
        f32x16 p0, p1; float mn, al; bf16x8 pa0, pa1, pa2, pa3;
        qkt(p0, p1, K_lds + bsel * SHM_K, qr, r32, hi);
        partialSM_band(p0, p1, m_reg, mn, al, qrel0 - (float)(j * KVBLK), hi, slope, Wf);
        RESC(al);
        finishSM(p0, p1, al, l_reg, pa0, pa1, pa2, pa3); SBAR();
        pv_d0(o, vb0 + bsel * (int)SHM_V, pa0, pa1, pa2, pa3);
        }
        if (j + 1 < NT) { asm volatile("s_waitcnt vmcnt(0)" ::: "memory"); if (bsel) { SWRITE(0, st); } else { SWRITE(1, st); } }
        __syncthreads();
    }
    if (a.lse != nullptr && hi == 0) a.lse[(wid * QBLK + r32) * a.ldl] = (m_reg + __builtin_amdgcn_logf(l_reg)) * LN2;
    store_o(o, l_reg, lds, a.O, a.ldo);
#undef SLOAD1
}
#undef RESC
#undef SWRITE
}

struct Args {
    const float* in[20]; float* out; unsigned char* ws; int ph_lo, ph_hi, use_bar, pad;
};
enum { IN_X = 0, IN_C, IN_WMOD, IN_BMOD, IN_WIN, IN_AQG, IN_AKG, IN_CSINK, IN_WPA, IN_WPB, IN_WPC, IN_WO, IN_LN1G, IN_LN1B, IN_PWQ, IN_PKEYS, IN_PU, IN_PV, IN_LN2G, IN_LN2B };
constexpr int LDS_RING = 0, LDS_WTAB = 128 * 1024  , LDS_MISC = 152 * 1024, LDS_BYTES = 153 * 1024;

struct Frame {
    const Args* a; unsigned char* ws; char* lds; int tid, wid, lane, G, bid;
    __device__ __forceinline__ unsigned char* wl(int l, size_t off) const { return ws + WS_W0 + (size_t)l * WL_BYTES + off; }
};

__device__ __forceinline__ void tconv_tile(const float* src, int N, bf16_t* dst, int ldd, int k0, int n0, float* tl, int tid) {
    {   const int r = tid >> 6, c4 = (tid & 63) * 4; f32x4 v[8];
#pragma unroll
        for (int i = 0; i < 8; ++i) v[i] = *(const f32x4*)(src + (size_t)(k0 + r + 8 * i) * N + n0 + c4);
#pragma unroll
        for (int i = 0; i < 8; ++i) { float* p = tl + (r + 8 * i) * 257 + c4; p[0] = v[i][0]; p[1] = v[i][1]; p[2] = v[i][2]; p[3] = v[i][3]; } }
    __syncthreads();
    {   const int n = tid >> 1, kh = (tid & 1) * 32;
#pragma unroll
        for (int q = 0; q < 4; ++q) { float v[8];
#pragma unroll
            for (int j = 0; j < 8; ++j) v[j] = tl[(kh + q * 8 + j) * 257 + n];
            *(u32x4*)(dst + (size_t)(n0 + n) * ldd + k0 + kh + q * 8) = pack8(v); } }
    __syncthreads();
}
__device__ __forceinline__ unsigned fp4_code(float y) {
    const float a = fabsf(y);
    const unsigned c = (a >= 0.25f) + (a >= 0.75f) + (a >= 1.25f) + (a >= 1.75f) + (a >= 2.5f) + (a >= 3.5f) + (a >= 5.0f);
    return c | (y < 0.f ? 8u : 0u);
}
__device__ __forceinline__ unsigned fp4_pack8(const float* v, float inv) {
    unsigned w = 0u;
#pragma unroll
    for (int j = 0; j < 8; ++j) w |= fp4_code(v[j] * inv) << (4 * j);
    return w;
}
__device__ __forceinline__ void store_h_q8(const float (&v)[2][16], unsigned char* hrow, float* shp, int lane) {
    float am = 0.f;
#pragma unroll
    for (int hf = 0; hf < 2; ++hf)
#pragma unroll
        for (int j = 0; j < 16; ++j) am = fmaxf(am, fabsf(v[hf][j]));
    am = wave_max(am); const float sc = am > 0.f ? am * (1.0f / 6.0f) : 1.0f, inv = 1.0f / sc;
#pragma unroll
    for (int hf = 0; hf < 2; ++hf) *(u32x2*)(hrow + hf * 512 + lane * 8) = (u32x2){fp4_pack8(&v[hf][0], inv), fp4_pack8(&v[hf][8], inv)};
    if (lane == 0) *shp = sc;
}

__device__ void phase_c0(const Frame& F) {
    const Args& A = *F.a; const int tid = F.tid, G = F.G, bid = F.bid;
    float* tl = (float*)F.lds;
    if (tid < 8) {
        float* rope = (float*)(F.ws + WS_ROPE);
        for (int e = bid * 8 + tid; e < 64 * 32; e += G * 8) {
            const int pos = e >> 5, i = e & 31;
            double inv = 1.0; for (int k = 0; k < i; ++k) inv *= 0.74989420933245582730;
            const double ang = (double)pos * (double)(float)inv;
            const double kq = __builtin_rint(ang * 0.63661977236758134308);
            const double r = (ang - kq * 1.5707963267948966192) - kq * 6.123233995736766e-17;
            const double r2 = r * r;
            double s = r * (1.0 + r2 * (-1.0 / 6 + r2 * (1.0 / 120 + r2 * (-1.0 / 5040 + r2 * (1.0 / 362880 + r2 * (-1.0 / 39916800 + r2 * (1.0 / 6227020800.0)))))));
            double c = 1.0 + r2 * (-0.5 + r2 * (1.0 / 24 + r2 * (-1.0 / 720 + r2 * (1.0 / 40320 + r2 * (-1.0 / 3628800 + r2 * (1.0 / 479001600.0 + r2 * (-1.0 / 87178291200.0)))))));
            const int q = ((int)kq) & 3;
            const double cs = q == 0 ? c : (q == 1 ? -s : (q == 2 ? -c : s)), sn = q == 0 ? s : (q == 1 ? c : (q == 2 ? -s : -c));
            rope[e] = (float)cs; rope[2048 + e] = (float)sn;
        }
    }
    for (int u = bid; u < 256; u += G) {
        const int gc0 = u * 96, l = gc0 / MODW, n0 = gc0 % MODW;
        const float* wm = A.in[IN_WMOD] + (size_t)l * DM * MODW; const float* cv = A.in[IN_C];
        const int rr = tid / 24, cq = tid % 24;
        f32x4 a0 = {0.f, 0.f, 0.f, 0.f}, a1 = {0.f, 0.f, 0.f, 0.f};
        if (rr < 21) {
            for (int k = rr; k < DM; k += 14 * 21) { f32x4 w[14];
#pragma unroll
                for (int i = 0; i < 14; ++i) { const int kk = k + 21 * i < DM ? k + 21 * i : DM - 1; w[i] = __builtin_nontemporal_load((const f32x4*)(wm + (size_t)kk * MODW + n0 + cq * 4)); }
#pragma unroll
                for (int i = 0; i < 14; ++i) { const bool ok = k + 21 * i < DM; const int kk = ok ? k + 21 * i : DM - 1; const float c0 = ok ? cv[kk] : 0.f, c1 = ok ? cv[DM + kk] : 0.f; a0 += w[i] * c0; a1 += w[i] * c1; } }
        }
        float* red = tl;
        if (rr < 21) { *(f32x4*)(red + (rr * 2 + 0) * 96 + cq * 4) = a0; *(f32x4*)(red + (rr * 2 + 1) * 96 + cq * 4) = a1; }
        __syncthreads();
        if (tid < 192) { const int b = tid / 96, n = tid % 96; float s = 0.f; for (int r = 0; r < 21; ++r) s += red[(r * 2 + b) * 96 + n];
            ((float*)(F.ws + WS_MOD))[((size_t)l * NBATCH + b) * MODW + n0 + n] = s + A.in[IN_BMOD][(size_t)l * MODW + n0 + n]; }
        __syncthreads();
    }
    {
        int mine = 0; for (int u = bid; u < 43; u += G) ++mine;
        if (mine > 0) { asm volatile("s_waitcnt vmcnt(0)" ::: "memory"); __syncthreads();
            if (tid == 0) { __builtin_amdgcn_fence(__ATOMIC_RELEASE, "agent"); asm volatile("s_waitcnt vmcnt(0)" ::: "memory"); (void)xb_add((unsigned*)(F.ws + WS_CTL) + XB_MODCNT, (unsigned)mine); } }
    }
    for (int u0 = bid; u0 < DEPTH * 16 * 8; u0 += G) {
        const int u = G == 256 ? (((u0 & 7) | ((u0 >> 6) << 3)) << 3) | ((u0 >> 3) & 7) : u0;
        const int l = u >> 7, hp = (u >> 3) & 15, kb = u & 7, p = hp & 1;
        const float* keys = A.in[IN_PKEYS] + ((size_t)(l * 2 + p) * 128) * 128; const float* wq = A.in[IN_PWQ] + (size_t)l * DM * DM;
        unsigned char* dst = F.wl(l, WL_WQK) + (size_t)(hp * 128 + kb * 16) * DM; float* swq = (float*)F.wl(l, WL_SWQK) + hp * 128 + kb * 16;
        float* red = (float*)F.lds; unsigned char* bt = (unsigned char*)F.lds + 1024;
        const int lane = F.lane, w = F.wid, li = lane & 15, lg = lane >> 4;
        f32x4 af[8];
#pragma unroll
        for (int blk = 0; blk < 8; ++blk) af[blk] = *(const f32x4*)(keys + (size_t)(kb * 16 + li) * 128 + blk * 16 + lg * 4);
        f32x4 bv[2][8]; f32x4 acc[16];
        const float* wrow = wq + (size_t)(w * 256 + li) * DM + hp * 128 + lg * 4;
#pragma unroll
        for (int blk = 0; blk < 8; ++blk) bv[0][blk] = *(const f32x4*)(wrow + blk * 16);
#pragma unroll
        for (int db = 0; db < 16; ++db) {
            const int cur = db & 1;
            if (db + 1 < 16) {
#pragma unroll
                for (int blk = 0; blk < 8; ++blk) bv[cur ^ 1][blk] = *(const f32x4*)(wrow + (size_t)(db + 1) * 16 * DM + blk * 16); }
            f32x4 a = {0.f, 0.f, 0.f, 0.f};
#pragma unroll
            for (int blk = 0; blk < 8; ++blk)
#pragma unroll
                for (int s2 = 0; s2 < 4; ++s2) a = __builtin_amdgcn_mfma_f32_16x16x4f32(af[blk][s2], bv[cur][blk][s2], a, 0, 0, 0);
            acc[db] = a;
        }
        float am[4] = {0.f, 0.f, 0.f, 0.f};
#pragma unroll
        for (int db = 0; db < 16; ++db)
#pragma unroll
            for (int r = 0; r < 4; ++r) am[r] = fmaxf(am[r], fabsf(acc[db][r]));
#pragma unroll
        for (int r = 0; r < 4; ++r) { float x = am[r]; x = fmaxf(x, dppf<XOR1>(x)); x = fmaxf(x, dppf<XOR2>(x)); x = fmaxf(x, dppf<HMIR>(x)); x = fmaxf(x, dppf<MIR>(x)); am[r] = x; }
        if (li == 0) {
#pragma unroll
            for (int r = 0; r < 4; ++r) red[w * 16 + lg * 4 + r] = am[r]; }
        __syncthreads();
        float inv[4];
#pragma unroll
        for (int r = 0; r < 4; ++r) { float x = 0.f;
#pragma unroll
            for (int ww = 0; ww < 8; ++ww) x = fmaxf(x, red[ww * 16 + lg * 4 + r]);
            const float sc = x > 0.f ? x * (1.0f / 127.0f) : 1.0f; inv[r] = 1.0f / sc;
            if (w == 0 && li == 0) swq[lg * 4 + r] = sc; }
#pragma unroll
        for (int db = 0; db < 16; ++db)
#pragma unroll
            for (int r = 0; r < 4; ++r) bt[(lg * 4 + r) * DM + w * 256 + db * 16 + li] = (unsigned char)((int)__builtin_rintf(acc[db][r] * inv[r]) & 0xff);
        __syncthreads();
#pragma unroll
        for (int q = 0; q < 4; ++q) { const int pc = q * NTHREADS + tid, k = pc >> 7, c16 = (pc & 127) * 16;
            *(u32x4*)(dst + (size_t)k * DM + c16) = *(const u32x4*)(bt + k * DM + c16); }
        __syncthreads();
    }
    for (int it = bid; it < DEPTH * 608; it += G) {
        const int l = it / 608; int r = it % 608 + 1440;
        const float* src; int N; bf16_t* dst; int ldd, koff, nkt;
        if (r < 1568) { r -= 1440; src = A.in[IN_WPA] + (size_t)l * 1024 * DM; N = DM; dst = (bf16_t*)F.wl(l, WL_WP); ldd = AOW; koff = AO_A; nkt = 16; }
        else if (r < 1664) { r -= 1568; src = A.in[IN_WPB] + (size_t)l * 768 * DM; N = DM; dst = (bf16_t*)F.wl(l, WL_WP); ldd = AOW; koff = AO_B; nkt = 12; }
        else if (r < 1792) { r -= 1664; src = A.in[IN_WPC] + (size_t)l * 1024 * DM; N = DM; dst = (bf16_t*)F.wl(l, WL_WP); ldd = AOW; koff = AO_C; nkt = 16; }
        else { r -= 1792; src = A.in[IN_WO] + (size_t)l * DM * DM; N = DM; dst = (bf16_t*)F.wl(l, WL_WO); ldd = DM; koff = 0; nkt = 32; }
        const int kt = r % nkt, ntile = r / nkt;
        tconv_tile(src, N, dst + koff, ldd, kt * 64, ntile * 256, tl, tid);
    }
    {
        const int lane = F.lane, wbase = bid * 32 + F.wid * 4;
        auto rowof = [&](int i) { return (i >> 2) * (G * 32) + wbase + (i & 3); };
        auto ldrow = [&](f32x4 (&v)[8], int rw) {
            if (rw < 4 * NEXP) { const int which = rw / NEXP, e = rw % NEXP;
                const float* src = A.in[(which & 1) ? IN_PV : IN_PU] + ((size_t)(which >> 1) * NEXP + e) * DM;
#pragma unroll
                for (int i = 0; i < 8; ++i) v[i] = __builtin_nontemporal_load((const f32x4*)(src + i * 256 + lane * 4)); } };
        auto cvrow = [&](const f32x4 (&v)[8], int rw) {
            if (rw >= 4 * NEXP) return;
            const int which = rw / NEXP, e = rw % NEXP, l = which >> 1, tb = which & 1;
            float am = 0.f, sq = 0.f;
#pragma unroll
            for (int i = 0; i < 8; ++i)
#pragma unroll
                for (int j = 0; j < 4; ++j) { am = fmaxf(am, fabsf(v[i][j])); sq = fmaf(v[i][j], v[i][j], sq); }
            am = wave_max(am); sq = wave_sum(sq);
            const float st = fminf(am * (1.0f / 7.5f), 0.3352f * __builtin_sqrtf(sq * (1.0f / DM)));
            const float sc = st > 0.f ? st : 1.0f, inv = 1.0f / sc;
            unsigned wd[4];
#pragma unroll
            for (int d = 0; d < 4; ++d) { float bq[4];
#pragma unroll
                for (int j = 0; j < 4; ++j) { const float lo = fminf(fmaxf(__builtin_floorf(v[2 * d][j] * inv) + 8.f, 0.f), 15.f), hi = fminf(fmaxf(__builtin_floorf(v[2 * d + 1][j] * inv) + 8.f, 0.f), 15.f); const float lo2 = tb ? lo : (lo >= 8.f ? lo - 8.f : lo + 8.f); bq[j] = fmaf(hi >= 8.f ? hi - 8.f : hi + 8.f, 16.f, lo2); }
                wd[d] = pack4_raw(bq[0], bq[1], bq[2], bq[3]); }
            *(u32x4*)(F.wl(l, tb ? WL_VB : WL_UB) + (size_t)e * (DM / 2) + lane * 16) = (u32x4){wd[0], wd[1], wd[2], wd[3]};
            if (lane == 0) ((float*)F.wl(l, tb ? WL_SV : WL_SU))[e] = sc; };
        const int nrw = ((4 * NEXP + G * 32 - 1) / (G * 32)) * 4;
        f32x4 va[8], vb[8];
        ldrow(va, rowof(0));
        for (int i = 0; i < nrw; i += 2) {
            ldrow(vb, rowof(i + 1));
            cvrow(va, rowof(i));
            if (i + 2 < nrw) ldrow(va, rowof(i + 2));
            cvrow(vb, rowof(i + 1));
        }
    }
    for (int u = G - 1 - bid; u < DEPTH * 360; u += G) {
        const int l = u / 360, n0 = (u % 360) * 32, g = tid & 7, kb = tid >> 3;
        const float* src = A.in[IN_WIN] + ((size_t)l * DM + kb * 32) * INW + n0 + g * 4;
        f32x4 v[32];
#pragma unroll
        for (int i = 0; i < 32; ++i) v[i] = __builtin_nontemporal_load((const f32x4*)(src + (size_t)i * INW));
        f32x4 m = {0.f, 0.f, 0.f, 0.f};
#pragma unroll
        for (int i = 0; i < 32; ++i) { m[0] = fmaxf(m[0], fabsf(v[i][0])); m[1] = fmaxf(m[1], fabsf(v[i][1])); m[2] = fmaxf(m[2], fabsf(v[i][2])); m[3] = fmaxf(m[3], fabsf(v[i][3])); }
#pragma unroll
        for (int j = 0; j < 4; ++j) { float x = m[j]; x = fmaxf(x, lperm(x, F.lane ^ 8)); x = fmaxf(x, lperm(x, F.lane ^ 16)); x = fmaxf(x, lperm(x, F.lane ^ 32)); m[j] = x; }
        float* red = tl;
        if (F.lane < 8) *(f32x4*)(red + F.wid * 32 + g * 4) = m;
        __syncthreads();
#pragma unroll
        for (int ww = 0; ww < 8; ++ww) { const f32x4 o = *(const f32x4*)(red + ww * 32 + g * 4); m[0] = fmaxf(m[0], o[0]); m[1] = fmaxf(m[1], o[1]); m[2] = fmaxf(m[2], o[2]); m[3] = fmaxf(m[3], o[3]); }
        unsigned char* dst = F.wl(l, WL_WIN) + (size_t)(n0 + g * 4) * (DM / 2) + kb * 16;
#pragma unroll
        for (int j = 0; j < 4; ++j) {
            const float sc = m[j] > 0.f ? m[j] * (1.0f / 6.0f) : 1.0f, inv = 1.0f / sc; unsigned w[4];
#pragma unroll
            for (int q = 0; q < 4; ++q) { float e8[8];
#pragma unroll
                for (int jj = 0; jj < 8; ++jj) e8[jj] = v[q * 8 + jj][j];
                w[q] = fp4_pack8(e8, inv); }
            *(u32x4*)(dst + (size_t)j * (DM / 2)) = (u32x4){w[0], w[1], w[2], w[3]};
            if (kb == 0) ((float*)F.wl(l, WL_SWIN))[n0 + g * 4 + j] = sc;
        }
        __syncthreads();
    }
    if (tid == 0) { unsigned* ctl = (unsigned*)(F.ws + WS_CTL); XB_SPIN(xb_ld(&ctl[XB_MODCNT]) < 43u, ctl); __builtin_amdgcn_fence(__ATOMIC_ACQUIRE, "agent"); }
    __syncthreads();
    {
    const float* x = A.in[IN_X]; const float* mod = (const float*)(F.ws + WS_MOD);
    for (int tt = F.bid * 32 + F.wid * 4; tt < NTOK; tt += F.G * 32) for (int t = tt; t < tt + 4; ++t) {
        const int b = t / SEQ; float v[2][16];
#pragma unroll
        for (int hf = 0; hf < 2; ++hf)
#pragma unroll
            for (int q = 0; q < 2; ++q) { const int c = hf * 1024 + F.lane * 16 + q * 8; float xv[8], sh[8], sc[8]; ld8f(x + (size_t)t * DM + c, xv); ld8f(mod + (size_t)b * MODW + c, sh); ld8f(mod + (size_t)b * MODW + DM + c, sc);
#pragma unroll
                for (int j = 0; j < 8; ++j) v[hf][q * 8 + j] = fmaf(xv[j], 1.0f + sc[j], sh[j]); }
        store_h_q8(v, F.ws + WS_H + (size_t)t * (DM / 2), (float*)(F.ws + WS_SH) + t, F.lane);
    }
    }
}


__device__ __forceinline__ void norm_rope_tile(const Frame& F, int l, int pm, int pn) {
    const float* raw = (const float*)(F.ws + WS_QKRAW); bf16_t* qkvb = (bf16_t*)(F.ws + WS_QKVB); const float* rope = (const float*)(F.ws + WS_ROPE);
    const int lane = F.lane, i = lane & 31; const bool isq = pn < 4;
    const float qs = isq ? att::SCALE * LOG2E : 1.0f;
    const float g0 = F.a->in[isq ? IN_AQG : IN_AKG][l * HD + lane] * qs, g1 = F.a->in[isq ? IN_AQG : IN_AKG][l * HD + 64 + lane] * qs;
    for (int q0 = F.wid * 64; q0 < F.wid * 64 + 64; q0 += 4) {
        float x0[4], x1[4], cr[4], sr[4], cc[4], sn[4];
#pragma unroll
        for (int k = 0; k < 4; ++k) { const int q = q0 + k, t = pm * 256 + (q >> 1), hh = pn * 2 + (q & 1), s = t % SEQ, pr = s >> 6, pc = s & 63;
            const float* src = raw + (size_t)t * QKRAWW + hh * HD; x0[k] = src[lane]; x1[k] = src[64 + lane];
            cr[k] = rope[pr * 32 + i]; sr[k] = rope[2048 + pr * 32 + i]; cc[k] = rope[pc * 32 + i]; sn[k] = rope[2048 + pc * 32 + i]; }
#pragma unroll
        for (int k = 0; k < 4; ++k) { const int q = q0 + k, t = pm * 256 + (q >> 1), hh = pn * 2 + (q & 1);
            const float ss = wave_sum(x0[k] * x0[k] + x1[k] * x1[k]);
            const float rs = __builtin_amdgcn_rsqf(ss * (1.0f / HD) + QK_EPS);
            const float a0 = x0[k] * rs * g0, a1 = x1[k] * rs * g1;
            const float y0 = lperm(a0, lane ^ 32), y1 = lperm(a1, lane ^ 32);
            const float o0 = lane < 32 ? a0 * cr[k] - y0 * sr[k] : a0 * cr[k] + y0 * sr[k];
            const float o1 = lane < 32 ? a1 * cc[k] - y1 * sn[k] : a1 * cc[k] + y1 * sn[k];
            bf16_t* dst = qkvb + (size_t)t * QKVW + hh * HD;
            dst[lane] = (bf16_t)(cvtpk(o0, 0.f) & 0xffffu); dst[64 + lane] = (bf16_t)(cvtpk(o1, 0.f) & 0xffffu); }
    }
}
__device__ __forceinline__ void band_range(int q0, int W, int L, int& kt0, int& NT) {
    int lo = q0 - W; if (lo < 0) lo = 0; int hi = q0 + 256 + W; if (hi > L) hi = L;
    const int t0 = lo >> 6, t1 = (hi + 63) >> 6;
    kt0 = t0; NT = t1 - t0;
}
__device__ __forceinline__ void attn_c_args(const Frame& F, int l, int u, att::Args& a) {
    const int qb = u & 15, h = (u >> 4) & 7, b = u >> 7, kvh = h >> 2;
    bf16_t* qkvb = (bf16_t*)(F.ws + WS_QKVB); bf16_t* ao = (bf16_t*)(F.ws + WS_AO);
    const size_t t0 = (size_t)b * SEQ;
    a.Q = qkvb + (t0 + qb * 256) * QKVW + COL_QC + h * HD; a.K = qkvb + t0 * QKVW + COL_KC + kvh * HD; a.V = qkvb + t0 * QKVW + COL_VC + kvh * HD;
    a.O = ao + (t0 + qb * 256) * AOW + AO_C + h * HD; a.lse = nullptr; a.ldq = QKVW; a.ldk = QKVW; a.ldo = AOW; a.ldl = 0;
    a.q0 = qb * 256; a.W = 128; band_range(a.q0, a.W, SEQ, a.kt0, a.NT);
    a.slope_l2 = __builtin_amdgcn_exp2f(-(float)(h + 1)) * LOG2E;
    a.m_init = F.a->in[IN_CSINK][l * 8 + h] * LOG2E; a.l_init = 1.0f;
}
__device__ __forceinline__ void attn_b_args(const Frame& F, int u, att::Args& a) {
    const int g = u >> 6, v = u & 63;
    const int r = g == 0 ? 1 : (g == 1 ? 4 : 16), sub = SEQ / r;
    int b, c, hg, qb;
    if (g == 0) { qb = v & 15; hg = (v >> 4) & 1; b = v >> 5; c = 0; }
    else if (g == 1) { qb = v & 3; c = (v >> 2) & 3; hg = (v >> 4) & 1; b = v >> 5; }
    else { qb = 0; c = v & 15; hg = (v >> 4) & 1; b = v >> 5; }
    const int head = g * 2 + hg;
    bf16_t* qkvb = (bf16_t*)(F.ws + WS_QKVB); bf16_t* ao = (bf16_t*)(F.ws + WS_AO); float* lse = (float*)(F.ws + WS_LSEB);
    const size_t t0 = (size_t)b * SEQ + c;
    a.ldq = r * QKVW; a.ldk = r * QKVW; a.ldo = r * AOW; a.ldl = 1;
    a.Q = qkvb + t0 * QKVW + COL_QB + head * HD + (size_t)(qb * 256) * a.ldq; a.K = qkvb + t0 * QKVW + COL_KB + head * HD; a.V = qkvb + t0 * QKVW + COL_VB + head * HD;
    a.O = ao + t0 * AOW + AO_B + head * HD + (size_t)(qb * 256) * a.ldo; a.lse = lse + (size_t)head * NTOK + ((size_t)(b * r + c)) * sub + qb * 256;
    a.q0 = qb * 256; a.W = 64; band_range(a.q0, a.W, sub, a.kt0, a.NT);
    a.slope_l2 = __builtin_amdgcn_exp2f(-8.0f * (float)(head + 1) / 6.0f) * (float)r * LOG2E;
    a.m_init = -1e30f; a.l_init = 0.f;
}
__device__ __forceinline__ void attn_a_unit(const Frame& F, int u) {
    const int xs = u & 7, idx = u >> 3, b = xs >> 2, kvh = (xs >> 1) & 1, h = kvh * 4 + (xs & 1) * 2 + (idx >> 4), qb = idx & 15;
    bf16_t* qkvb = (bf16_t*)(F.ws + WS_QKVB); bf16_t* ao = (bf16_t*)(F.ws + WS_AO);
    const size_t t0 = (size_t)b * SEQ;
    att::attn_dense_unit<QKVW, AOW, COL_VA - COL_KA>(qkvb + (t0 + qb * 256) * QKVW + COL_QA + h * HD, qkvb + t0 * QKVW + COL_KA + kvh * HD,
                                    ao + (t0 + qb * 256) * AOW + AO_A + h * HD, SEQ / 64, F.lds);
}
__device__ void phase_att(const Frame& F, int l) {
    for (int u = F.bid; u < 256; u += F.G) attn_a_unit(F, u);
    for (int u = F.bid; u < 256 + 192; u += F.G) { att::Args a; if (u < 256) attn_c_args(F, l, u, a); else attn_b_args(F, u - 256, a); att::attn_band_unit(a, F.lds); }
}

__device__ void phase_ln1(const Frame& F, int l) {
    const bf16_t* yb = (const bf16_t*)(F.ws + WS_Z); const float* xin = l == 0 ? F.a->in[IN_X] : (const float*)(F.ws + WS_XCUR); bf16_t* x1 = (bf16_t*)(F.ws + WS_X1); unsigned char* h2 = F.ws + WS_H2; float* sh2 = (float*)(F.ws + WS_SH2);
    const float* g = F.a->in[IN_LN1G] + (size_t)l * DM; const float* bb = F.a->in[IN_LN1B] + (size_t)l * DM;
    const float* mod = (const float*)(F.ws + WS_MOD) + (size_t)l * NBATCH * MODW;
    LAS float* pl = (LAS float*)F.lds;
    for (int tt = F.bid * 32 + F.wid * 4; tt < NTOK; tt += F.G * 32) {
      {   const int bq = tt / SEQ, c = F.tid * 4;
          __syncthreads();
          *(LAS f32x4*)(pl + c) = *(const f32x4*)(g + c); *(LAS f32x4*)(pl + 2048 + c) = *(const f32x4*)(bb + c);
          *(LAS f32x4*)(pl + 4096 + c) = *(const f32x4*)(mod + (size_t)bq * MODW + 4 * DM + c) + 1.0f; *(LAS f32x4*)(pl + 6144 + c) = *(const f32x4*)(mod + (size_t)bq * MODW + 3 * DM + c);
          __syncthreads(); }
      for (int t = tt; t < tt + 4; ++t) {
        float v[4][8]; float s = 0.f;
#pragma unroll
        for (int i = 0; i < 4; ++i) { const size_t o = (size_t)t * DM + i * 512 + F.lane * 8; ld8f(xin + o, v[i]); const u32x4 yw = *(const u32x4*)(yb + o);
            const float yy[8] = {bf_lo(yw.x), bf_hi(yw.x), bf_lo(yw.y), bf_hi(yw.y), bf_lo(yw.z), bf_hi(yw.z), bf_lo(yw.w), bf_hi(yw.w)};
#pragma unroll
            for (int j = 0; j < 8; ++j) { v[i][j] = fmaf(ALPHA, v[i][j], yy[j]); s += v[i][j]; } }
        const float mean = wave_sum(s) * (1.0f / DM); float q = 0.f;
#pragma unroll
        for (int i = 0; i < 4; ++i)
#pragma unroll
            for (int j = 0; j < 8; ++j) { v[i][j] -= mean; q += v[i][j] * v[i][j]; }
        const float rstd = __builtin_amdgcn_rsqf(wave_sum(q) * (1.0f / DM) + LN_EPS);
        float hmax = 0.f;
#pragma unroll
        for (int i = 0; i < 4; ++i) { const int c = i * 512 + F.lane * 8; float gg[8], be[8], sh[8], sc[8];
            { const f32x4 a0 = *(const LAS f32x4*)(pl + c), a1 = *(const LAS f32x4*)(pl + c + 4), b0 = *(const LAS f32x4*)(pl + 2048 + c), b1 = *(const LAS f32x4*)(pl + 2048 + c + 4);
              const f32x4 c0 = *(const LAS f32x4*)(pl + 4096 + c), c1 = *(const LAS f32x4*)(pl + 4096 + c + 4), d0 = *(const LAS f32x4*)(pl + 6144 + c), d1 = *(const LAS f32x4*)(pl + 6144 + c + 4);
#pragma unroll
              for (int j = 0; j < 4; ++j) { gg[j] = a0[j]; gg[4 + j] = a1[j]; be[j] = b0[j]; be[4 + j] = b1[j]; sc[j] = c0[j]; sc[4 + j] = c1[j]; sh[j] = d0[j]; sh[4 + j] = d1[j]; } }
#pragma unroll
            for (int j = 0; j < 8; ++j) v[i][j] = fmaf(v[i][j] * rstd, gg[j], be[j]);
            *(u32x4*)(x1 + (size_t)t * DM + c) = pack8(v[i]);
#pragma unroll
            for (int j = 0; j < 8; ++j) { v[i][j] = fmaf(v[i][j], sc[j], sh[j]); hmax = fmaxf(hmax, fabsf(v[i][j])); } }
        hmax = wave_max(hmax); const float hs = hmax > 0.f ? hmax * (1.0f / 119.0f) : 1.0f, hi = 1.0f / hs;
#pragma unroll
        for (int i = 0; i < 4; ++i) *(u32x2*)(h2 + (size_t)t * DM + i * 512 + F.lane * 8) = (u32x2){pack4_u8(v[i][0] * hi, v[i][1] * hi, v[i][2] * hi, v[i][3] * hi) ^ 0x80808080u, pack4_u8(v[i][4] * hi, v[i][5] * hi, v[i][6] * hi, v[i][7] * hi) ^ 0x80808080u};
        if (F.lane == 0) sh2[t] = hs;
    }
    }
}

__device__ __forceinline__ unsigned row16_umax(unsigned x) { x = max(x, dppu<XOR1>(x)); x = max(x, dppu<XOR2>(x)); x = max(x, dppu<HMIR>(x)); x = max(x, dppu<MIR>(x)); return x; }
__device__ __forceinline__ unsigned fsort(float v) { const unsigned f = __float_as_uint(v); return (f & 0x80000000u) ? ~f : (f | 0x80000000u); }
__device__ __forceinline__ void topk_rows(const Frame& F, const float* rows, int pitch, int tok0, int h, int nit) {
    int* eidx = (int*)(F.ws + WS_EIDX); float* egate = (float*)(F.ws + WS_EGATE);
    const int lane = F.lane, row = lane >> 4, l15 = lane & 15, rbase = lane & 48;
#pragma unroll 1
    for (int it = 0; it < nit; ++it) {
        const int t0 = tok0 + it * 4;
        float sval[2]; int sidx[2];
#pragma unroll
        for (int ps = 0; ps < 2; ++ps) {
            const int tok = t0 + 2 * ps + (row >> 1), p = row & 1;
            const float* src = rows + (size_t)(tok - tok0) * pitch + p * 128;
            const f32x4 va = *(const f32x4*)(src + l15 * 8), vb = *(const f32x4*)(src + l15 * 8 + 4);
            unsigned k[8];
#pragma unroll
            for (int j = 0; j < 4; ++j) { k[j] = (fsort(va[j]) & ~127u) | (unsigned)(127 - (l15 * 8 + j)); k[4 + j] = (fsort(vb[j]) & ~127u) | (unsigned)(127 - (l15 * 8 + 4 + j)); }
#define CE(i, j) do { const unsigned hi_ = max(k[i], k[j]), lo_ = min(k[i], k[j]); k[i] = hi_; k[j] = lo_; } while (0)
            CE(0, 1); CE(2, 3); CE(4, 5); CE(6, 7); CE(0, 2); CE(1, 3); CE(4, 6); CE(5, 7); CE(1, 2); CE(5, 6);
            CE(0, 4); CE(1, 5); CE(2, 6); CE(3, 7); CE(2, 4); CE(3, 5); CE(1, 2); CE(3, 4); CE(5, 6);
#undef CE
            unsigned sel = 0u;
#pragma unroll
            for (int r = 0; r < 16; ++r) {
                const unsigned m = row16_umax(k[0]); const bool win = k[0] == m;
#pragma unroll
                for (int j = 0; j < 7; ++j) k[j] = win ? k[j + 1] : k[j];
                k[7] = win ? 0u : k[7];
                sel = l15 == r ? m : sel;
            }
            sidx[ps] = 127 - (int)(sel & 127u); sval[ps] = src[sidx[ps]];
        }
        const int srcx = ((row & 1) * 2) * 16 + l15, srcy = srcx + 16;
        const float xv0 = lperm(sval[0], srcx), xv1 = lperm(sval[1], srcx), yv0 = lperm(sval[0], srcy), yv1 = lperm(sval[1], srcy);
        const int xi0 = lperm(sidx[0], srcx), xi1 = lperm(sidx[1], srcx), yi0 = lperm(sidx[0], srcy), yi1 = lperm(sidx[1], srcy);
        const float v1 = row < 2 ? xv0 : xv1, yv = row < 2 ? yv0 : yv1; const int i1 = row < 2 ? xi0 : xi1, yi = row < 2 ? yi0 : yi1;
        const unsigned long long CI0 = 0x0c87654322110000ull, CJ0 = 0x000000004040c840ull, CCN = 0x0442223414444444ull;
        const int ci0 = (int)(CI0 >> (4 * l15)) & 15, cj0 = (int)(CJ0 >> (4 * l15)) & 15, ccn = (int)(CCN >> (4 * l15)) & 15; const bool ccol = l15 >= 13;
        unsigned kq[4];
#pragma unroll
        for (int q = 0; q < 4; ++q) { const int ii = ci0 + (ccol ? q : 0), jj = cj0 + (ccol ? 0 : q);
            const float sm = lperm(v1, rbase + ii) + lperm(yv, rbase + (jj & 15));
            kq[q] = q < ccn ? ((fsort(sm) & ~63u) | (unsigned)(l15 * 4 + q)) : 0u; }
#define CE4(i, j) do { const unsigned hi_ = max(kq[i], kq[j]), lo_ = min(kq[i], kq[j]); kq[i] = hi_; kq[j] = lo_; } while (0)
        CE4(0, 1); CE4(2, 3); CE4(0, 2); CE4(1, 3); CE4(1, 2);
#undef CE4
        unsigned rec = 0u;
#pragma unroll
        for (int r = 0; r < 16; ++r) {
            const unsigned m = row16_umax(kq[0]); const bool win = kq[0] == m;
            kq[0] = win ? kq[1] : kq[0]; kq[1] = win ? kq[2] : kq[1]; kq[2] = win ? kq[3] : kq[2]; kq[3] = win ? 0u : kq[3];
            rec = l15 == r ? m : rec;
        }
        const int wl = (int)(rec >> 2) & 15, wq = (int)rec & 3; const bool wcol = wl >= 13;
        const int wi = ((int)(CI0 >> (4 * wl)) & 15) + (wcol ? wq : 0), wj = ((int)(CJ0 >> (4 * wl)) & 15) + (wcol ? 0 : wq);
        const float rec_s = lperm(v1, rbase + wi) + lperm(yv, rbase + wj);
        const int rec_e = lperm(i1, rbase + wi) * 128 + lperm(yi, rbase + wj);
        float smax = rec_s; smax = fmaxf(smax, dppf<XOR1>(smax)); smax = fmaxf(smax, dppf<XOR2>(smax)); smax = fmaxf(smax, dppf<HMIR>(smax)); smax = fmaxf(smax, dppf<MIR>(smax));
        const float e = __builtin_amdgcn_exp2f((rec_s - smax) * LOG2E);
        const float tot = row16_sum(e);
        const size_t o = ((size_t)h * NTOK + (t0 + row)) * 16 + l15;
        eidx[o] = rec_e; egate[o] = e / tot;
    }
}

__device__ void topk_tile(const Frame& F, int pm, int h) {
    const int tok0 = pm * 256 + F.wid * 32;
    topk_rows(F, (const float*)(F.ws + WS_SC) + (size_t)tok0 * DM + h * 256, DM, tok0, h, 8);
}

__device__ void phase_pe(const Frame& F, int l) {
    const unsigned char* U4 = F.wl(l, WL_UB); const unsigned char* V4 = F.wl(l, WL_VB);
    const float* SU = (const float*)F.wl(l, WL_SU); const float* SV = (const float*)F.wl(l, WL_SV);
    const unsigned char* h2 = F.ws + WS_H2; const float* sh2 = (const float*)(F.ws + WS_SH2); const bf16_t* x1 = (const bf16_t*)(F.ws + WS_X1);
    const int* eidx = (const int*)(F.ws + WS_EIDX); const float* egate = (const float*)(F.ws + WS_EGATE);
    const float* mod = (const float*)(F.ws + WS_MOD) + (size_t)l * NBATCH * MODW;
    const float* modn = (const float*)(F.ws + WS_MOD) + (size_t)(l + 1) * NBATCH * MODW;
    const float* g = F.a->in[IN_LN2G] + (size_t)l * DM; const float* bb = F.a->in[IN_LN2B] + (size_t)l * DM;
    const bool last = (l == DEPTH - 1);
    float* xo = last ? F.a->out : (float*)(F.ws + WS_XCUR);
    const int lane = F.lane, l15 = lane & 15;
    LAS float* pl = (LAS float*)((LAS unsigned char*)F.lds + 16384);
    for (int tt = F.bid * 32 + F.wid * 4; tt < NTOK; tt += F.G * 32) {
      {   const int bq = tt / SEQ, c = F.tid * 4;
          __syncthreads();
          *(LAS f32x4*)(pl + c) = *(const f32x4*)(mod + (size_t)bq * MODW + 5 * DM + c) + 1.0f; *(LAS f32x4*)(pl + 2048 + c) = *(const f32x4*)(g + c); *(LAS f32x4*)(pl + 4096 + c) = *(const f32x4*)(bb + c);
          if (!last) { *(LAS f32x4*)(pl + 6144 + c) = *(const f32x4*)(modn + (size_t)bq * MODW + DM + c) + 1.0f; *(LAS f32x4*)(pl + 8192 + c) = *(const f32x4*)(modn + (size_t)bq * MODW + c); }
          __syncthreads(); }
      constexpr int NTK = 4;
      for (int t = tt; t < tt + 4; t += NTK) {
        __syncthreads();
        unsigned hA[NTK][4], hB[NTK][4]; float sh[NTK]; int hsum[NTK];
        int e0[NTK], e1[NTK]; float g0[NTK], g1[NTK];
#pragma unroll
        for (int tk = 0; tk < NTK; ++tk) {
            sh[tk] = sh2[t + tk]; int hs_ = 0; unsigned hq[8];
#pragma unroll
            for (int i = 0; i < 8; ++i) { hq[i] = *(const unsigned*)(h2 + (size_t)(t + tk) * DM + i * 256 + lane * 4); hs_ = __builtin_amdgcn_sdot4((int)hq[i], 0x01010101, hs_, false); }
            hsum[tk] = xrow_isum(row16_isum(hs_));
#pragma unroll
            for (int d = 0; d < 4; ++d) {
                const unsigned X = hq[2 * d], Y = hq[2 * d + 1];
                const unsigned uX = (X ^ 0x80808080u) + 0x08080808u, uY = (Y ^ 0x80808080u) + 0x08080808u;
                hB[tk][d] = (X & 0x0F0F0F0Fu) | ((Y & 0x0F0F0F0Fu) << 4);
                hA[tk][d] = (((uX >> 4) & 0x0F0F0F0Fu) ^ 0x08080808u) | ((((uY >> 4) & 0x0F0F0F0Fu) ^ 0x08080808u) << 4); }
            const size_t eo0 = ((size_t)(lane >> 4) * NTOK + (t + tk)) * 16 + l15, eo1 = eo0 + (size_t)4 * NTOK * 16;
            e0[tk] = eidx[eo0]; e1[tk] = eidx[eo1]; g0[tk] = egate[eo0]; g1[tk] = egate[eo1];
        }
#pragma unroll
        for (int tk = 0; tk < NTK; ++tk) {
            LAS unsigned* cnt = (LAS unsigned*)F.lds + F.wid * 512; LAS int* sid = (LAS int*)(cnt + 64); LAS float* sgt = (LAS float*)(cnt + 192);
            cnt[lane] = 0u;
            const int b0 = e0[tk] >> 8, b1 = e1[tk] >> 8;
            const unsigned p0 = __atomic_fetch_add(cnt + b0, 1u, __ATOMIC_RELAXED), p1 = __atomic_fetch_add(cnt + b1, 1u, __ATOMIC_RELAXED);
            const unsigned c = cnt[lane]; unsigned inc = c;
            inc += (unsigned)__builtin_amdgcn_update_dpp(0, (int)inc, 0x111, 0xf, 0xf, false); inc += (unsigned)__builtin_amdgcn_update_dpp(0, (int)inc, 0x112, 0xf, 0xf, false);
            inc += (unsigned)__builtin_amdgcn_update_dpp(0, (int)inc, 0x114, 0xf, 0xf, false); inc += (unsigned)__builtin_amdgcn_update_dpp(0, (int)inc, 0x118, 0xf, 0xf, false);
            inc += (unsigned)__builtin_amdgcn_update_dpp(0, (int)inc, 0x142, 0xa, 0xf, false); inc += (unsigned)__builtin_amdgcn_update_dpp(0, (int)inc, 0x143, 0xc, 0xf, false);
            cnt[lane] = inc - c;
            const unsigned d0 = cnt[b0] + p0, d1 = cnt[b1] + p1;
            sid[d0] = e0[tk]; sgt[d0] = g0[tk]; sid[d1] = e1[tk]; sgt[d1] = g1[tk];
            e0[tk] = sid[lane]; e1[tk] = sid[64 + lane]; g0[tk] = sgt[lane]; g1[tk] = sgt[64 + lane];
            asm volatile("s_waitcnt lgkmcnt(0)" ::: "memory");
        }
        int dA[NTK], dB[NTK]; float su0[NTK], su1[NTK], sv0[NTK], sv1[NTK];
#pragma unroll
        for (int tk = 0; tk < NTK; ++tk) { dA[tk] = 0; dB[tk] = 0; su0[tk] = SU[e0[tk]]; su1[tk] = SU[e1[tk]]; sv0[tk] = SV[e0[tk]]; sv1[tk] = SV[e1[tk]]; }
#pragma unroll 1
        for (int gi = 0; gi < 8; ++gi) {
#pragma unroll
          for (int tk = 0; tk < NTK; ++tk) {
            int stage = 0;
            u32x4 ub[16];
#pragma unroll
            for (int k = 0; k < 16; ++k) { const int slot = gi * 16 + k; const int e = __builtin_amdgcn_readlane(slot < 64 ? e0[tk] : e1[tk], slot & 63);
                ub[k] = *(const u32x4*)(U4 + (size_t)e * (DM / 2) + lane * 16); }
#pragma unroll
            for (int k = 0; k < 16; ++k) { int a0 = 0, a1 = 0; const unsigned w[4] = {ub[k].x, ub[k].y, ub[k].z, ub[k].w};
#pragma unroll
                for (int d = 0; d < 4; ++d) { a0 = __builtin_amdgcn_sdot8((int)w[d], (int)hA[tk][d], a0, false); a1 = __builtin_amdgcn_sdot8((int)w[d], (int)hB[tk][d], a1, false); }
                const int rs = row16_isum((a0 << 4) + a1);
                stage = (l15 == k) ? rs : stage; }
            const int dsum = xrow_isum(stage);
            const bool mine = (lane >> 4) == (gi & 3);
            if (gi < 4) dA[tk] = mine ? dsum : dA[tk]; else dB[tk] = mine ? dsum : dB[tk];
            asm volatile("" ::: "memory");
          }
        }
        LAS unsigned* cf = (LAS unsigned*)((LAS unsigned char*)F.lds + 57344 + F.wid * 1024);
#pragma unroll
        for (int tk = 0; tk < NTK; ++tk) {
            const float aA = g0[tk] * gelu_erf((float)(2 * dA[tk] + hsum[tk]) * (0.5f * su0[tk] * sh[tk])) * sv0[tk];
            const float aB = g1[tk] * gelu_erf((float)(2 * dB[tk] + hsum[tk]) * (0.5f * su1[tk] * sh[tk])) * sv1[tk];
            const float amx = wave_max(fmaxf(fabsf(aA), fabsf(aB)));
            const float sa_ = amx > 0.f ? amx * (1.0f / 127.0f) : 1.0f, sai = 1.0f / sa_;
            const int qA = (int)__builtin_rintf(aA * sai), qB = (int)__builtin_rintf(aB * sai);
            const int qsum_ = xrow_isum(row16_isum(qA + qB));
            const unsigned pkA_ = ((unsigned)dppu<0x00>((unsigned)qA) & 0xffu) | (((unsigned)dppu<0x55>((unsigned)qA) & 0xffu) << 8) | (((unsigned)dppu<0xAA>((unsigned)qA) & 0xffu) << 16) | ((unsigned)dppu<0xFF>((unsigned)qA) << 24);
            const unsigned pkB_ = ((unsigned)dppu<0x00>((unsigned)qB) & 0xffu) | (((unsigned)dppu<0x55>((unsigned)qB) & 0xffu) << 8) | (((unsigned)dppu<0xAA>((unsigned)qB) & 0xffu) << 16) | ((unsigned)dppu<0xFF>((unsigned)qB) << 24);
            if ((lane & 3) == 0) { cf[tk * 32 + (lane >> 2)] = pkA_; cf[tk * 32 + 16 + (lane >> 2)] = pkB_; }
            if (lane == 0) { cf[128 + tk] = __float_as_uint(sa_); cf[132 + tk] = (unsigned)qsum_; }
        }
        asm volatile("s_waitcnt lgkmcnt(0)" ::: "memory");
        {   constexpr int pr = 0;
        int yi[NTK][8][4];
#pragma unroll
        for (int tk = 0; tk < NTK; ++tk)
#pragma unroll
            for (int i = 0; i < 8; ++i)
#pragma unroll
                for (int j = 0; j < 4; ++j) yi[tk][i][j] = 0;
#pragma unroll 1
        for (int sb = 0; sb < 128; sb += 16) {
#pragma unroll
          for (int tk = 0; tk < NTK; ++tk) {
            u32x4 vb[16]; unsigned a4[4];
#pragma unroll
            for (int k = 0; k < 16; ++k) { const int slot = sb + k; const int e = __builtin_amdgcn_readlane(slot < 64 ? e0[pr + tk] : e1[pr + tk], slot & 63);
                vb[k] = *(const u32x4*)(V4 + (size_t)e * (DM / 2) + lane * 16); }
            { const u32x4 cq = *(const LAS u32x4*)(cf + (pr + tk) * 32 + (sb >> 2)); a4[0] = cq.x; a4[1] = cq.y; a4[2] = cq.z; a4[3] = cq.w; }
#pragma unroll
            for (int qd = 0; qd < 4; ++qd) {
#pragma unroll
                for (int d = 0; d < 4; ++d) {
                    const unsigned w1 = vb[4 * qd][d], w2 = vb[4 * qd + 1][d], w3 = vb[4 * qd + 2][d], w4 = vb[4 * qd + 3][d];
                    const unsigned p01 = __builtin_amdgcn_perm(w2, w1, 0x05010400u), p01h = __builtin_amdgcn_perm(w2, w1, 0x07030602u), p23 = __builtin_amdgcn_perm(w4, w3, 0x05010400u), p23h = __builtin_amdgcn_perm(w4, w3, 0x07030602u);
                    const unsigned t4[4] = {__builtin_amdgcn_perm(p23, p01, 0x05040100u), __builtin_amdgcn_perm(p23, p01, 0x07060302u), __builtin_amdgcn_perm(p23h, p01h, 0x05040100u), __builtin_amdgcn_perm(p23h, p01h, 0x07060302u)};
#pragma unroll
                    for (int j = 0; j < 4; ++j) {
                        yi[tk][2 * d][j] = __builtin_amdgcn_sdot4((int)(t4[j] & 0x0F0F0F0Fu), (int)a4[qd], yi[tk][2 * d][j], false);
                        yi[tk][2 * d + 1][j] = __builtin_amdgcn_sdot4((int)(t4[j] & 0xF0F0F0F0u), (int)a4[qd], yi[tk][2 * d + 1][j], false); }
                }
            }
            asm volatile("" ::: "memory");
          }
        }
#pragma unroll
        for (int tk = 0; tk < NTK; ++tk) {
        const int tq = t + pr + tk;
        float z[8][4]; float s = 0.f; const int qs_ = (int)cf[132 + pr + tk]; const float sa_ = __uint_as_float(cf[128 + pr + tk]); const int ybias = 15 * qs_; const float sah = 0.5f * sa_, sa16 = 0.0625f * sa_;
#pragma unroll
        for (int i = 0; i < 8; ++i) { const int c = i * 256 + lane * 4; const u32x2 xr = __builtin_nontemporal_load((const u32x2*)(x1 + (size_t)tq * DM + c)); const f32x4 xv = {bf_lo(xr.x), bf_hi(xr.x), bf_lo(xr.y), bf_hi(xr.y)}, gf1 = *(const LAS f32x4*)(pl + c);
#pragma unroll
            for (int j = 0; j < 4; ++j) { const float yy = (i & 1) ? sa16 * (float)(yi[tk][i][j] + 8 * qs_) : sah * (float)(2 * yi[tk][i][j] - ybias); const float zz = fmaf(ALPHA, xv[j], gf1[j] * yy); z[i][j] = zz; s += zz; } }
        const float mean = wave_sum(s) * (1.0f / DM); float qv = 0.f;
#pragma unroll
        for (int i = 0; i < 8; ++i)
#pragma unroll
            for (int j = 0; j < 4; ++j) { z[i][j] -= mean; qv += z[i][j] * z[i][j]; }
        const float rstd = __builtin_amdgcn_rsqf(wave_sum(qv) * (1.0f / DM) + LN_EPS);
        float hmax = 0.f;
#pragma unroll
        for (int i = 0; i < 8; ++i) { const int c = i * 256 + lane * 4; const f32x4 gg = *(const LAS f32x4*)(pl + 2048 + c), be = *(const LAS f32x4*)(pl + 4096 + c); f32x4 o4;
#pragma unroll
            for (int j = 0; j < 4; ++j) o4[j] = fmaf(z[i][j] * rstd, gg[j], be[j]);
            __builtin_nontemporal_store(o4, (f32x4*)(xo + (size_t)tq * DM + c));
            if (!last) { const f32x4 shv = *(const LAS f32x4*)(pl + 8192 + c), sc1 = *(const LAS f32x4*)(pl + 6144 + c);
#pragma unroll
                for (int j = 0; j < 4; ++j) { z[i][j] = fmaf(o4[j], sc1[j], shv[j]); hmax = fmaxf(hmax, fabsf(z[i][j])); } } }
        if (!last) {
            hmax = wave_max(hmax); const float hs = hmax > 0.f ? hmax * (1.0f / 6.0f) : 1.0f, hi = 1.0f / hs;
            unsigned char* hrow = F.ws + WS_H + (size_t)tq * (DM / 2);
#pragma unroll
            for (int i = 0; i < 8; ++i) *(unsigned short*)(hrow + i * 128 + lane * 2) = (unsigned short)(fp4_code(z[i][0] * hi) | (fp4_code(z[i][1] * hi) << 4) | (fp4_code(z[i][2] * hi) << 8) | (fp4_code(z[i][3] * hi) << 12));
            if (lane == 0) ((float*)(F.ws + WS_SH))[tq] = hs;
        }
        }
        }
    }
    }
}

constexpr int NPL = 7;
constexpr int N_PHASES = 1 + NPL * DEPTH;
__global__ void __launch_bounds__(NTHREADS, 2) mk_fwd(Args args) {
    extern __shared__ __attribute__((aligned(16))) unsigned char lds_raw[];
    Frame F; F.a = &args; F.ws = args.ws; F.lds = (char*)lds_raw; F.tid = threadIdx.x; F.lane = F.tid & 63; F.wid = __builtin_amdgcn_readfirstlane(F.tid >> 6); F.G = gridDim.x; F.bid = blockIdx.x;
    LAS unsigned char* ldsl = (LAS unsigned char*)lds_raw;
    volatile LAS unsigned* misc = (volatile LAS unsigned*)(ldsl + LDS_MISC);
    if (F.tid < 64) misc[F.tid] = 0u;
    __syncthreads();
    XcdBarrier bar; bar.bar = (unsigned*)(args.ws + WS_CTL); bar.x = 0; bar.st = misc;
    if (args.use_bar) bar = xcd_barrier_post((unsigned*)(args.ws + WS_CTL), misc);
    const int lo = args.ph_lo, hi = args.ph_hi;
#define REFRAME() do { int tz_ = threadIdx.x; asm volatile("" : "+v"(tz_)); F.tid = tz_; F.lane = tz_ & 63; F.wid = __builtin_amdgcn_readfirstlane(tz_ >> 6); } while (0)
#ifndef MK_PHMASK
#define MK_PHMASK 0x3ff
#endif
#define PHJ(j) ((MK_PHMASK >> (j)) & 1)
#ifndef MK_DUP
#define MK_DUP 0
#endif
#define DUPJ(j) ((MK_DUP >> (j)) & 1)
#define IN(k) (lo <= (k) && (k) < hi)
#define SEAM(k) do { if (args.use_bar && IN((k) + 1)) xcd_barrier(bar); } while (0)
    if (PHJ(0) && IN(0)) { REFRAME(); phase_c0(F); if (DUPJ(0)) { __syncthreads(); phase_c0(F); } SEAM(0); }
    for (int l = 0; l < DEPTH; ++l) {
        const int pb = 1 + NPL * l;
        if (PHJ(2) && IN(pb + 0)) {
            REFRAME();
            pg8::Gemm g{(const bf16_t*)(F.ws + WS_H), (const bf16_t*)F.wl(l, WL_WIN), DM / 4, DM / 4}; pg8::SchedG1 S; S.init(NTOK, INW, DM / 4, F.G, F.bid);
            pg8::EpiG1 E{(float*)(F.ws + WS_QKRAW), (bf16_t*)(F.ws + WS_QKVB), (unsigned char*)(F.ws + WS_GATES), (const float*)(F.ws + WS_SH), (const float*)F.wl(l, WL_SWIN)};
            pg8::gemm_phase(ldsl + LDS_RING, g, S, E); if (DUPJ(2)) pg8::gemm_phase(ldsl + LDS_RING, g, S, E);
            asm volatile("s_waitcnt vmcnt(0)" ::: "memory"); __syncthreads(); REFRAME();
            pg8::Unit u; for (int i = 0; S.next(i, u); ++i) if (u.pn < 5) norm_rope_tile(F, l, u.pm, u.pn);
            SEAM(pb + 0);
        }
        if (PHJ(3) && IN(pb + 1)) { REFRAME(); phase_att(F, l); if (DUPJ(3)) phase_att(F, l); SEAM(pb + 1); }
        if (PHJ(4) && IN(pb + 2)) {
            REFRAME();
            pg8::Gemm g{(const bf16_t*)(F.ws + WS_AO), (const bf16_t*)F.wl(l, WL_WP), AOW, AOW}; pg8::SchedSimple S; S.init(NTOK, DM, AOW, F.G, F.bid);
            pg8::EpiG2 E{(const unsigned char*)(F.ws + WS_GATES), (bf16_t*)(F.ws + WS_MERGED), (const float*)(F.ws + WS_LSEB), (float*)(F.lds + LDS_WTAB)};
            pg8::gemm_phase(ldsl + LDS_RING, g, S, E); if (DUPJ(5)) pg8::gemm_phase(ldsl + LDS_RING, g, S, E); SEAM(pb + 2);
        }
        if (PHJ(5) && IN(pb + 3)) {
            REFRAME();
            pg8::Gemm g{(const bf16_t*)(F.ws + WS_MERGED), (const bf16_t*)F.wl(l, WL_WO), DM, DM}; pg8::SchedSimple S; S.init(NTOK, DM, DM, F.G, F.bid);
            pg8::EpiG3 E{(const float*)(F.ws + WS_MOD) + (size_t)l * NBATCH * MODW + 2 * DM, (bf16_t*)(F.ws + WS_Z)};
            pg8::gemm_phase(ldsl + LDS_RING, g, S, E); if (DUPJ(6)) pg8::gemm_phase(ldsl + LDS_RING, g, S, E); SEAM(pb + 3);
        }
        if (PHJ(6) && IN(pb + 4)) { REFRAME(); phase_ln1(F, l); if (DUPJ(7)) phase_ln1(F, l); SEAM(pb + 4); }
        if (PHJ(7) && IN(pb + 5)) {
            REFRAME();
            pg8::Gemm g{(const bf16_t*)(F.ws + WS_H2), (const bf16_t*)F.wl(l, WL_WQK), DM / 2, DM / 2}; pg8::SchedSimple S; S.init(NTOK, DM, DM / 2, F.G, F.bid);
            pg8::EpiSC8 E{(float*)(F.ws + WS_SC), (const float*)(F.ws + WS_SH2), (const float*)F.wl(l, WL_SWQK), &F, (float*)F.lds};
            pg8::gemm_phase(ldsl + LDS_RING, g, S, E);
            asm volatile("s_waitcnt vmcnt(0)" ::: "memory"); __syncthreads(); REFRAME();
            pg8::Unit u, un; for (int i = 0; S.next(i, u); ++i) if (S.next(i + 1, un)) topk_tile(F, u.pm, u.pn);
            if (DUPJ(9)) { __syncthreads(); pg8::gemm_phase(ldsl + LDS_RING, g, S, E); }
            SEAM(pb + 5);
        }
        if (PHJ(8) && IN(pb + 6)) { REFRAME(); phase_pe(F, l); if (DUPJ(10)) phase_pe(F, l); SEAM(pb + 6); }
    }
#undef IN
#undef SEAM
}

extern "C" void kernel_launch(void* const* d_in, const int* in_sizes, int n_in, void* d_out, int out_size, void* d_ws, size_t ws_size, hipStream_t stream) {
    static int grid = 0;
    if (grid == 0) {
        if (n_in != 20 || out_size != NTOK * DM || ws_size < WS_END) { fprintf(stderr, "kernel_launch: unexpected shapes: n_in %d out %d ws %zu (need %zu)\n", n_in, out_size, ws_size, (size_t)WS_END); grid = -1; return; }
        int dev = 0, cus = 0, per_cu = 0;
        if (hipGetDevice(&dev) != hipSuccess || hipDeviceGetAttribute(&cus, hipDeviceAttributeMultiprocessorCount, dev) != hipSuccess) { grid = -1; return; }
        if (hipFuncSetAttribute((const void*)mk_fwd, hipFuncAttributeMaxDynamicSharedMemorySize, LDS_BYTES) != hipSuccess) { fprintf(stderr, "kernel_launch: hipFuncSetAttribute failed\n"); grid = -1; return; }
        if (hipOccupancyMaxActiveBlocksPerMultiprocessor(&per_cu, (const void*)mk_fwd, NTHREADS, LDS_BYTES) != hipSuccess || per_cu < 1) { fprintf(stderr, "kernel_launch: occupancy query reports %d\n", per_cu); (void)hipGetLastError(); }
        grid = cus;
    }
    if (grid < 0) return;
    (void)hipMemsetAsync((char*)d_ws + WS_CTL, 0, CTL_BYTES, stream);
    Args a{};
    for (int i = 0; i < 20; ++i) a.in[i] = (const float*)d_in[i];
    a.out = (float*)d_out; a.ws = (unsigned char*)d_ws; a.pad = 0;
#if MK_ONE_LAUNCH
    a.ph_lo = 0; a.ph_hi = N_PHASES; a.use_bar = 1;
    hipLaunchKernelGGL(mk_fwd, dim3(grid), dim3(NTHREADS), LDS_BYTES, stream, a);
#else
    for (int p = 0; p < N_PHASES; ++p) { a.ph_lo = p; a.ph_hi = p + 1; a.use_bar = 0; hipLaunchKernelGGL(mk_fwd, dim3(grid), dim3(NTHREADS), LDS_BYTES, stream, a); }
#endif
    const hipError_t le = hipPeekAtLastError();
    if (le != hipSuccess) fprintf(stderr, "kernel_launch: launch failed: %s\n", hipGetErrorName(le));
}
```

```cpp
#include <hip/hip_runtime.h>
#include <hip/hip_bf16.h>
#include <cstdio>
#include <cstdint>

#ifndef MK_ONE_LAUNCH
#define MK_ONE_LAUNCH 1
#endif

#define LAS __attribute__((address_space(3)))
typedef unsigned short bf16_t;
typedef short bf16x8 __attribute__((ext_vector_type(8)));
typedef short s16x4 __attribute__((ext_vector_type(4)));
typedef float f32x2 __attribute__((ext_vector_type(2)));
typedef float f32x4 __attribute__((ext_vector_type(4)));
typedef float f32x16 __attribute__((ext_vector_type(16)));
typedef unsigned u32x2 __attribute__((ext_vector_type(2)));
typedef unsigned u32x4 __attribute__((ext_vector_type(4)));
typedef __bf16 bf16x2v __attribute__((ext_vector_type(2)));
typedef int i32x4 __attribute__((ext_vector_type(4)));
typedef int i32x8 __attribute__((ext_vector_type(8)));

constexpr int DM = 2048, NBATCH = 2, SEQ = 4096, NTOK = NBATCH * SEQ, DEPTH = 2, HD = 128;
constexpr int INW = 11520, QKVW = 5376, GLW = 6144, QKRAWW = 1280, AOW = 2816, MODW = 6 * DM;
constexpr int COL_QA = 0, COL_KA = 1024, COL_VA = 1280, COL_QB = 1536, COL_KB = 2304, COL_VB = 3072, COL_QC = 3840, COL_KC = 4864, COL_VC = 5120;
constexpr int AO_A = 0, AO_B = 1024, AO_C = 1792;
constexpr int NEXP = 16384, PEER_HK = 128;
constexpr float LN_EPS = 1e-5f, QK_EPS = 1e-6f, ALPHA = 1.4142135623730951f, LOG2E = 1.4426950408889634f, LN2 = 0.6931471805599453f;
constexpr int NTHREADS = 512, NWAVES = 8;

constexpr size_t al256(size_t x) { return (x + 255) / 256 * 256; }
constexpr size_t WS_CTL = 0;
constexpr size_t CTL_BYTES = 65536;
constexpr size_t WS_MOD = WS_CTL + CTL_BYTES;
constexpr size_t WS_ROPE = WS_MOD + al256((size_t)DEPTH * NBATCH * MODW * 4);
constexpr size_t WS_LSEB = WS_ROPE + 64 * 32 * 2 * 4;
constexpr size_t WS_W0 = WS_LSEB + (size_t)NTOK * 8 * 4;
constexpr size_t WL_WIN = 0;
constexpr size_t WL_SWIN = WL_WIN + (size_t)INW * DM / 2;
constexpr size_t WL_WP = WL_SWIN + al256((size_t)INW * 4);
constexpr size_t WL_WO = WL_WP + (size_t)DM * AOW * 2;
constexpr size_t WL_WQK = WL_WO + (size_t)DM * DM * 2;
constexpr size_t WL_SWQK = WL_WQK + (size_t)DM * DM;
constexpr size_t WL_UB = WL_SWQK + (size_t)DM * 4;
constexpr size_t WL_VB = WL_UB + (size_t)NEXP * DM / 2;
constexpr size_t WL_SU = WL_VB + (size_t)NEXP * DM / 2;
constexpr size_t WL_SV = WL_SU + (size_t)NEXP * 4;
constexpr size_t WL_BYTES = WL_SV + (size_t)NEXP * 4;
constexpr size_t WS_H = WS_W0 + DEPTH * WL_BYTES;
constexpr size_t WS_SH = WS_H + (size_t)NTOK * DM / 2;
constexpr size_t WS_H2 = WS_SH + (size_t)NTOK * 4;
constexpr size_t WS_SH2 = WS_H2 + (size_t)NTOK * DM;
constexpr size_t WS_QKVB = WS_SH2 + (size_t)NTOK * 4;
constexpr size_t WS_QKRAW = WS_QKVB + (size_t)NTOK * QKVW * 2;
constexpr size_t WS_GATES = WS_QKRAW + (size_t)NTOK * QKRAWW * 4;
constexpr size_t WS_SC = WS_GATES;
constexpr size_t WS_AO = WS_GATES + (size_t)NTOK * GLW * 2;
constexpr size_t WS_MTMP = WS_AO + (size_t)NTOK * AOW * 2;
constexpr size_t WS_Z = WS_MTMP;
constexpr size_t WS_MERGED = WS_MTMP + (size_t)NTOK * DM * 4;
constexpr size_t WS_X1 = WS_MERGED + (size_t)NTOK * DM * 2;
constexpr size_t WS_XCUR = WS_X1 + (size_t)NTOK * DM * 4;
constexpr size_t WS_EIDX = WS_XCUR + (size_t)NTOK * DM * 4;
constexpr size_t WS_EGATE = WS_EIDX + (size_t)NTOK * 128 * 4;
constexpr size_t WS_END = WS_EGATE + (size_t)NTOK * 128 * 4;
static_assert(WS_SC + (size_t)NTOK * DM * 4 <= WS_AO, "SC alias must fit in GATES");

__device__ __forceinline__ unsigned cvtpk(float lo, float hi) { return __builtin_bit_cast(unsigned, __builtin_convertvector((f32x2){lo, hi}, bf16x2v)); }
__device__ __forceinline__ float bf_lo(unsigned w) { return __uint_as_float(w << 16); }
__device__ __forceinline__ float bf_hi(unsigned w) { return __uint_as_float(w & 0xffff0000u); }
__device__ __forceinline__ float dot2(unsigned a, unsigned b, float acc) { return __builtin_amdgcn_fdot2_f32_bf16(__builtin_bit_cast(bf16x2v, a), __builtin_bit_cast(bf16x2v, b), acc, false); }
template <int CTRL> __device__ __forceinline__ float dppf(float x) { return __builtin_bit_cast(float, __builtin_amdgcn_mov_dpp(__builtin_bit_cast(int, x), CTRL, 0xf, 0xf, true)); }
template <int CTRL> __device__ __forceinline__ unsigned dppu(unsigned x) { return (unsigned)__builtin_amdgcn_mov_dpp((int)x, CTRL, 0xf, 0xf, true); }
constexpr int XOR1 = 0xB1, XOR2 = 0x4E, HMIR = 0x141, MIR = 0x140;
__device__ __forceinline__ float row16_sum(float x) { x += dppf<XOR1>(x); x += dppf<XOR2>(x); x += dppf<HMIR>(x); x += dppf<MIR>(x); return x; }
__device__ __forceinline__ float xrow_sum(float x) {
    auto s = __builtin_amdgcn_permlane16_swap(__float_as_uint(x), __float_as_uint(x), false, false);
    x = __uint_as_float(s[0]) + __uint_as_float(s[1]);
    auto t = __builtin_amdgcn_permlane32_swap(__float_as_uint(x), __float_as_uint(x), false, false);
    return __uint_as_float(t[0]) + __uint_as_float(t[1]);
}
__device__ __forceinline__ float wave_sum(float x) { return xrow_sum(row16_sum(x)); }
__device__ __forceinline__ int lperm(int v, int src) { return __builtin_amdgcn_ds_bpermute(src << 2, v); }
__device__ __forceinline__ unsigned lperm(unsigned v, int src) { return (unsigned)__builtin_amdgcn_ds_bpermute(src << 2, (int)v); }
__device__ __forceinline__ float lperm(float v, int src) { return __int_as_float(__builtin_amdgcn_ds_bpermute(src << 2, __float_as_int(v))); }
__device__ __forceinline__ float wave_max(float x) {
    x = fmaxf(x, dppf<XOR1>(x)); x = fmaxf(x, dppf<XOR2>(x)); x = fmaxf(x, dppf<HMIR>(x)); x = fmaxf(x, dppf<MIR>(x));
    auto s = __builtin_amdgcn_permlane16_swap(__float_as_uint(x), __float_as_uint(x), false, false); x = fmaxf(__uint_as_float(s[0]), __uint_as_float(s[1]));
    auto t = __builtin_amdgcn_permlane32_swap(__float_as_uint(x), __float_as_uint(x), false, false); return fmaxf(__uint_as_float(t[0]), __uint_as_float(t[1]));
}
__device__ __forceinline__ int row16_isum(int x) { x += (int)dppu<XOR1>((unsigned)x); x += (int)dppu<XOR2>((unsigned)x); x += (int)dppu<HMIR>((unsigned)x); x += (int)dppu<MIR>((unsigned)x); return x; }
__device__ __forceinline__ int xrow_isum(int x) {
    auto s = __builtin_amdgcn_permlane16_swap((unsigned)x, (unsigned)x, false, false); x = (int)s[0] + (int)s[1];
    auto t = __builtin_amdgcn_permlane32_swap((unsigned)x, (unsigned)x, false, false); return (int)t[0] + (int)t[1];
}
__device__ __forceinline__ unsigned pack4_raw(float a, float b, float c, float d) {
    unsigned w = __builtin_amdgcn_cvt_pk_u8_f32(a, 0, 0u); w = __builtin_amdgcn_cvt_pk_u8_f32(b, 1, w); w = __builtin_amdgcn_cvt_pk_u8_f32(c, 2, w); return __builtin_amdgcn_cvt_pk_u8_f32(d, 3, w);
}
__device__ __forceinline__ unsigned pack4_u8(float a, float b, float c, float d) {
    unsigned w = __builtin_amdgcn_cvt_pk_u8_f32(__builtin_rintf(a + 128.f), 0, 0u); w = __builtin_amdgcn_cvt_pk_u8_f32(__builtin_rintf(b + 128.f), 1, w);
    w = __builtin_amdgcn_cvt_pk_u8_f32(__builtin_rintf(c + 128.f), 2, w); return __builtin_amdgcn_cvt_pk_u8_f32(__builtin_rintf(d + 128.f), 3, w);
}
__device__ __forceinline__ float gelu_erf(float v) {
    const float av = fabsf(v), t = __builtin_amdgcn_rcpf(fmaf(av, 0.2316418882f, 1.0f));
    float q = fmaf(t, 0.5307027145f, -0.7265760135f); q = fmaf(q, t, 0.7107068705f); q = fmaf(q, t, -0.142248368f); q = fmaf(q, t, 0.127414796f); q = q * t;
    const float e = __builtin_amdgcn_exp2f(v * v * -0.72134752044f);
    const float m = v * (q * e);
    return v < 0.f ? m : v - m;
}
__device__ __forceinline__ void ld8f(const float* p, float (&v)[8]) { const f32x4 a = *(const f32x4*)p, b = *(const f32x4*)(p + 4); v[0] = a[0]; v[1] = a[1]; v[2] = a[2]; v[3] = a[3]; v[4] = b[0]; v[5] = b[1]; v[6] = b[2]; v[7] = b[3]; }
__device__ __forceinline__ void st8f(float* p, const float (&v)[8]) { *(f32x4*)p = (f32x4){v[0], v[1], v[2], v[3]}; *(f32x4*)(p + 4) = (f32x4){v[4], v[5], v[6], v[7]}; }
__device__ __forceinline__ u32x4 pack8(const float (&v)[8]) { return (u32x4){cvtpk(v[0], v[1]), cvtpk(v[2], v[3]), cvtpk(v[4], v[5]), cvtpk(v[6], v[7])}; }

#define XB_TMO      128
#define XB_XCNT(j)  (256  + 64 * (j))
#define XB_XSUB(j)  (1280 + 64 * (j))
#define XB_XGEN(j)  (2304 + 64 * (j))
#define XB_TOP      3328
#define XB_TOPGEN   3392
#define XCD_BAR_WORDS 3456
#define XB_MODCNT   3520
#define XB_SPIN_CAP (1u << 22)
__device__ __forceinline__ unsigned xb_ld(unsigned* p)              { return __hip_atomic_load(p, __ATOMIC_RELAXED, __HIP_MEMORY_SCOPE_AGENT); }
__device__ __forceinline__ unsigned xb_add(unsigned* p, unsigned v) { return __hip_atomic_fetch_add(p, v, __ATOMIC_RELAXED, __HIP_MEMORY_SCOPE_AGENT); }
__device__ __forceinline__ unsigned xb_xcc_id() { return (unsigned)__builtin_amdgcn_s_getreg((3 << 11) | 20) & 0xFu; }
#define XB_SPIN(cond, bar) do { unsigned _sp = 0; while (cond) { __builtin_amdgcn_s_sleep(1); \
    if ((++_sp & 255u) == 0u) { if (xb_ld(&(bar)[XB_TMO])) break; if (_sp > XB_SPIN_CAP) { atomicAdd(&(bar)[XB_TMO], 1u); break; } } } } while (0)
struct XcdBarrier { unsigned* bar; unsigned x; volatile LAS unsigned* st; };
__device__ __forceinline__ XcdBarrier xcd_barrier_post(unsigned* bar, volatile LAS unsigned* st) {
    XcdBarrier b; b.bar = bar; b.x = xb_xcc_id(); b.st = st;
    if (threadIdx.x == 0) (void)xb_add(&bar[XB_XCNT(b.x)], 1u);
    return b;
}
__device__ __forceinline__ void xcd_barrier_complete(unsigned* bar, unsigned x, unsigned& nloc, unsigned& nx) {
    const unsigned G = gridDim.x * gridDim.y * gridDim.z;
    unsigned sum, cnt, mine, sp = 0u;
    for (;;) {
        sum = 0u; cnt = 0u; mine = 0u;
#pragma unroll
        for (unsigned j = 0; j < 16; ++j) { const unsigned c = xb_ld(&bar[XB_XCNT(j)]); sum += c; cnt += (c > 0u) ? 1u : 0u; mine = (j == x) ? c : mine; }
        if (sum == G) break;
        __builtin_amdgcn_s_sleep(1);
        if ((++sp & 255u) == 0u) { if (xb_ld(&bar[XB_TMO])) break; if (sp > XB_SPIN_CAP) { atomicAdd(&bar[XB_TMO], 1u); break; } }
    }
    nloc = mine > 0u ? mine : 1u; nx = cnt > 0u ? cnt : 1u;
}
__device__ __forceinline__ void xcd_barrier(const XcdBarrier& b) {
    asm volatile("s_waitcnt vmcnt(0)" ::: "memory");
    __syncthreads();
    if (threadIdx.x == 0) {
        unsigned* bar = b.bar;
        __builtin_amdgcn_s_waitcnt(0);
        unsigned nloc = b.st[0], nx = b.st[1];
        if (nloc == 0u) { xcd_barrier_complete(bar, b.x, nloc, nx); b.st[0] = nloc; b.st[1] = nx; }
        const unsigned old = xb_add(&bar[XB_XSUB(b.x)], 1u);
        const unsigned gen = old / nloc;
        if (old + 1u == (gen + 1u) * nloc) {
            __builtin_amdgcn_fence(__ATOMIC_RELEASE, "agent");
            asm volatile("s_waitcnt vmcnt(0)" ::: "memory");
            const unsigned og = xb_add(&bar[XB_TOP], 1u);
            const unsigned tg = og / nx;
            if (og + 1u == (tg + 1u) * nx) xb_add(&bar[XB_TOPGEN], 1u);
            else XB_SPIN(xb_ld(&bar[XB_TOPGEN]) == tg, bar);
            __builtin_amdgcn_fence(__ATOMIC_ACQUIRE, "agent");
            xb_add(&bar[XB_XGEN(b.x)], 1u);
            asm volatile("s_waitcnt vmcnt(0)" ::: "memory");
        } else {
            XB_SPIN(xb_ld(&bar[XB_XGEN(b.x)]) == gen, bar);
            __builtin_amdgcn_fence(__ATOMIC_ACQUIRE, "agent");
            asm volatile("s_waitcnt vmcnt(0)" ::: "memory");
        }
    }
    __syncthreads();
}

struct Frame;
__device__ __forceinline__ void topk_rows(const Frame& F, const float* rows, int pitch, int tok0, int h, int nit);
namespace pg8 {
constexpr int BM = 256, BK = 64, HALF = 128, HTB = HALF * BK * 2, STAGE_BYTES = 8 * HTB, NXCD = 8, WGM = 8;
__host__ __device__ __forceinline__ int lds_byte(int r, int c) { const int st = (r >> 4) * 2 + (c >> 5), rr = r & 15, cc = c & 31, ob = rr * 64 + cc * 2; return st * 1024 + (ob ^ (((ob >> 9) & 1) << 5)); }
__host__ __device__ __forceinline__ void stage_rc(int b, int& R, int& C) { const int st = b / 1024, sb = b % 1024, swz = sb ^ (((sb >> 9) & 1) << 5); R = (st >> 1) * 16 + swz / 64; C = (st & 1) * 32 + (swz % 64) / 2; }
__host__ __device__ __forceinline__ int perm32(int rho) { const int n = rho >> 4, i = rho & 15; return 8 * (i >> 2) + 4 * n + (i & 3); }
struct Unit { int pm, pn, koff, nt, aux; };
struct Gemm { const bf16_t* A; const bf16_t* Bt; int lda, ldb; };
struct TileOrder {
    int nM, nN, nwg;
    __device__ void init(int M, int N) { nM = M / BM; nN = N / BM; nwg = nM * nN; }
    __device__ bool tile(long L, int& pm, int& pn) const {
        if (L >= nwg) return false;
        int wgid = (int)L; { const int q = nwg / NXCD, r = nwg % NXCD, xcd = wgid % NXCD, off = wgid / NXCD; wgid = (xcd < r ? xcd * (q + 1) : r * (q + 1) + (xcd - r) * q) + off; }
        const int nig = WGM * nN, gid = wgid / nig, fm = gid * WGM, gsz = (nM - fm) < WGM ? (nM - fm) : WGM;
        pm = fm + ((wgid % nig) % gsz); pn = (wgid % nig) / gsz; return true;
    }
};
struct SchedSimple {
    TileOrder T; int G, c, nt;
    __device__ void init(int M, int N, int K, int G_, int c_) { T.init(M, N); G = G_; c = c_; nt = K / BK; }
    __device__ bool next(int i, Unit& u) const { if (!T.tile((long)i * G + c, u.pm, u.pn)) return false; u.koff = 0; u.nt = nt; u.aux = 0; return true; }
};
struct SchedG1 {
    SchedSimple S0; int x, j; bool bal;
    __device__ void init(int M, int N, int K, int G_, int c_) { S0.init(M, N, K, G_, c_); bal = (G_ == 256 && M == 32 * BM && N == 45 * BM); x = c_ & 7; j = c_ >> 3; }
    __device__ bool next(int i, Unit& u) const {
        if (!bal) return S0.next(i, u);
        int o;
        if (j < 20) { if (i >= 6) return false; o = i * 20 + j; }
        else { const int jb = j - 20, no = jb < 4 ? 4 : 3;
            if (i >= 5) return false;
            o = i < no ? 120 + i * 12 + jb : 160 + (jb < 4 ? jb : 4 + (jb - 4) * 2 + (i - no)); }
        if (o < 160) { u.pn = 5 + (o >> 2); u.pm = 4 * x + (o & 3); } else { u.pn = (o - 160) >> 2; u.pm = 4 * x + ((o - 160) & 3); }
        u.koff = 0; u.nt = S0.nt; u.aux = 0; return true;
    }
};
template <class Epi, class Sched>
__device__ __forceinline__ void gemm_phase(LAS unsigned char* lds, const Gemm g, const Sched& S, const Epi& E) {
    int tid = threadIdx.x; asm volatile("" : "+v"(tid));
    const int wid = __builtin_amdgcn_readfirstlane(tid >> 6), lane = tid & 63, wr = wid >> 2, wc = wid & 3, fr = lane & 15, fq = lane >> 4;
    unsigned voffA[2], voffB[2];
#pragma unroll
    for (int i = 0; i < 2; ++i) { int R, C; stage_rc(tid * 16 + i * 8192, R, C); const int Rb = Epi::PERM ? ((R & ~31) + perm32(R & 31)) : R;
        voffA[i] = (unsigned)(R * g.lda + C) * 2u; voffB[i] = (unsigned)(Rb * g.ldb + C) * 2u; }
    const size_t kstep = (size_t)(BK * 2);
    const size_t hstepA = (size_t)HALF * g.lda * 2, hstepB = (size_t)HALF * g.ldb * 2;
    const unsigned ldsw = (unsigned)wid * 1024u;
    const int aoff = lds_byte(wr * 64 + fr, fq * 8), boff = lds_byte(wc * 32 + fr, fq * 8);
#define PG8_SA(b, h) (((b) * 2 + (h)) * HTB)
#define PG8_SB(b, h) ((4 + (b) * 2 + (h)) * HTB)
#define PG8_STAGE(bufoff, gbase, voff) do { _Pragma("unroll") for (int _i = 0; _i < 2; ++_i) \
        __builtin_amdgcn_global_load_lds((const unsigned*)((const char*)(gbase) + (voff)[_i]), (LAS unsigned*)(lds + (bufoff) + ldsw + _i * 8192), 16, 0, 0); } while (0)
#define PG8_LDA(dst, b, h) do { _Pragma("unroll") for (int m = 0; m < 4; ++m) _Pragma("unroll") for (int k = 0; k < 2; ++k) dst[m][k] = *(const LAS bf16x8*)(lds + PG8_SA(b, h) + aoff + m * 2048 + k * 1024); } while (0)
#define PG8_LDB(dst, b, h) do { _Pragma("unroll") for (int n = 0; n < 2; ++n) _Pragma("unroll") for (int k = 0; k < 2; ++k) dst[n][k] = *(const LAS bf16x8*)(lds + PG8_SB(b, h) + boff + n * 2048 + k * 1024); } while (0)
#define PG8_MMA(ai, bj, At, Bt) do { __builtin_amdgcn_s_setprio(1); _Pragma("unroll") for (int m = 0; m < 4; ++m) _Pragma("unroll") for (int n = 0; n < 2; ++n) _Pragma("unroll") for (int k = 0; k < 2; ++k) \
        acc[ai][bj][m][n] = Epi::mma(Bt[n][k], At[m][k], acc[ai][bj][m][n]); __builtin_amdgcn_s_setprio(0); } while (0)
#define PG8_WAIT_V(n) asm volatile("s_waitcnt vmcnt(" #n ")" ::: "memory")
#define PG8_WAIT_L(n) asm volatile("s_waitcnt lgkmcnt(" #n ")" ::: "memory")
#define PG8_BAR __builtin_amdgcn_s_barrier()
#define PG8_SCHED __builtin_amdgcn_sched_barrier(0)
    Unit cur, nxt; int ui = 0;
    if (!S.next(0, cur)) return;
    typedef typename Epi::acc_t acc_t;
    acc_t acc[2][2][4][2];
#pragma unroll
    for (int a = 0; a < 2; ++a)
#pragma unroll
        for (int b = 0; b < 2; ++b)
#pragma unroll
            for (int m = 0; m < 4; ++m)
#pragma unroll
                for (int n = 0; n < 2; ++n) acc[a][b][m][n] = (acc_t){0, 0, 0, 0};
    bf16x8 At[4][2], B0[2][2], B1[2][2];
    const char* cA = (const char*)g.A + ((size_t)cur.pm * BM * g.lda + cur.koff) * 2; const char* cB = (const char*)g.Bt + ((size_t)cur.pn * BM * g.ldb + cur.koff) * 2;
    PG8_STAGE(PG8_SB(0, 0), cB, voffB); PG8_STAGE(PG8_SA(0, 0), cA, voffA); PG8_STAGE(PG8_SB(0, 1), cB + hstepB, voffB); PG8_STAGE(PG8_SA(0, 1), cA + hstepA, voffA);
    if (wr == 1) PG8_BAR;
    PG8_WAIT_V(4); PG8_BAR;
    PG8_STAGE(PG8_SB(1, 0), cB + kstep, voffB); PG8_STAGE(PG8_SA(1, 0), cA + kstep, voffA); PG8_STAGE(PG8_SB(1, 1), cB + hstepB + kstep, voffB);
    PG8_WAIT_V(6); PG8_BAR;
    for (;;) {
        const bool has_next = S.next(ui + 1, nxt);
        const char* nA = has_next ? (const char*)g.A + ((size_t)nxt.pm * BM * g.lda + nxt.koff) * 2 : cA; const char* nB = has_next ? (const char*)g.Bt + ((size_t)nxt.pn * BM * g.ldb + nxt.koff) * 2 : cB;
        const int nt = cur.nt;
        for (int t = 0; t < nt; t += 2) {
            if constexpr (Epi::HAS_MID) { if (E.mid_at(t)) E.mid(acc, cur, t, wr, wc, fr, fq); }
            const bool last = (t == nt - 2);
            const char* a1 = cA + (size_t)(t + 1) * kstep;
            const char* a2 = last ? nA : cA + (size_t)(t + 2) * kstep; const char* b2 = last ? nB : cB + (size_t)(t + 2) * kstep;
            const char* a3 = a2 + kstep; const char* b3 = b2 + kstep;
            PG8_LDB(B0, 0, 0); PG8_SCHED; PG8_LDA(At, 0, 0); PG8_STAGE(PG8_SA(1, 1), a1 + hstepA, voffA);
            PG8_WAIT_L(8); PG8_BAR; PG8_WAIT_L(0); PG8_MMA(0, 0, At, B0); PG8_BAR; PG8_SCHED;
            PG8_LDB(B1, 0, 1); PG8_STAGE(PG8_SB(0, 0), b2, voffB);
            PG8_BAR; PG8_WAIT_L(0); PG8_MMA(0, 1, At, B1); PG8_BAR;
            PG8_LDA(At, 0, 1); PG8_STAGE(PG8_SA(0, 0), a2, voffA);
            PG8_BAR; PG8_WAIT_L(0); PG8_MMA(1, 0, At, B0); PG8_BAR; PG8_SCHED;
            PG8_STAGE(PG8_SB(0, 1), b2 + hstepB, voffB);
            PG8_WAIT_V(6); PG8_BAR; PG8_MMA(1, 1, At, B1); PG8_BAR;
            PG8_LDB(B0, 1, 0); PG8_SCHED; PG8_LDA(At, 1, 0); PG8_STAGE(PG8_SA(0, 1), a2 + hstepA, voffA);
            PG8_WAIT_L(8); PG8_BAR; PG8_WAIT_L(0); PG8_MMA(0, 0, At, B0); PG8_BAR; PG8_SCHED;
            PG8_LDB(B1, 1, 1); PG8_STAGE(PG8_SB(1, 0), b3, voffB);
            PG8_BAR; PG8_WAIT_L(0); PG8_MMA(0, 1, At, B1); PG8_BAR;
            PG8_LDA(At, 1, 1); PG8_STAGE(PG8_SA(1, 0), a3, voffA);
            PG8_BAR; PG8_WAIT_L(0); PG8_MMA(1, 0, At, B0); PG8_BAR; PG8_SCHED;
            PG8_STAGE(PG8_SB(1, 1), b3 + hstepB, voffB);
            PG8_WAIT_V(6); PG8_BAR; PG8_MMA(1, 1, At, B1); PG8_BAR;
        }
        if constexpr (Epi::AFTER_DRAIN) { if (has_next) E(acc, cur, wr, wc, fr, fq); } else E(acc, cur, wr, wc, fr, fq);
        if (!has_next) break;
#pragma unroll
        for (int a = 0; a < 2; ++a)
#pragma unroll
            for (int b = 0; b < 2; ++b)
#pragma unroll
                for (int m = 0; m < 4; ++m)
#pragma unroll
                    for (int n = 0; n < 2; ++n) acc[a][b][m][n] = (acc_t){0, 0, 0, 0};
        cur = nxt; cA = nA; cB = nB; ++ui;
    }
    PG8_WAIT_V(0);
    if (wr == 0) PG8_BAR;
    PG8_BAR;
    if constexpr (Epi::AFTER_DRAIN) E.fused(acc, cur, wr, wc, fr, fq);
#undef PG8_SA
#undef PG8_SB
#undef PG8_STAGE
#undef PG8_LDA
#undef PG8_LDB
#undef PG8_MMA
#undef PG8_WAIT_V
#undef PG8_WAIT_L
#undef PG8_BAR
#undef PG8_SCHED
}

struct EpiG1 {
    static constexpr bool PERM = true; static constexpr bool HAS_MID = false; static constexpr bool AFTER_DRAIN = false;
    typedef f32x4 acc_t;
    static __device__ __forceinline__ f32x4 mma(bf16x8 b, bf16x8 a, f32x4 c) {
        const i32x4 bb = __builtin_bit_cast(i32x4, b), aa = __builtin_bit_cast(i32x4, a);
        const i32x8 B8 = {bb[0], bb[1], bb[2], bb[3], 0, 0, 0, 0}, A8 = {aa[0], aa[1], aa[2], aa[3], 0, 0, 0, 0};
        return __builtin_amdgcn_mfma_scale_f32_16x16x128_f8f6f4(B8, A8, c, 4, 4, 0, 0x7F7F7F7F, 0, 0x7F7F7F7F);
    }
    float* qkraw; bf16_t* qkvb; unsigned char* gates; const float* sh; const float* sw;
    __device__ __forceinline__ void operator()(const f32x4 (&acc)[2][2][4][2], const Unit& u, int wr, int wc, int fr, int fq) const {
        const int row0 = u.pm * BM + wr * 64 + fr, colt = wc * 32 + 8 * fq, pn = u.pn;
        f32x4 cw[2][2];
#pragma unroll
        for (int bj = 0; bj < 2; ++bj) { cw[bj][0] = *(const f32x4*)(sw + pn * BM + bj * HALF + colt); cw[bj][1] = *(const f32x4*)(sw + pn * BM + bj * HALF + colt + 4); }
        f32x4 cwl[2][2];
#pragma unroll
        for (int bj = 0; bj < 2; ++bj) { cwl[bj][0] = cw[bj][0] * -LOG2E; cwl[bj][1] = cw[bj][1] * -LOG2E; }
#pragma unroll
        for (int ai = 0; ai < 2; ++ai)
#pragma unroll
            for (int m = 0; m < 4; ++m) {
                const size_t row = (size_t)(row0 + ai * HALF + m * 16);
                const float rs = sh[row];
                if (pn >= 21) {
                    unsigned w[4];
#pragma unroll
                    for (int bj = 0; bj < 2; ++bj) { const f32x4 v0 = acc[ai][bj][m][0] * cwl[bj][0] * rs, v1 = acc[ai][bj][m][1] * cwl[bj][1] * rs; float sg[8];
#pragma unroll
                        for (int j = 0; j < 4; ++j) { sg[j] = __builtin_rintf(__builtin_amdgcn_rcpf(fmaf(__builtin_amdgcn_exp2f(v0[j]), 1.0f / 255.0f, 1.0f / 255.0f))); sg[4 + j] = __builtin_rintf(__builtin_amdgcn_rcpf(fmaf(__builtin_amdgcn_exp2f(v1[j]), 1.0f / 255.0f, 1.0f / 255.0f))); }
                        w[2 * bj] = pack4_raw(sg[0], sg[1], sg[2], sg[3]); w[2 * bj + 1] = pack4_raw(sg[4], sg[5], sg[6], sg[7]); }
                    *(u32x4*)(gates + row * GLW + (pn - 21) * BM + (wc * 4 + fq) * 16) = (u32x4){w[0], w[1], w[2], w[3]};
                } else {
#pragma unroll
                for (int bj = 0; bj < 2; ++bj) {
                    const f32x4 v0 = acc[ai][bj][m][0] * cw[bj][0] * rs, v1 = acc[ai][bj][m][1] * cw[bj][1] * rs;
                    const int col = pn * BM + bj * HALF + colt;
                    if (pn < 5) { float* p = qkraw + row * QKRAWW + col; *(f32x4*)p = v0; *(f32x4*)(p + 4) = v1; }
                    else { u32x4 w; w.x = cvtpk(v0[0], v0[1]); w.y = cvtpk(v0[2], v0[3]); w.z = cvtpk(v1[0], v1[1]); w.w = cvtpk(v1[2], v1[3]); *(u32x4*)(qkvb + row * QKVW + col) = w; }
                }
                }
            }
    }
};
struct EpiG2 {
    static constexpr bool PERM = true; static constexpr bool HAS_MID = true; static constexpr bool AFTER_DRAIN = false;
    typedef f32x4 acc_t;
    static __device__ __forceinline__ f32x4 mma(bf16x8 b, bf16x8 a, f32x4 c) { return __builtin_amdgcn_mfma_f32_16x16x32_bf16(b, a, c, 0, 0, 0); }
    const unsigned char* gates; bf16_t* merged; const float* lse; float* wtab;
    static __device__ __forceinline__ float gb(unsigned w, int k) { return fmaxf((float)((w >> (8 * k)) & 0xffu), 0.25f); }
    __device__ __forceinline__ bool mid_at(int t) const { return t >= 16 && t <= 28; }
    __device__ __forceinline__ void mid(f32x4 (&acc)[2][2][4][2], const Unit& u, int t, int, int, int, int) const {
        int tz = threadIdx.x; asm volatile("" : "+v"(tz));
        const int wid = tz >> 6, lane = tz & 63, wr = wid >> 2, wc = wid & 3, fr = lane & 15, fq = lane >> 4;
        float* tab = wtab + wid * 768;
        if (t == 16) {
#pragma unroll
            for (int k = 0; k < 4; ++k) { const int p = lane + 64 * k, ti = p >> 1, hg = p & 1, row = (ti >> 6) * HALF + wr * 64 + ((ti >> 4) & 3) * 16 + (ti & 15), tok = u.pm * BM + row, bb = tok / SEQ, sq = tok % SEQ;
                const float a0 = lse[(size_t)hg * NTOK + (size_t)bb * SEQ + sq], a1 = lse[(size_t)(2 + hg) * NTOK + ((size_t)(bb * 4 + (sq & 3))) * (SEQ / 4) + (sq >> 2)], a2 = lse[(size_t)(4 + hg) * NTOK + ((size_t)(bb * 16 + (sq & 15))) * (SEQ / 16) + (sq >> 4)];
                const float mx = fmaxf(a0, fmaxf(a1, a2)); const float e0 = __builtin_amdgcn_exp2f((a0 - mx) * LOG2E), e1 = __builtin_amdgcn_exp2f((a1 - mx) * LOG2E), e2 = __builtin_amdgcn_exp2f((a2 - mx) * LOG2E);
                const float inv = 1.0f / (e0 + e1 + e2); tab[ti * 6 + hg] = fmaxf(e0 * inv, 1e-30f); tab[ti * 6 + 2 + hg] = fmaxf(e1 * inv, 1e-30f); tab[ti * 6 + 4 + hg] = fmaxf(e2 * inv, 1e-30f); }
            asm volatile("s_waitcnt lgkmcnt(0)" ::: "memory");
        }
        {   const int h = (t - 16) >> 1;
#pragma unroll
            for (int ai = 0; ai < 2; ++ai)
#pragma unroll
                for (int m = 0; m < 4; ++m) { const float* e = tab + ((ai * 4 + m) * 16 + fr) * 6;
                    const float rf = h == 0 ? __builtin_amdgcn_rcpf(e[0]) : (h == 6 ? e[5] : e[h - 1] * __builtin_amdgcn_rcpf(e[h]));
#pragma unroll
                    for (int bj = 0; bj < 2; ++bj) { acc[ai][bj][m][0] *= rf; acc[ai][bj][m][1] *= rf; } }
            if (t != 16 && t != 28) return;
        }
        const int row0 = u.pm * BM + wr * 64 + fr, gcol = u.pn * BM + (wc * 4 + fq) * 16, br = t == 16 ? 0 : 1;
#pragma unroll
        for (int ai = 0; ai < 2; ++ai)
#pragma unroll
            for (int m = 0; m < 4; ++m) {
                const size_t row = (size_t)(row0 + ai * HALF + m * 16);
                const u32x4 gaq = *(const u32x4*)(gates + row * GLW + br * DM + gcol), gnq = *(const u32x4*)(gates + row * GLW + (br + 1) * DM + gcol);
#pragma unroll
                for (int bj = 0; bj < 2; ++bj) {
                    const unsigned gax = bj ? gaq.z : gaq.x, gay = bj ? gaq.w : gaq.y, gnx = bj ? gnq.z : gnq.x, gny = bj ? gnq.w : gnq.y;
                    const float a0 = br == 0 ? (float)(gax & 0xffu) : gb(gax, 0), a1 = br == 0 ? (float)((gax >> 8) & 0xffu) : gb(gax, 1), a2 = br == 0 ? (float)((gax >> 16) & 0xffu) : gb(gax, 2), a3 = br == 0 ? (float)(gax >> 24) : gb(gax, 3);
                    const float a4 = br == 0 ? (float)(gay & 0xffu) : gb(gay, 0), a5 = br == 0 ? (float)((gay >> 8) & 0xffu) : gb(gay, 1), a6 = br == 0 ? (float)((gay >> 16) & 0xffu) : gb(gay, 2), a7 = br == 0 ? (float)(gay >> 24) : gb(gay, 3);
                    acc[ai][bj][m][0] *= (f32x4){a0 * __builtin_amdgcn_rcpf(gb(gnx, 0)), a1 * __builtin_amdgcn_rcpf(gb(gnx, 1)), a2 * __builtin_amdgcn_rcpf(gb(gnx, 2)), a3 * __builtin_amdgcn_rcpf(gb(gnx, 3))};
                    acc[ai][bj][m][1] *= (f32x4){a4 * __builtin_amdgcn_rcpf(gb(gny, 0)), a5 * __builtin_amdgcn_rcpf(gb(gny, 1)), a6 * __builtin_amdgcn_rcpf(gb(gny, 2)), a7 * __builtin_amdgcn_rcpf(gb(gny, 3))};
                }
            }
    }
    __device__ __forceinline__ void operator()(const f32x4 (&acc)[2][2][4][2], const Unit& u, int wr, int wc, int fr, int fq) const {
        const int row0 = u.pm * BM + wr * 64 + fr, colt = u.pn * BM + wc * 32 + 8 * fq, gcol = u.pn * BM + (wc * 4 + fq) * 16;
        constexpr float K = 1.0f / 255.0f;
#pragma unroll
        for (int ai = 0; ai < 2; ++ai)
#pragma unroll
            for (int m = 0; m < 4; ++m) {
                const size_t row = (size_t)(row0 + ai * HALF + m * 16);
                const u32x4 gq = *(const u32x4*)(gates + row * GLW + 2 * DM + gcol);
#pragma unroll
                for (int bj = 0; bj < 2; ++bj) {
                    const int col = colt + bj * HALF;
                    const unsigned gx = bj ? gq.z : gq.x, gy = bj ? gq.w : gq.y;
                    const f32x4 v0 = acc[ai][bj][m][0], v1 = acc[ai][bj][m][1];
                    const float r[8] = {gb(gx, 0) * K * v0[0], gb(gx, 1) * K * v0[1], gb(gx, 2) * K * v0[2], gb(gx, 3) * K * v0[3], gb(gy, 0) * K * v1[0], gb(gy, 1) * K * v1[1], gb(gy, 2) * K * v1[2], gb(gy, 3) * K * v1[3]};
                    *(u32x4*)(merged + row * DM + col) = pack8(r);
                }
            }
    }
};
struct EpiG3 {
    static constexpr bool PERM = true; static constexpr bool HAS_MID = false; static constexpr bool AFTER_DRAIN = false;
    typedef f32x4 acc_t;
    static __device__ __forceinline__ f32x4 mma(bf16x8 b, bf16x8 a, f32x4 c) { return __builtin_amdgcn_mfma_f32_16x16x32_bf16(b, a, c, 0, 0, 0); }
    const float* ga  ; bf16_t* y;
    __device__ __forceinline__ void operator()(const f32x4 (&acc)[2][2][4][2], const Unit& u, int wr, int wc, int fr, int fq) const {
        const int row0 = u.pm * BM + wr * 64 + fr, colt = u.pn * BM + wc * 32 + 8 * fq;
        const float* gab = ga + (size_t)((u.pm * BM) / SEQ) * MODW;
        f32x4 gv[2][2];
#pragma unroll
        for (int bj = 0; bj < 2; ++bj) { gv[bj][0] = *(const f32x4*)(gab + colt + bj * HALF) + 1.0f; gv[bj][1] = *(const f32x4*)(gab + colt + bj * HALF + 4) + 1.0f; }
#pragma unroll
        for (int ai = 0; ai < 2; ++ai)
#pragma unroll
            for (int m = 0; m < 4; ++m) { const size_t ro = (size_t)(row0 + ai * HALF + m * 16) * DM + colt;
#pragma unroll
                for (int bj = 0; bj < 2; ++bj) { const f32x4 v0 = gv[bj][0] * acc[ai][bj][m][0], v1 = gv[bj][1] * acc[ai][bj][m][1];
                    u32x4 w; w.x = cvtpk(v0[0], v0[1]); w.y = cvtpk(v0[2], v0[3]); w.z = cvtpk(v1[0], v1[1]); w.w = cvtpk(v1[2], v1[3]);
                    *(u32x4*)(y + ro + bj * HALF) = w; } }
    }
};
struct EpiSC8 {
    static constexpr bool PERM = false; static constexpr bool HAS_MID = false; static constexpr bool AFTER_DRAIN = true;
    typedef i32x4 acc_t;
    static __device__ __forceinline__ i32x4 mma(bf16x8 b, bf16x8 a, i32x4 c) { return __builtin_amdgcn_mfma_i32_16x16x64_i8(__builtin_bit_cast(i32x4, b), __builtin_bit_cast(i32x4, a), c, 0, 0, 0); }
    float* C; const float* sh; const float* sw; const Frame* F; float* tile;
    __device__ __forceinline__ void fused(const i32x4 (&acc)[2][2][4][2], const Unit& u, int wr, int wc, int fr, int fq) const {
        const int col0 = wc * 32 + 4 * fq;
        f32x4 cw[2][2];
#pragma unroll
        for (int bj = 0; bj < 2; ++bj)
#pragma unroll
            for (int n = 0; n < 2; ++n) cw[bj][n] = *(const f32x4*)(sw + u.pn * BM + col0 + bj * HALF + n * 16);
#pragma unroll
        for (int ai = 0; ai < 2; ++ai) {
#pragma unroll
            for (int m = 0; m < 4; ++m) { const int lr = wr * 64 + m * 16 + fr; const float rs = sh[u.pm * BM + ai * HALF + lr];
#pragma unroll
                for (int bj = 0; bj < 2; ++bj)
#pragma unroll
                    for (int n = 0; n < 2; ++n) { const i32x4 a = acc[ai][bj][m][n]; *(f32x4*)(tile + lr * 260 + col0 + bj * HALF + n * 16) = (f32x4){(float)a[0], (float)a[1], (float)a[2], (float)a[3]} * cw[bj][n] * rs; } }
            __syncthreads();
            { int tz = threadIdx.x; asm volatile("" : "+v"(tz)); const int w = __builtin_amdgcn_readfirstlane(tz >> 6);
              topk_rows(*F, tile + (size_t)(w * 16) * 260, 260, u.pm * BM + ai * HALF + w * 16, u.pn, 4); }
            __syncthreads();
        }
    }
    __device__ __forceinline__ void operator()(const i32x4 (&acc)[2][2][4][2], const Unit& u, int wr, int wc, int fr, int fq) const {
        const int row0 = u.pm * BM + wr * 64 + fr, col0 = u.pn * BM + wc * 32 + 4 * fq;
        f32x4 cw[2][2];
#pragma unroll
        for (int bj = 0; bj < 2; ++bj)
#pragma unroll
            for (int n = 0; n < 2; ++n) cw[bj][n] = *(const f32x4*)(sw + col0 + bj * HALF + n * 16);
#pragma unroll
        for (int ai = 0; ai < 2; ++ai)
#pragma unroll
            for (int m = 0; m < 4; ++m) { const int row = row0 + ai * HALF + m * 16; const float rs = sh[row]; float* rowp = C + (size_t)row * DM + col0;
#pragma unroll
                for (int bj = 0; bj < 2; ++bj)
#pragma unroll
                    for (int n = 0; n < 2; ++n) { const i32x4 a = acc[ai][bj][m][n]; *(f32x4*)(rowp + bj * HALF + n * 16) = (f32x4){(float)a[0], (float)a[1], (float)a[2], (float)a[3]} * cw[bj][n] * rs; } }
    }
};
}

namespace att {
constexpr int D = 128, NW = 8, QBLK = 32, KVBLK = 64;
constexpr float SCALE = 0.088388347648318440f;
constexpr float THR = 8.f;
constexpr int SHM_V = KVBLK * D * 2, SHM_K = KVBLK * D * 2, SHM_ATTN = 2 * SHM_V + 2 * SHM_K + NW * 64 * 4;
struct Args {
    const bf16_t* Q; const bf16_t* K; const bf16_t* V; bf16_t* O; float* lse;
    int ldq, ldk, ldo, ldl;
    int kt0, NT;
    int q0, W;
    float slope_l2, m_init, l_init;
};
#define KSWZ(row, colB) ((row) * 256 + ((colB) ^ (((row) & 7) << 4)))
#define SBAR() __builtin_amdgcn_sched_barrier(0)
__device__ __forceinline__ int crow(int r, int hi) { return (r & 3) + 8 * (r >> 2) + 4 * hi; }
template <bool FIRST>
__device__ __forceinline__ void partialSM_dense(f32x16& p0, f32x16& p1, f32x16& negm, float& alpha) {
    float pmax = p0[0];
#pragma unroll
    for (int r = 1; r < 16; ++r) pmax = fmaxf(pmax, p0[r]);
#pragma unroll
    for (int r = 0; r < 16; ++r) pmax = fmaxf(pmax, p1[r]);
    { auto rr = __builtin_amdgcn_permlane32_swap(__float_as_uint(pmax), __float_as_uint(pmax), false, false); pmax = fmaxf(__uint_as_float(rr[0]), __uint_as_float(rr[1])); }
    if (!FIRST && __builtin_expect(__all(pmax <= THR * LOG2E), 1)) { alpha = 1.f; }
    else {
        const float d = FIRST ? pmax : fmaxf(pmax, 0.f);
        alpha = FIRST ? 1.f : __builtin_amdgcn_exp2f(-d); const float nm = negm[0] - d;
#pragma unroll
        for (int r = 0; r < 16; ++r) { p0[r] -= d; p1[r] -= d; negm[r] = nm; }
        asm volatile("" : "+v"(negm));
    }
#pragma unroll
    for (int r = 0; r < 16; ++r) p0[r] = __builtin_amdgcn_exp2f(p0[r]);
}
__device__ __forceinline__ void partialSM_band(f32x16& p0, f32x16& p1, float& m_reg, float& mn, float& alpha, float qrel, int hi, float slope_l2, float Wf) {
    constexpr float C = SCALE * LOG2E;
    const float ninf = -__builtin_inff();
    float pmax = ninf; const float h4 = (float)(4 * hi);
#pragma unroll
    for (int r = 0; r < 16; ++r) { const float kl = (float)((r & 3) + 8 * (r >> 2)) + h4; const float d0 = fabsf(qrel - kl), d1 = fabsf(qrel - (kl + 32.f));
        float t0 = fmaf(p0[r], C, -slope_l2 * d0), t1 = fmaf(p1[r], C, -slope_l2 * d1);
        t0 = d0 <= Wf ? t0 : ninf; t1 = d1 <= Wf ? t1 : ninf; p0[r] = t0; p1[r] = t1; pmax = fmaxf(pmax, fmaxf(t0, t1)); }
    { auto rr = __builtin_amdgcn_permlane32_swap(__float_as_uint(pmax), __float_as_uint(pmax), false, false); pmax = fmaxf(__uint_as_float(rr[0]), __uint_as_float(rr[1])); }
    if (__all(pmax - m_reg <= THR * LOG2E)) { mn = m_reg; alpha = 1.f; }
    else { mn = fmaxf(m_reg, pmax); alpha = __builtin_amdgcn_exp2f(m_reg - mn); m_reg = mn; }
#pragma unroll
    for (int r = 0; r < 16; ++r) p1[r] = p1[r] - mn;
#pragma unroll
    for (int r = 0; r < 16; ++r) p0[r] = __builtin_amdgcn_exp2f(p0[r] - mn);
}
__device__ __forceinline__ void finishSM(f32x16& p0, f32x16& p1, float alpha, float& l_reg, bf16x8& pa0, bf16x8& pa1, bf16x8& pa2, bf16x8& pa3) {
#pragma unroll
    for (int r = 0; r < 16; ++r) p1[r] = __builtin_amdgcn_exp2f(p1[r]);
    float ps = 0;
#pragma unroll
    for (int r = 0; r < 16; ++r) ps += p0[r];
#pragma unroll
    for (int r = 0; r < 16; ++r) ps += p1[r];
    { auto rr = __builtin_amdgcn_permlane32_swap(__float_as_uint(ps), __float_as_uint(ps), false, false); ps = __uint_as_float(rr[0]) + __uint_as_float(rr[1]); }
    l_reg = l_reg * alpha + ps;
#define PK4(P, BASE, OUT) do { unsigned a0 = cvtpk(P[BASE + 0], P[BASE + 1]), a1 = cvtpk(P[BASE + 2], P[BASE + 3]);   \
    unsigned b0 = cvtpk(P[BASE + 4], P[BASE + 5]), b1 = cvtpk(P[BASE + 6], P[BASE + 7]);                              \
    auto r0 = __builtin_amdgcn_permlane32_swap(a0, b0, false, false); auto r1 = __builtin_amdgcn_permlane32_swap(a1, b1, false, false); \
    u32x4 w = {r0[0], r1[0], r0[1], r1[1]}; OUT = *reinterpret_cast<bf16x8*>(&w); } while (0)
    PK4(p0, 0, pa0); PK4(p0, 8, pa1); PK4(p1, 0, pa2); PK4(p1, 8, pa3);
#undef PK4
}
__device__ __forceinline__ void qkt(f32x16& p0, f32x16& p1, const char* Ks, const bf16x8* qr, int r32, int hi) {
    p0 = f32x16{}; p1 = f32x16{};
#pragma unroll
    for (int d0 = 0; d0 < 8; ++d0) { const int cb = (d0 * 16 + hi * 8) * 2;
        const bf16x8 b0 = *reinterpret_cast<const bf16x8*>(Ks + KSWZ(r32, cb));
        const bf16x8 b1 = *reinterpret_cast<const bf16x8*>(Ks + KSWZ(32 + r32, cb));
        p0 = __builtin_amdgcn_mfma_f32_32x32x16_bf16(b0, qr[d0], p0, 0, 0, 0);
        p1 = __builtin_amdgcn_mfma_f32_32x32x16_bf16(b1, qr[d0], p1, 0, 0, 0); }
}
__device__ __forceinline__ void qkt_c(f32x16& p0, f32x16& p1, const char* Ks, const bf16x8* qr, const f32x16& c, int r32, int hi) {
#pragma unroll
    for (int d0 = 0; d0 < 8; ++d0) { const int cb = (d0 * 16 + hi * 8) * 2;
        const bf16x8 b0 = *reinterpret_cast<const bf16x8*>(Ks + KSWZ(r32, cb));
        const bf16x8 b1 = *reinterpret_cast<const bf16x8*>(Ks + KSWZ(32 + r32, cb));
        if (d0 == 0) { p0 = __builtin_amdgcn_mfma_f32_32x32x16_bf16(b0, qr[0], c, 0, 0, 0); p1 = __builtin_amdgcn_mfma_f32_32x32x16_bf16(b1, qr[0], c, 0, 0, 0); }
        else { p0 = __builtin_amdgcn_mfma_f32_32x32x16_bf16(b0, qr[d0], p0, 0, 0, 0); p1 = __builtin_amdgcn_mfma_f32_32x32x16_bf16(b1, qr[d0], p1, 0, 0, 0); } }
}
__device__ __forceinline__ int v_st(int k, int c) { const int kk = (k & ~0xC) | ((k & 4) << 1) | ((k & 8) >> 1); return ((kk >> 3) * 4 + (c >> 5)) * 512 + ((kk & 7) * 32 + (c & 31)) * 2; }
__device__ __forceinline__ int v_rd_base(int lane) { return ((lane & 3) << 3) | (((lane >> 2) & 3) << 6) | (((lane >> 4) & 1) << 5) | (((lane >> 5) & 1) << 8); }
constexpr int v_rd_off(int d0, int ks, int half) { return d0 * 512 + ks * 4096 + half * 2048; }
template <int OFF> __device__ __forceinline__ s16x4 tr_read(int vb) { s16x4 r; asm volatile("ds_read_b64_tr_b16 %0, %1 offset:%2" : "=&v"(r) : "v"(vb), "i"(OFF) : "memory"); return r; }
template <int D0> __device__ __forceinline__ void pv_one(f32x16& od, int vb, bf16x8 pa0, bf16x8 pa1, bf16x8 pa2, bf16x8 pa3) {
    const s16x4 l0 = tr_read<v_rd_off(D0, 0, 0)>(vb), h0 = tr_read<v_rd_off(D0, 0, 1)>(vb), l1 = tr_read<v_rd_off(D0, 1, 0)>(vb), h1 = tr_read<v_rd_off(D0, 1, 1)>(vb);
    const s16x4 l2 = tr_read<v_rd_off(D0, 2, 0)>(vb), h2 = tr_read<v_rd_off(D0, 2, 1)>(vb), l3 = tr_read<v_rd_off(D0, 3, 0)>(vb), h3 = tr_read<v_rd_off(D0, 3, 1)>(vb);
    asm volatile("s_waitcnt lgkmcnt(0)" ::: "memory"); SBAR();
#define PK(L, H) (bf16x8){L[0], L[1], L[2], L[3], H[0], H[1], H[2], H[3]}
    od = __builtin_amdgcn_mfma_f32_32x32x16_bf16(pa0, PK(l0, h0), od, 0, 0, 0);
    od = __builtin_amdgcn_mfma_f32_32x32x16_bf16(pa1, PK(l1, h1), od, 0, 0, 0);
    od = __builtin_amdgcn_mfma_f32_32x32x16_bf16(pa2, PK(l2, h2), od, 0, 0, 0);
    od = __builtin_amdgcn_mfma_f32_32x32x16_bf16(pa3, PK(l3, h3), od, 0, 0, 0);
#undef PK
}
__device__ __forceinline__ void pv_d0(f32x16* o, int vb, bf16x8 pa0, bf16x8 pa1, bf16x8 pa2, bf16x8 pa3) {
    pv_one<0>(o[0], vb, pa0, pa1, pa2, pa3); pv_one<1>(o[1], vb, pa0, pa1, pa2, pa3); pv_one<2>(o[2], vb, pa0, pa1, pa2, pa3); pv_one<3>(o[3], vb, pa0, pa1, pa2, pa3);
}
__device__ __forceinline__ void store_o(const f32x16 (&o)[4], float l_reg, char* lds, bf16_t* O, int ldo) {
    int tz = threadIdx.x; asm volatile("" : "+v"(tz));
    const int wid = tz >> 6, lane = tz & 63, r32 = lane & 31, hi = lane >> 5;
    float* li_l = (float*)(lds + 2 * SHM_V + 2 * SHM_K) + wid * 64;
    if (hi == 0) li_l[r32] = l_reg; asm volatile("s_waitcnt lgkmcnt(0)" ::: "memory");
    float rli[16];
#pragma unroll
    for (int r = 0; r < 16; ++r) rli[r] = __builtin_amdgcn_rcpf(li_l[crow(r, hi)]);
    __syncthreads();
    char* ow = lds + wid * 8192;
#pragma unroll
    for (int r = 0; r < 16; ++r) { const int orow = crow(r, hi);
#pragma unroll
        for (int d0 = 0; d0 < 4; ++d0) *(bf16_t*)(ow + orow * 256 + (d0 * 32 + r32) * 2) = (bf16_t)(cvtpk(o[d0][r] * rli[r], 0.f) & 0xffffu); }
    asm volatile("s_waitcnt lgkmcnt(0)" ::: "memory");
    bf16_t* Ow = O + (wid * QBLK) * ldo;
#pragma unroll
    for (int i = 0; i < 8; ++i) { const int p = i * 64 + lane, row = p >> 4, c16 = p & 15;
        const u32x4 v = *(const u32x4*)(ow + row * 256 + c16 * 16);
        *(u32x4*)(Ow + row * ldo + c16 * 8) = v; }
    __syncthreads();
}
#define RESC(al) do { if (__any((al) < 1.f)) { if (hi == 0) al_l[r32] = (al); asm volatile("s_waitcnt lgkmcnt(0)" ::: "memory"); \
    _Pragma("unroll") for (int d = 0; d < 4; ++d) _Pragma("unroll") for (int r = 0; r < 16; ++r) o[d][r] *= al_l[crow(r, hi)]; } } while (0)
#define SWRITE(b, S) do { *(bf16x8*)(V_lds + (b) * SHM_V + vst0) = S.vs0; *(bf16x8*)(V_lds + (b) * SHM_V + vst1) = S.vs1; const int kc = sc * 2; \
    *(bf16x8*)(K_lds + (b) * SHM_K + KSWZ(sr, kc)) = S.ks0; *(bf16x8*)(K_lds + (b) * SHM_K + KSWZ(32 + sr, kc)) = S.ks1; } while (0)
struct Slot { bf16x8 vs0, vs1, ks0, ks1; };
template <int LDQK, int LDO, int VDELTA>
__device__ __forceinline__ void attn_dense_unit(const bf16_t* Q, const bf16_t* K, bf16_t* O, int NT, char* lds) {
    int tid = threadIdx.x; asm volatile("" : "+v"(tid));
    const int wid = __builtin_amdgcn_readfirstlane(tid >> 6), lane = tid & 63, r32 = lane & 31, hi = lane >> 5;
    char* V_lds = lds; char* K_lds = lds + 2 * SHM_V;
    float* ws = (float*)(lds + 2 * SHM_V + 2 * SHM_K) + wid * 64; float* al_l = ws + 32;
    float l_reg = 0.f; f32x16 o[4] = {}; bf16x8 qr[8]; f32x16 negm = f32x16{}; asm volatile("" : "+v"(negm));
    const bf16_t* Qw = Q + (wid * QBLK + r32) * LDQK + hi * 8;
#pragma unroll
    for (int d0 = 0; d0 < 8; ++d0) qr[d0] = *reinterpret_cast<const bf16x8*>(Qw + d0 * 16);
    const int vb0 = (int)(uintptr_t)V_lds + v_rd_base(lane);
    int koff[2];
#pragma unroll
    for (int q = 0; q < 2; ++q) { const int row = 4 * (2 * wid + q) + (lane >> 4), cb = ((lane & 15) * 16) ^ ((row & 7) << 4); koff[q] = row * LDQK + (cb >> 1); }
    const int vkk = 8 * wid + ((lane & 31) >> 2), vkey = (vkk & ~0xC) | ((vkk & 4) << 1) | ((vkk & 8) >> 1);
    const int voff = vkey * LDQK + (lane >> 5) * 32 + (lane & 3) * 8 + VDELTA;
    LAS unsigned char* Kl = (LAS unsigned char*)K_lds + 2 * wid * 1024; LAS unsigned char* Vl = (LAS unsigned char*)V_lds + 2 * wid * 1024;
#define DMA_K(tile, buf) do { const bf16_t* kt_ = K + (size_t)((tile) < NT ? (tile) : NT - 1) * (KVBLK * LDQK); _Pragma("unroll") for (int q_ = 0; q_ < 2; ++q_) \
        __builtin_amdgcn_global_load_lds((const unsigned*)(kt_ + koff[q_]), (LAS unsigned*)(Kl + (buf) * SHM_K + q_ * 1024), 16, 0, 0); } while (0)
#define DMA_V(tile, buf) do { const bf16_t* vt_ = K + (size_t)((tile) < NT ? (tile) : NT - 1) * (KVBLK * LDQK) + voff; _Pragma("unroll") for (int q_ = 0; q_ < 2; ++q_) \
        __builtin_amdgcn_global_load_lds((const unsigned*)(vt_ + q_ * 64), (LAS unsigned*)(Vl + (buf) * SHM_V + q_ * 1024), 16, 0, 0); } while (0)
#define WBAR4() do { asm volatile("s_waitcnt vmcnt(4)" ::: "memory"); __builtin_amdgcn_s_barrier(); } while (0)
#define XBAR() do { asm volatile("s_waitcnt lgkmcnt(0)" ::: "memory"); __builtin_amdgcn_s_barrier(); } while (0)
    f32x16 pA0, pA1, pB0, pB1; float alA, alB; bf16x8 pa0, pa1, pa2, pa3;
    DMA_K(0, 0); DMA_V(0, 0); DMA_K(1, 1);
    WBAR4();
    qkt_c(pA0, pA1, K_lds, qr, negm, r32, hi); partialSM_dense<true>(pA0, pA1, negm, alA);
    XBAR();
    DMA_V(1, 1); DMA_K(2, 0);
    WBAR4();
#define STEP_E(t) do { SBAR(); qkt_c(pB0, pB1, K_lds + SHM_K, qr, negm, r32, hi); \
        finishSM(pA0, pA1, alA, l_reg, pa0, pa1, pa2, pa3); SBAR(); \
        pv_d0(o, vb0, pa0, pa1, pa2, pa3); partialSM_dense<false>(pB0, pB1, negm, alB); \
        XBAR(); DMA_V((t) + 2, 0); DMA_K((t) + 3, 1); RESC(alB); WBAR4(); } while (0)
#define STEP_O(t) do { SBAR(); qkt_c(pA0, pA1, K_lds, qr, negm, r32, hi); \
        finishSM(pB0, pB1, alB, l_reg, pa0, pa1, pa2, pa3); SBAR(); \
        pv_d0(o, vb0 + (int)SHM_V, pa0, pa1, pa2, pa3); partialSM_dense<false>(pA0, pA1, negm, alA); \
        XBAR(); DMA_V((t) + 2, 1); DMA_K((t) + 3, 0); RESC(alA); WBAR4(); } while (0)
    int t = 0;
    for (; t + 2 < NT; t += 2) { STEP_E(t); STEP_O(t + 1); }
    STEP_E(t);
    finishSM(pB0, pB1, alB, l_reg, pa0, pa1, pa2, pa3); SBAR();
    pv_d0(o, vb0 + (int)SHM_V, pa0, pa1, pa2, pa3);
    asm volatile("s_waitcnt vmcnt(0)" ::: "memory");
    store_o(o, l_reg, lds, O, LDO);
#undef DMA_K
#undef DMA_V
#undef WBAR4
#undef XBAR
#undef STEP_E
#undef STEP_O
}
__device__ __forceinline__ void attn_band_unit(const Args& a, char* lds) {
    int tid = threadIdx.x; asm volatile("" : "+v"(tid));
    const int wid = tid >> 6, lane = tid & 63, r32 = lane & 31, hi = lane >> 5;
    char* V_lds = lds; char* K_lds = lds + 2 * SHM_V;
    float* ws = (float*)(lds + 2 * SHM_V + 2 * SHM_K) + wid * 64; float* li_l = ws; float* al_l = ws + 32;
    float m_reg = a.m_init, l_reg = a.l_init; f32x16 o[4] = {}; bf16x8 qr[8];
    const bf16_t* Qw = a.Q + (wid * QBLK + r32) * a.ldq + hi * 8;
#pragma unroll
    for (int d0 = 0; d0 < 8; ++d0) qr[d0] = *reinterpret_cast<const bf16x8*>(Qw + d0 * 16);
    const int sr = tid >> 4, sc = (tid & 15) * 8, vst0 = v_st(sr, sc), vst1 = v_st(32 + sr, sc);
    const int vb0 = (int)(uintptr_t)V_lds + v_rd_base(lane);
    const char* Kh = (const char*)(a.K + (long)a.kt0 * KVBLK * a.ldk); const char* Vh = (const char*)(a.V + (long)a.kt0 * KVBLK * a.ldk);
    const unsigned so0 = (unsigned)(sr * a.ldk + sc) * 2u, so1 = so0 + (unsigned)(32 * a.ldk) * 2u; const long tstep = (long)KVBLK * a.ldk * 2;
    const float qrel0 = (float)(a.q0 + wid * QBLK + r32 - a.kt0 * KVBLK), Wf = (float)a.W, slope = a.slope_l2;
    Slot st; const int NT = a.NT;
#define SLOAD1(tile) do { const char* vt_ = Vh + (long)(tile) * tstep; const char* kt_ = Kh + (long)(tile) * tstep; \
    st.vs0 = *reinterpret_cast<const bf16x8*>(vt_ + so0); st.vs1 = *reinterpret_cast<const bf16x8*>(vt_ + so1); \
    st.ks0 = *reinterpret_cast<const bf16x8*>(kt_ + so0); st.ks1 = *reinterpret_cast<const bf16x8*>(kt_ + so1); } while (0)
    SLOAD1(0); asm volatile("s_waitcnt vmcnt(0)" ::: "memory"); SWRITE(0, st); __syncthreads();
    for (int j = 0; j < NT; ++j) {
        const int bsel = j & 1;
        if (j + 1 < NT) SLOAD1(j + 1);
        const int kb = (a.kt0 + j) * KVBLK, qlo = a.q0 + __builtin_amdgcn_readfirstlane(wid) * QBLK;
        if (kb <= qlo + QBLK - 1 + a.W && kb + KVBLK - 1 >= qlo - a.W) {
        f32x16 p0, p1; float mn, al; bf16x8 pa0, pa1, pa2, pa3;
        qkt(p0, p1, K_lds + bsel * SHM_K, qr, r32, hi);
        partialSM_band(p0, p1, m_reg, mn, al, qrel0 - (float)(j * KVBLK), hi, slope, Wf);
        RESC(al);
        finishSM(p0, p1, al, l_reg, pa0, pa1, pa2, pa3); SBAR();
        pv_d0(o, vb0 + bsel * (int)SHM_V, pa0, pa1, pa2, pa3);
        }
        if (j + 1 < NT) { asm volatile("s_waitcnt vmcnt(0)" ::: "memory"); if (bsel) { SWRITE(0, st); } else { SWRITE(1, st); } }
        __syncthreads();
    }
    if (a.lse != nullptr && hi == 0) a.lse[(wid * QBLK + r32) * a.ldl] = (m_reg + __builtin_amdgcn_logf(l_reg)) * LN2;
    store_o(o, l_reg, lds, a.O, a.ldo);
#undef SLOAD1
}
#undef RESC
#undef SWRITE
}

struct Args {
    const float* in[20]; float* out; unsigned char* ws; int ph_lo, ph_hi, use_bar, pad;
};
enum { IN_X = 0, IN_C, IN_WMOD, IN_BMOD, IN_WIN, IN_AQG, IN_AKG, IN_CSINK, IN_WPA, IN_WPB, IN_WPC, IN_WO, IN_LN1G, IN_LN1B, IN_PWQ, IN_PKEYS, IN_PU, IN_PV, IN_LN2G, IN_LN2B };
constexpr int LDS_RING = 0, LDS_WTAB = 128 * 1024  , LDS_MISC = 152 * 1024, LDS_BYTES = 153 * 1024;

struct Frame {
    const Args* a; unsigned char* ws; char* lds; int tid, wid, lane, G, bid;
    __device__ __forceinline__ unsigned char* wl(int l, size_t off) const { return ws + WS_W0 + (size_t)l * WL_BYTES + off; }
};

__device__ __forceinline__ void tconv_tile(const float* src, int N, bf16_t* dst, int ldd, int k0, int n0, float* tl, int tid) {
    {   const int r = tid >> 6, c4 = (tid & 63) * 4; f32x4 v[8];
#pragma unroll
        for (int i = 0; i < 8; ++i) v[i] = *(const f32x4*)(src + (size_t)(k0 + r + 8 * i) * N + n0 + c4);
#pragma unroll
        for (int i = 0; i < 8; ++i) { float* p = tl + (r + 8 * i) * 257 + c4; p[0] = v[i][0]; p[1] = v[i][1]; p[2] = v[i][2]; p[3] = v[i][3]; } }
    __syncthreads();
    {   const int n = tid >> 1, kh = (tid & 1) * 32;
#pragma unroll
        for (int q = 0; q < 4; ++q) { float v[8];
#pragma unroll
            for (int j = 0; j < 8; ++j) v[j] = tl[(kh + q * 8 + j) * 257 + n];
            *(u32x4*)(dst + (size_t)(n0 + n) * ldd + k0 + kh + q * 8) = pack8(v); } }
    __syncthreads();
}
__device__ __forceinline__ unsigned fp4_code(float y) {
    const float a = fabsf(y);
    const unsigned c = (a >= 0.25f) + (a >= 0.75f) + (a >= 1.25f) + (a >= 1.75f) + (a >= 2.5f) + (a >= 3.5f) + (a >= 5.0f);
    return c | (y < 0.f ? 8u : 0u);
}
__device__ __forceinline__ unsigned fp4_pack8(const float* v, float inv) {
    unsigned w = 0u;
#pragma unroll
    for (int j = 0; j < 8; ++j) w |= fp4_code(v[j] * inv) << (4 * j);
    return w;
}
__device__ __forceinline__ void store_h_q8(const float (&v)[2][16], unsigned char* hrow, float* shp, int lane) {
    float am = 0.f;
#pragma unroll
    for (int hf = 0; hf < 2; ++hf)
#pragma unroll
        for (int j = 0; j < 16; ++j) am = fmaxf(am, fabsf(v[hf][j]));
    am = wave_max(am); const float sc = am > 0.f ? am * (1.0f / 6.0f) : 1.0f, inv = 1.0f / sc;
#pragma unroll
    for (int hf = 0; hf < 2; ++hf) *(u32x2*)(hrow + hf * 512 + lane * 8) = (u32x2){fp4_pack8(&v[hf][0], inv), fp4_pack8(&v[hf][8], inv)};
    if (lane == 0) *shp = sc;
}

__device__ void phase_c0(const Frame& F) {
    const Args& A = *F.a; const int tid = F.tid, G = F.G, bid = F.bid;
    float* tl = (float*)F.lds;
    if (tid < 8) {
        float* rope = (float*)(F.ws + WS_ROPE);
        for (int e = bid * 8 + tid; e < 64 * 32; e += G * 8) {
            const int pos = e >> 5, i = e & 31;
            double inv = 1.0; for (int k = 0; k < i; ++k) inv *= 0.74989420933245582730;
            const double ang = (double)pos * (double)(float)inv;
            const double kq = __builtin_rint(ang * 0.63661977236758134308);
            const double r = (ang - kq * 1.5707963267948966192) - kq * 6.123233995736766e-17;
            const double r2 = r * r;
            double s = r * (1.0 + r2 * (-1.0 / 6 + r2 * (1.0 / 120 + r2 * (-1.0 / 5040 + r2 * (1.0 / 362880 + r2 * (-1.0 / 39916800 + r2 * (1.0 / 6227020800.0)))))));
            double c = 1.0 + r2 * (-0.5 + r2 * (1.0 / 24 + r2 * (-1.0 / 720 + r2 * (1.0 / 40320 + r2 * (-1.0 / 3628800 + r2 * (1.0 / 479001600.0 + r2 * (-1.0 / 87178291200.0)))))));
            const int q = ((int)kq) & 3;
            const double cs = q == 0 ? c : (q == 1 ? -s : (q == 2 ? -c : s)), sn = q == 0 ? s : (q == 1 ? c : (q == 2 ? -s : -c));
            rope[e] = (float)cs; rope[2048 + e] = (float)sn;
        }
    }
    for (int u = bid; u < 256; u += G) {
        const int gc0 = u * 96, l = gc0 / MODW, n0 = gc0 % MODW;
        const float* wm = A.in[IN_WMOD] + (size_t)l * DM * MODW; const float* cv = A.in[IN_C];
        const int rr = tid / 24, cq = tid % 24;
        f32x4 a0 = {0.f, 0.f, 0.f, 0.f}, a1 = {0.f, 0.f, 0.f, 0.f};
        if (rr < 21) {
            for (int k = rr; k < DM; k += 14 * 21) { f32x4 w[14];
#pragma unroll
                for (int i = 0; i < 14; ++i) { const int kk = k + 21 * i < DM ? k + 21 * i : DM - 1; w[i] = __builtin_nontemporal_load((const f32x4*)(wm + (size_t)kk * MODW + n0 + cq * 4)); }
#pragma unroll
                for (int i = 0; i < 14; ++i) { const bool ok = k + 21 * i < DM; const int kk = ok ? k + 21 * i : DM - 1; const float c0 = ok ? cv[kk] : 0.f, c1 = ok ? cv[DM + kk] : 0.f; a0 += w[i] * c0; a1 += w[i] * c1; } }
        }
        float* red = tl;
        if (rr < 21) { *(f32x4*)(red + (rr * 2 + 0) * 96 + cq * 4) = a0; *(f32x4*)(red + (rr * 2 + 1) * 96 + cq * 4) = a1; }
        __syncthreads();
        if (tid < 192) { const int b = tid / 96, n = tid % 96; float s = 0.f; for (int r = 0; r < 21; ++r) s += red[(r * 2 + b) * 96 + n];
            ((float*)(F.ws + WS_MOD))[((size_t)l * NBATCH + b) * MODW + n0 + n] = s + A.in[IN_BMOD][(size_t)l * MODW + n0 + n]; }
        __syncthreads();
    }
    {
        int mine = 0; for (int u = bid; u < 43; u += G) ++mine;
        if (mine > 0) { asm volatile("s_waitcnt vmcnt(0)" ::: "memory"); __syncthreads();
            if (tid == 0) { __builtin_amdgcn_fence(__ATOMIC_RELEASE, "agent"); asm volatile("s_waitcnt vmcnt(0)" ::: "memory"); (void)xb_add((unsigned*)(F.ws + WS_CTL) + XB_MODCNT, (unsigned)mine); } }
    }
    for (int u0 = bid; u0 < DEPTH * 16 * 8; u0 += G) {
        const int u = G == 256 ? (((u0 & 7) | ((u0 >> 6) << 3)) << 3) | ((u0 >> 3) & 7) : u0;
        const int l = u >> 7, hp = (u >> 3) & 15, kb = u & 7, p = hp & 1;
        const float* keys = A.in[IN_PKEYS] + ((size_t)(l * 2 + p) * 128) * 128; const float* wq = A.in[IN_PWQ] + (size_t)l * DM * DM;
        unsigned char* dst = F.wl(l, WL_WQK) + (size_t)(hp * 128 + kb * 16) * DM; float* swq = (float*)F.wl(l, WL_SWQK) + hp * 128 + kb * 16;
        float* red = (float*)F.lds; unsigned char* bt = (unsigned char*)F.lds + 1024;
        const int lane = F.lane, w = F.wid, li = lane & 15, lg = lane >> 4;
        f32x4 af[8];
#pragma unroll
        for (int blk = 0; blk < 8; ++blk) af[blk] = *(const f32x4*)(keys + (size_t)(kb * 16 + li) * 128 + blk * 16 + lg * 4);
        f32x4 bv[2][8]; f32x4 acc[16];
        const float* wrow = wq + (size_t)(w * 256 + li) * DM + hp * 128 + lg * 4;
#pragma unroll
        for (int blk = 0; blk < 8; ++blk) bv[0][blk] = *(const f32x4*)(wrow + blk * 16);
#pragma unroll
        for (int db = 0; db < 16; ++db) {
            const int cur = db & 1;
            if (db + 1 < 16) {
#pragma unroll
                for (int blk = 0; blk < 8; ++blk) bv[cur ^ 1][blk] = *(const f32x4*)(wrow + (size_t)(db + 1) * 16 * DM + blk * 16); }
            f32x4 a = {0.f, 0.f, 0.f, 0.f};
#pragma unroll
            for (int blk = 0; blk < 8; ++blk)
#pragma unroll
                for (int s2 = 0; s2 < 4; ++s2) a = __builtin_amdgcn_mfma_f32_16x16x4f32(af[blk][s2], bv[cur][blk][s2], a, 0, 0, 0);
            acc[db] = a;
        }
        float am[4] = {0.f, 0.f, 0.f, 0.f};
#pragma unroll
        for (int db = 0; db < 16; ++db)
#pragma unroll
            for (int r = 0; r < 4; ++r) am[r] = fmaxf(am[r], fabsf(acc[db][r]));
#pragma unroll
        for (int r = 0; r < 4; ++r) { float x = am[r]; x = fmaxf(x, dppf<XOR1>(x)); x = fmaxf(x, dppf<XOR2>(x)); x = fmaxf(x, dppf<HMIR>(x)); x = fmaxf(x, dppf<MIR>(x)); am[r] = x; }
        if (li == 0) {
#pragma unroll
            for (int r = 0; r < 4; ++r) red[w * 16 + lg * 4 + r] = am[r]; }
        __syncthreads();
        float inv[4];
#pragma unroll
        for (int r = 0; r < 4; ++r) { float x = 0.f;
#pragma unroll
            for (int ww = 0; ww < 8; ++ww) x = fmaxf(x, red[ww * 16 + lg * 4 + r]);
            const float sc = x > 0.f ? x * (1.0f / 127.0f) : 1.0f; inv[r] = 1.0f / sc;
            if (w == 0 && li == 0) swq[lg * 4 + r] = sc; }
#pragma unroll
        for (int db = 0; db < 16; ++db)
#pragma unroll
            for (int r = 0; r < 4; ++r) bt[(lg * 4 + r) * DM + w * 256 + db * 16 + li] = (unsigned char)((int)__builtin_rintf(acc[db][r] * inv[r]) & 0xff);
        __syncthreads();
#pragma unroll
        for (int q = 0; q < 4; ++q) { const int pc = q * NTHREADS + tid, k = pc >> 7, c16 = (pc & 127) * 16;
            *(u32x4*)(dst + (size_t)k * DM + c16) = *(const u32x4*)(bt + k * DM + c16); }
        __syncthreads();
    }
    for (int it = bid; it < DEPTH * 608; it += G) {
        const int l = it / 608; int r = it % 608 + 1440;
        const float* src; int N; bf16_t* dst; int ldd, koff, nkt;
        if (r < 1568) { r -= 1440; src = A.in[IN_WPA] + (size_t)l * 1024 * DM; N = DM; dst = (bf16_t*)F.wl(l, WL_WP); ldd = AOW; koff = AO_A; nkt = 16; }
        else if (r < 1664) { r -= 1568; src = A.in[IN_WPB] + (size_t)l * 768 * DM; N = DM; dst = (bf16_t*)F.wl(l, WL_WP); ldd = AOW; koff = AO_B; nkt = 12; }
        else if (r < 1792) { r -= 1664; src = A.in[IN_WPC] + (size_t)l * 1024 * DM; N = DM; dst = (bf16_t*)F.wl(l, WL_WP); ldd = AOW; koff = AO_C; nkt = 16; }
        else { r -= 1792; src = A.in[IN_WO] + (size_t)l * DM * DM; N = DM; dst = (bf16_t*)F.wl(l, WL_WO); ldd = DM; koff = 0; nkt = 32; }
        const int kt = r % nkt, ntile = r / nkt;
        tconv_tile(src, N, dst + koff, ldd, kt * 64, ntile * 256, tl, tid);
    }
    {
        const int lane = F.lane, wbase = bid * 32 + F.wid * 4;
        auto rowof = [&](int i) { return (i >> 2) * (G * 32) + wbase + (i & 3); };
        auto ldrow = [&](f32x4 (&v)[8], int rw) {
            if (rw < 4 * NEXP) { const int which = rw / NEXP, e = rw % NEXP;
                const float* src = A.in[(which & 1) ? IN_PV : IN_PU] + ((size_t)(which >> 1) * NEXP + e) * DM;
#pragma unroll
                for (int i = 0; i < 8; ++i) v[i] = __builtin_nontemporal_load((const f32x4*)(src + i * 256 + lane * 4)); } };
        auto cvrow = [&](const f32x4 (&v)[8], int rw) {
            if (rw >= 4 * NEXP) return;
            const int which = rw / NEXP, e = rw % NEXP, l = which >> 1, tb = which & 1;
            float am = 0.f, sq = 0.f;
#pragma unroll
            for (int i = 0; i < 8; ++i)
#pragma unroll
                for (int j = 0; j < 4; ++j) { am = fmaxf(am, fabsf(v[i][j])); sq = fmaf(v[i][j], v[i][j], sq); }
            am = wave_max(am); sq = wave_sum(sq);
            const float st = fminf(am * (1.0f / 7.5f), 0.3352f * __builtin_sqrtf(sq * (1.0f / DM)));
            const float sc = st > 0.f ? st : 1.0f, inv = 1.0f / sc;
            unsigned wd[4];
#pragma unroll
            for (int d = 0; d < 4; ++d) { float bq[4];
#pragma unroll
                for (int j = 0; j < 4; ++j) { const float lo = fminf(fmaxf(__builtin_floorf(v[2 * d][j] * inv) + 8.f, 0.f), 15.f), hi = fminf(fmaxf(__builtin_floorf(v[2 * d + 1][j] * inv) + 8.f, 0.f), 15.f); bq[j] = fmaf(hi >= 8.f ? hi - 8.f : hi + 8.f, 16.f, lo); }
                wd[d] = pack4_raw(bq[0], bq[1], bq[2], bq[3]); }
            *(u32x4*)(F.wl(l, tb ? WL_VB : WL_UB) + (size_t)e * (DM / 2) + lane * 16) = (u32x4){wd[0], wd[1], wd[2], wd[3]};
            if (lane == 0) ((float*)F.wl(l, tb ? WL_SV : WL_SU))[e] = sc; };
        const int nrw = ((4 * NEXP + G * 32 - 1) / (G * 32)) * 4;
        f32x4 va[8], vb[8];
        ldrow(va, rowof(0));
        for (int i = 0; i < nrw; i += 2) {
            ldrow(vb, rowof(i + 1));
            cvrow(va, rowof(i));
            if (i + 2 < nrw) ldrow(va, rowof(i + 2));
            cvrow(vb, rowof(i + 1));
        }
    }
    for (int u = G - 1 - bid; u < DEPTH * 360; u += G) {
        const int l = u / 360, n0 = (u % 360) * 32, g = tid & 7, kb = tid >> 3;
        const float* src = A.in[IN_WIN] + ((size_t)l * DM + kb * 32) * INW + n0 + g * 4;
        f32x4 v[32];
#pragma unroll
        for (int i = 0; i < 32; ++i) v[i] = __builtin_nontemporal_load((const f32x4*)(src + (size_t)i * INW));
        f32x4 m = {0.f, 0.f, 0.f, 0.f};
#pragma unroll
        for (int i = 0; i < 32; ++i) { m[0] = fmaxf(m[0], fabsf(v[i][0])); m[1] = fmaxf(m[1], fabsf(v[i][1])); m[2] = fmaxf(m[2], fabsf(v[i][2])); m[3] = fmaxf(m[3], fabsf(v[i][3])); }
#pragma unroll
        for (int j = 0; j < 4; ++j) { float x = m[j]; x = fmaxf(x, lperm(x, F.lane ^ 8)); x = fmaxf(x, lperm(x, F.lane ^ 16)); x = fmaxf(x, lperm(x, F.lane ^ 32)); m[j] = x; }
        float* red = tl;
        if (F.lane < 8) *(f32x4*)(red + F.wid * 32 + g * 4) = m;
        __syncthreads();
#pragma unroll
        for (int ww = 0; ww < 8; ++ww) { const f32x4 o = *(const f32x4*)(red + ww * 32 + g * 4); m[0] = fmaxf(m[0], o[0]); m[1] = fmaxf(m[1], o[1]); m[2] = fmaxf(m[2], o[2]); m[3] = fmaxf(m[3], o[3]); }
        unsigned char* dst = F.wl(l, WL_WIN) + (size_t)(n0 + g * 4) * (DM / 2) + kb * 16;
#pragma unroll
        for (int j = 0; j < 4; ++j) {
            const float sc = m[j] > 0.f ? m[j] * (1.0f / 6.0f) : 1.0f, inv = 1.0f / sc; unsigned w[4];
#pragma unroll
            for (int q = 0; q < 4; ++q) { float e8[8];
#pragma unroll
                for (int jj = 0; jj < 8; ++jj) e8[jj] = v[q * 8 + jj][j];
                w[q] = fp4_pack8(e8, inv); }
            *(u32x4*)(dst + (size_t)j * (DM / 2)) = (u32x4){w[0], w[1], w[2], w[3]};
            if (kb == 0) ((float*)F.wl(l, WL_SWIN))[n0 + g * 4 + j] = sc;
        }
        __syncthreads();
    }
    if (tid == 0) { unsigned* ctl = (unsigned*)(F.ws + WS_CTL); XB_SPIN(xb_ld(&ctl[XB_MODCNT]) < 43u, ctl); __builtin_amdgcn_fence(__ATOMIC_ACQUIRE, "agent"); }
    __syncthreads();
    {
    const float* x = A.in[IN_X]; const float* mod = (const float*)(F.ws + WS_MOD);
    for (int tt = F.bid * 32 + F.wid * 4; tt < NTOK; tt += F.G * 32) for (int t = tt; t < tt + 4; ++t) {
        const int b = t / SEQ; float v[2][16];
#pragma unroll
        for (int hf = 0; hf < 2; ++hf)
#pragma unroll
            for (int q = 0; q < 2; ++q) { const int c = hf * 1024 + F.lane * 16 + q * 8; float xv[8], sh[8], sc[8]; ld8f(x + (size_t)t * DM + c, xv); ld8f(mod + (size_t)b * MODW + c, sh); ld8f(mod + (size_t)b * MODW + DM + c, sc);
#pragma unroll
                for (int j = 0; j < 8; ++j) v[hf][q * 8 + j] = fmaf(xv[j], 1.0f + sc[j], sh[j]); }
        store_h_q8(v, F.ws + WS_H + (size_t)t * (DM / 2), (float*)(F.ws + WS_SH) + t, F.lane);
    }
    }
}


__device__ __forceinline__ void norm_rope_tile(const Frame& F, int l, int pm, int pn) {
    const float* raw = (const float*)(F.ws + WS_QKRAW); bf16_t* qkvb = (bf16_t*)(F.ws + WS_QKVB); const float* rope = (const float*)(F.ws + WS_ROPE);
    const int lane = F.lane, i = lane & 31; const bool isq = pn < 4;
    const float qs = isq ? att::SCALE * LOG2E : 1.0f;
    const float g0 = F.a->in[isq ? IN_AQG : IN_AKG][l * HD + lane] * qs, g1 = F.a->in[isq ? IN_AQG : IN_AKG][l * HD + 64 + lane] * qs;
    for (int q0 = F.wid * 64; q0 < F.wid * 64 + 64; q0 += 4) {
        float x0[4], x1[4], cr[4], sr[4], cc[4], sn[4];
#pragma unroll
        for (int k = 0; k < 4; ++k) { const int q = q0 + k, t = pm * 256 + (q >> 1), hh = pn * 2 + (q & 1), s = t % SEQ, pr = s >> 6, pc = s & 63;
            const float* src = raw + (size_t)t * QKRAWW + hh * HD; x0[k] = src[lane]; x1[k] = src[64 + lane];
            cr[k] = rope[pr * 32 + i]; sr[k] = rope[2048 + pr * 32 + i]; cc[k] = rope[pc * 32 + i]; sn[k] = rope[2048 + pc * 32 + i]; }
#pragma unroll
        for (int k = 0; k < 4; ++k) { const int q = q0 + k, t = pm * 256 + (q >> 1), hh = pn * 2 + (q & 1);
            const float ss = wave_sum(x0[k] * x0[k] + x1[k] * x1[k]);
            const float rs = __builtin_amdgcn_rsqf(ss * (1.0f / HD) + QK_EPS);
            const float a0 = x0[k] * rs * g0, a1 = x1[k] * rs * g1;
            const float y0 = lperm(a0, lane ^ 32), y1 = lperm(a1, lane ^ 32);
            const float o0 = lane < 32 ? a0 * cr[k] - y0 * sr[k] : a0 * cr[k] + y0 * sr[k];
            const float o1 = lane < 32 ? a1 * cc[k] - y1 * sn[k] : a1 * cc[k] + y1 * sn[k];
            bf16_t* dst = qkvb + (size_t)t * QKVW + hh * HD;
            dst[lane] = (bf16_t)(cvtpk(o0, 0.f) & 0xffffu); dst[64 + lane] = (bf16_t)(cvtpk(o1, 0.f) & 0xffffu); }
    }
}
__device__ __forceinline__ void band_range(int q0, int W, int L, int& kt0, int& NT) {
    int lo = q0 - W; if (lo < 0) lo = 0; int hi = q0 + 256 + W; if (hi > L) hi = L;
    const int t0 = lo >> 6, t1 = (hi + 63) >> 6;
    kt0 = t0; NT = t1 - t0;
}
__device__ __forceinline__ void attn_c_args(const Frame& F, int l, int u, att::Args& a) {
    const int qb = u & 15, h = (u >> 4) & 7, b = u >> 7, kvh = h >> 2;
    bf16_t* qkvb = (bf16_t*)(F.ws + WS_QKVB); bf16_t* ao = (bf16_t*)(F.ws + WS_AO);
    const size_t t0 = (size_t)b * SEQ;
    a.Q = qkvb + (t0 + qb * 256) * QKVW + COL_QC + h * HD; a.K = qkvb + t0 * QKVW + COL_KC + kvh * HD; a.V = qkvb + t0 * QKVW + COL_VC + kvh * HD;
    a.O = ao + (t0 + qb * 256) * AOW + AO_C + h * HD; a.lse = nullptr; a.ldq = QKVW; a.ldk = QKVW; a.ldo = AOW; a.ldl = 0;
    a.q0 = qb * 256; a.W = 128; band_range(a.q0, a.W, SEQ, a.kt0, a.NT);
    a.slope_l2 = __builtin_amdgcn_exp2f(-(float)(h + 1)) * LOG2E;
    a.m_init = F.a->in[IN_CSINK][l * 8 + h] * LOG2E; a.l_init = 1.0f;
}
__device__ __forceinline__ void attn_b_args(const Frame& F, int u, att::Args& a) {
    const int g = u >> 6, v = u & 63;
    const int r = g == 0 ? 1 : (g == 1 ? 4 : 16), sub = SEQ / r;
    int b, c, hg, qb;
    if (g == 0) { qb = v & 15; hg = (v >> 4) & 1; b = v >> 5; c = 0; }
    else if (g == 1) { qb = v & 3; c = (v >> 2) & 3; hg = (v >> 4) & 1; b = v >> 5; }
    else { qb = 0; c = v & 15; hg = (v >> 4) & 1; b = v >> 5; }
    const int head = g * 2 + hg;
    bf16_t* qkvb = (bf16_t*)(F.ws + WS_QKVB); bf16_t* ao = (bf16_t*)(F.ws + WS_AO); float* lse = (float*)(F.ws + WS_LSEB);
    const size_t t0 = (size_t)b * SEQ + c;
    a.ldq = r * QKVW; a.ldk = r * QKVW; a.ldo = r * AOW; a.ldl = 1;
    a.Q = qkvb + t0 * QKVW + COL_QB + head * HD + (size_t)(qb * 256) * a.ldq; a.K = qkvb + t0 * QKVW + COL_KB + head * HD; a.V = qkvb + t0 * QKVW + COL_VB + head * HD;
    a.O = ao + t0 * AOW + AO_B + head * HD + (size_t)(qb * 256) * a.ldo; a.lse = lse + (size_t)head * NTOK + ((size_t)(b * r + c)) * sub + qb * 256;
    a.q0 = qb * 256; a.W = 64; band_range(a.q0, a.W, sub, a.kt0, a.NT);
    a.slope_l2 = __builtin_amdgcn_exp2f(-8.0f * (float)(head + 1) / 6.0f) * (float)r * LOG2E;
    a.m_init = -1e30f; a.l_init = 0.f;
}
__device__ __forceinline__ void attn_a_unit(const Frame& F, int u) {
    const int xs = u & 7, idx = u >> 3, b = xs >> 2, kvh = (xs >> 1) & 1, h = kvh * 4 + (xs & 1) * 2 + (idx >> 4), qb = idx & 15;
    bf16_t* qkvb = (bf16_t*)(F.ws + WS_QKVB); bf16_t* ao = (bf16_t*)(F.ws + WS_AO);
    const size_t t0 = (size_t)b * SEQ;
    att::attn_dense_unit<QKVW, AOW, COL_VA - COL_KA>(qkvb + (t0 + qb * 256) * QKVW + COL_QA + h * HD, qkvb + t0 * QKVW + COL_KA + kvh * HD,
                                    ao + (t0 + qb * 256) * AOW + AO_A + h * HD, SEQ / 64, F.lds);
}
__device__ void phase_att(const Frame& F, int l) {
    for (int u = F.bid; u < 256; u += F.G) attn_a_unit(F, u);
    for (int u = F.bid; u < 256 + 192; u += F.G) { att::Args a; if (u < 256) attn_c_args(F, l, u, a); else attn_b_args(F, u - 256, a); att::attn_band_unit(a, F.lds); }
}

__device__ void phase_ln1(const Frame& F, int l) {
    const bf16_t* yb = (const bf16_t*)(F.ws + WS_Z); const float* xin = l == 0 ? F.a->in[IN_X] : (const float*)(F.ws + WS_XCUR); bf16_t* x1 = (bf16_t*)(F.ws + WS_X1); unsigned char* h2 = F.ws + WS_H2; float* sh2 = (float*)(F.ws + WS_SH2);
    const float* g = F.a->in[IN_LN1G] + (size_t)l * DM; const float* bb = F.a->in[IN_LN1B] + (size_t)l * DM;
    const float* mod = (const float*)(F.ws + WS_MOD) + (size_t)l * NBATCH * MODW;
    LAS float* pl = (LAS float*)F.lds;
    for (int tt = F.bid * 32 + F.wid * 4; tt < NTOK; tt += F.G * 32) {
      {   const int bq = tt / SEQ, c = F.tid * 4;
          __syncthreads();
          *(LAS f32x4*)(pl + c) = *(const f32x4*)(g + c); *(LAS f32x4*)(pl + 2048 + c) = *(const f32x4*)(bb + c);
          *(LAS f32x4*)(pl + 4096 + c) = *(const f32x4*)(mod + (size_t)bq * MODW + 4 * DM + c) + 1.0f; *(LAS f32x4*)(pl + 6144 + c) = *(const f32x4*)(mod + (size_t)bq * MODW + 3 * DM + c);
          __syncthreads(); }
      for (int t = tt; t < tt + 4; ++t) {
        float v[4][8]; float s = 0.f;
#pragma unroll
        for (int i = 0; i < 4; ++i) { const size_t o = (size_t)t * DM + i * 512 + F.lane * 8; ld8f(xin + o, v[i]); const u32x4 yw = *(const u32x4*)(yb + o);
            const float yy[8] = {bf_lo(yw.x), bf_hi(yw.x), bf_lo(yw.y), bf_hi(yw.y), bf_lo(yw.z), bf_hi(yw.z), bf_lo(yw.w), bf_hi(yw.w)};
#pragma unroll
            for (int j = 0; j < 8; ++j) { v[i][j] = fmaf(ALPHA, v[i][j], yy[j]); s += v[i][j]; } }
        const float mean = wave_sum(s) * (1.0f / DM); float q = 0.f;
#pragma unroll
        for (int i = 0; i < 4; ++i)
#pragma unroll
            for (int j = 0; j < 8; ++j) { v[i][j] -= mean; q += v[i][j] * v[i][j]; }
        const float rstd = __builtin_amdgcn_rsqf(wave_sum(q) * (1.0f / DM) + LN_EPS);
        float hmax = 0.f;
#pragma unroll
        for (int i = 0; i < 4; ++i) { const int c = i * 512 + F.lane * 8; float gg[8], be[8], sh[8], sc[8];
            { const f32x4 a0 = *(const LAS f32x4*)(pl + c), a1 = *(const LAS f32x4*)(pl + c + 4), b0 = *(const LAS f32x4*)(pl + 2048 + c), b1 = *(const LAS f32x4*)(pl + 2048 + c + 4);
              const f32x4 c0 = *(const LAS f32x4*)(pl + 4096 + c), c1 = *(const LAS f32x4*)(pl + 4096 + c + 4), d0 = *(const LAS f32x4*)(pl + 6144 + c), d1 = *(const LAS f32x4*)(pl + 6144 + c + 4);
#pragma unroll
              for (int j = 0; j < 4; ++j) { gg[j] = a0[j]; gg[4 + j] = a1[j]; be[j] = b0[j]; be[4 + j] = b1[j]; sc[j] = c0[j]; sc[4 + j] = c1[j]; sh[j] = d0[j]; sh[4 + j] = d1[j]; } }
#pragma unroll
            for (int j = 0; j < 8; ++j) v[i][j] = fmaf(v[i][j] * rstd, gg[j], be[j]);
            *(u32x4*)(x1 + (size_t)t * DM + c) = pack8(v[i]);
#pragma unroll
            for (int j = 0; j < 8; ++j) { v[i][j] = fmaf(v[i][j], sc[j], sh[j]); hmax = fmaxf(hmax, fabsf(v[i][j])); } }
        hmax = wave_max(hmax); const float hs = hmax > 0.f ? hmax * (1.0f / 127.0f) : 1.0f, hi = 1.0f / hs;
#pragma unroll
        for (int i = 0; i < 4; ++i) *(u32x2*)(h2 + (size_t)t * DM + i * 512 + F.lane * 8) = (u32x2){pack4_u8(v[i][0] * hi, v[i][1] * hi, v[i][2] * hi, v[i][3] * hi) ^ 0x80808080u, pack4_u8(v[i][4] * hi, v[i][5] * hi, v[i][6] * hi, v[i][7] * hi) ^ 0x80808080u};
        if (F.lane == 0) sh2[t] = hs;
    }
    }
}

__device__ __forceinline__ unsigned row16_umax(unsigned x) { x = max(x, dppu<XOR1>(x)); x = max(x, dppu<XOR2>(x)); x = max(x, dppu<HMIR>(x)); x = max(x, dppu<MIR>(x)); return x; }
__device__ __forceinline__ unsigned fsort(float v) { const unsigned f = __float_as_uint(v); return (f & 0x80000000u) ? ~f : (f | 0x80000000u); }
__device__ __forceinline__ void topk_rows(const Frame& F, const float* rows, int pitch, int tok0, int h, int nit) {
    int* eidx = (int*)(F.ws + WS_EIDX); float* egate = (float*)(F.ws + WS_EGATE);
    const int lane = F.lane, row = lane >> 4, l15 = lane & 15, rbase = lane & 48;
#pragma unroll 1
    for (int it = 0; it < nit; ++it) {
        const int t0 = tok0 + it * 4;
        float sval[2]; int sidx[2];
#pragma unroll
        for (int ps = 0; ps < 2; ++ps) {
            const int tok = t0 + 2 * ps + (row >> 1), p = row & 1;
            const float* src = rows + (size_t)(tok - tok0) * pitch + p * 128;
            const f32x4 va = *(const f32x4*)(src + l15 * 8), vb = *(const f32x4*)(src + l15 * 8 + 4);
            unsigned k[8];
#pragma unroll
            for (int j = 0; j < 4; ++j) { k[j] = (fsort(va[j]) & ~127u) | (unsigned)(127 - (l15 * 8 + j)); k[4 + j] = (fsort(vb[j]) & ~127u) | (unsigned)(127 - (l15 * 8 + 4 + j)); }
#define CE(i, j) do { const unsigned hi_ = max(k[i], k[j]), lo_ = min(k[i], k[j]); k[i] = hi_; k[j] = lo_; } while (0)
            CE(0, 1); CE(2, 3); CE(4, 5); CE(6, 7); CE(0, 2); CE(1, 3); CE(4, 6); CE(5, 7); CE(1, 2); CE(5, 6);
            CE(0, 4); CE(1, 5); CE(2, 6); CE(3, 7); CE(2, 4); CE(3, 5); CE(1, 2); CE(3, 4); CE(5, 6);
#undef CE
            unsigned sel = 0u;
#pragma unroll
            for (int r = 0; r < 16; ++r) {
                const unsigned m = row16_umax(k[0]); const bool win = k[0] == m;
#pragma unroll
                for (int j = 0; j < 7; ++j) k[j] = win ? k[j + 1] : k[j];
                k[7] = win ? 0u : k[7];
                sel = l15 == r ? m : sel;
            }
            sidx[ps] = 127 - (int)(sel & 127u); sval[ps] = src[sidx[ps]];
        }
        const int srcx = ((row & 1) * 2) * 16 + l15, srcy = srcx + 16;
        const float xv0 = lperm(sval[0], srcx), xv1 = lperm(sval[1], srcx), yv0 = lperm(sval[0], srcy), yv1 = lperm(sval[1], srcy);
        const int xi0 = lperm(sidx[0], srcx), xi1 = lperm(sidx[1], srcx), yi0 = lperm(sidx[0], srcy), yi1 = lperm(sidx[1], srcy);
        const float v1 = row < 2 ? xv0 : xv1, yv = row < 2 ? yv0 : yv1; const int i1 = row < 2 ? xi0 : xi1, yi = row < 2 ? yi0 : yi1;
        const unsigned long long CI0 = 0x0c87654322110000ull, CJ0 = 0x000000004040c840ull, CCN = 0x0442223414444444ull;
        const int ci0 = (int)(CI0 >> (4 * l15)) & 15, cj0 = (int)(CJ0 >> (4 * l15)) & 15, ccn = (int)(CCN >> (4 * l15)) & 15; const bool ccol = l15 >= 13;
        unsigned kq[4];
#pragma unroll
        for (int q = 0; q < 4; ++q) { const int ii = ci0 + (ccol ? q : 0), jj = cj0 + (ccol ? 0 : q);
            const float sm = lperm(v1, rbase + ii) + lperm(yv, rbase + (jj & 15));
            kq[q] = q < ccn ? ((fsort(sm) & ~63u) | (unsigned)(l15 * 4 + q)) : 0u; }
#define CE4(i, j) do { const unsigned hi_ = max(kq[i], kq[j]), lo_ = min(kq[i], kq[j]); kq[i] = hi_; kq[j] = lo_; } while (0)
        CE4(0, 1); CE4(2, 3); CE4(0, 2); CE4(1, 3); CE4(1, 2);
#undef CE4
        unsigned rec = 0u;
#pragma unroll
        for (int r = 0; r < 16; ++r) {
            const unsigned m = row16_umax(kq[0]); const bool win = kq[0] == m;
            kq[0] = win ? kq[1] : kq[0]; kq[1] = win ? kq[2] : kq[1]; kq[2] = win ? kq[3] : kq[2]; kq[3] = win ? 0u : kq[3];
            rec = l15 == r ? m : rec;
        }
        const int wl = (int)(rec >> 2) & 15, wq = (int)rec & 3; const bool wcol = wl >= 13;
        const int wi = ((int)(CI0 >> (4 * wl)) & 15) + (wcol ? wq : 0), wj = ((int)(CJ0 >> (4 * wl)) & 15) + (wcol ? 0 : wq);
        const float rec_s = lperm(v1, rbase + wi) + lperm(yv, rbase + wj);
        const int rec_e = lperm(i1, rbase + wi) * 128 + lperm(yi, rbase + wj);
        float smax = rec_s; smax = fmaxf(smax, dppf<XOR1>(smax)); smax = fmaxf(smax, dppf<XOR2>(smax)); smax = fmaxf(smax, dppf<HMIR>(smax)); smax = fmaxf(smax, dppf<MIR>(smax));
        const float e = __builtin_amdgcn_exp2f((rec_s - smax) * LOG2E);
        const float tot = row16_sum(e);
        const size_t o = ((size_t)h * NTOK + (t0 + row)) * 16 + l15;
        eidx[o] = rec_e; egate[o] = e / tot;
    }
}

__device__ void topk_tile(const Frame& F, int pm, int h) {
    const int tok0 = pm * 256 + F.wid * 32;
    topk_rows(F, (const float*)(F.ws + WS_SC) + (size_t)tok0 * DM + h * 256, DM, tok0, h, 8);
}

__device__ void phase_pe(const Frame& F, int l) {
    const unsigned char* U4 = F.wl(l, WL_UB); const unsigned char* V4 = F.wl(l, WL_VB);
    const float* SU = (const float*)F.wl(l, WL_SU); const float* SV = (const float*)F.wl(l, WL_SV);
    const unsigned char* h2 = F.ws + WS_H2; const float* sh2 = (const float*)(F.ws + WS_SH2); const bf16_t* x1 = (const bf16_t*)(F.ws + WS_X1);
    const int* eidx = (const int*)(F.ws + WS_EIDX); const float* egate = (const float*)(F.ws + WS_EGATE);
    const float* mod = (const float*)(F.ws + WS_MOD) + (size_t)l * NBATCH * MODW;
    const float* modn = (const float*)(F.ws + WS_MOD) + (size_t)(l + 1) * NBATCH * MODW;
    const float* g = F.a->in[IN_LN2G] + (size_t)l * DM; const float* bb = F.a->in[IN_LN2B] + (size_t)l * DM;
    const bool last = (l == DEPTH - 1);
    float* xo = last ? F.a->out : (float*)(F.ws + WS_XCUR);
    const int lane = F.lane, l15 = lane & 15;
    LAS float* pl = (LAS float*)((LAS unsigned char*)F.lds + 16384);
    for (int tt = F.bid * 32 + F.wid * 4; tt < NTOK; tt += F.G * 32) {
      {   const int bq = tt / SEQ, c = F.tid * 4;
          __syncthreads();
          *(LAS f32x4*)(pl + c) = *(const f32x4*)(mod + (size_t)bq * MODW + 5 * DM + c) + 1.0f; *(LAS f32x4*)(pl + 2048 + c) = *(const f32x4*)(g + c); *(LAS f32x4*)(pl + 4096 + c) = *(const f32x4*)(bb + c);
          if (!last) { *(LAS f32x4*)(pl + 6144 + c) = *(const f32x4*)(modn + (size_t)bq * MODW + DM + c) + 1.0f; *(LAS f32x4*)(pl + 8192 + c) = *(const f32x4*)(modn + (size_t)bq * MODW + c); }
          __syncthreads(); }
      constexpr int NTK = 4;
      for (int t = tt; t < tt + 4; t += NTK) {
        __syncthreads();
        unsigned hq[NTK][8]; float sh[NTK]; int hsum[NTK];
        int e0[NTK], e1[NTK]; float g0[NTK], g1[NTK];
#pragma unroll
        for (int tk = 0; tk < NTK; ++tk) {
            sh[tk] = sh2[t + tk]; int hsE = 0, hsO = 0;
#pragma unroll
            for (int i = 0; i < 8; ++i) { hq[tk][i] = *(const unsigned*)(h2 + (size_t)(t + tk) * DM + i * 256 + lane * 4); if (i & 1) hsO = __builtin_amdgcn_sdot4((int)hq[tk][i], 0x01010101, hsO, false); else hsE = __builtin_amdgcn_sdot4((int)hq[tk][i], 0x01010101, hsE, false); }
            hsum[tk] = xrow_isum(row16_isum(8 * hsO - 120 * hsE));
            const size_t eo0 = ((size_t)(lane >> 4) * NTOK + (t + tk)) * 16 + l15, eo1 = eo0 + (size_t)4 * NTOK * 16;
            e0[tk] = eidx[eo0]; e1[tk] = eidx[eo1]; g0[tk] = egate[eo0]; g1[tk] = egate[eo1];
        }
#pragma unroll
        for (int tk = 0; tk < NTK; ++tk) {
            LAS unsigned* cnt = (LAS unsigned*)F.lds + F.wid * 512; LAS int* sid = (LAS int*)(cnt + 64); LAS float* sgt = (LAS float*)(cnt + 192);
            if (lane < 9) cnt[lane] = 0u;
            const int o0 = e0[tk] >> 11, o1 = e1[tk] >> 11;
            const unsigned p0 = __atomic_fetch_add(cnt + o0, 1u, __ATOMIC_RELAXED), p1 = __atomic_fetch_add(cnt + o1, 1u, __ATOMIC_RELAXED);
            int cc[8], dd[9]; dd[0] = 0;
#pragma unroll
            for (int k = 0; k < 8; ++k) { cc[k] = (int)cnt[k]; dd[k + 1] = dd[k] + (cc[k] < 16 ? 16 - cc[k] : 0); }
            unsigned d0 = 16u * (unsigned)o0 + p0, d1 = 16u * (unsigned)o1 + p1;
            if (p0 >= 16u) { const int r = (int)__atomic_fetch_add(cnt + 8, 1u, __ATOMIC_RELAXED);
#pragma unroll
                for (int k = 0; k < 8; ++k) d0 = (r >= dd[k] && r < dd[k + 1]) ? (unsigned)(16 * k + cc[k] + r - dd[k]) : d0; }
            if (p1 >= 16u) { const int r = (int)__atomic_fetch_add(cnt + 8, 1u, __ATOMIC_RELAXED);
#pragma unroll
                for (int k = 0; k < 8; ++k) d1 = (r >= dd[k] && r < dd[k + 1]) ? (unsigned)(16 * k + cc[k] + r - dd[k]) : d1; }
            sid[d0] = e0[tk]; sgt[d0] = g0[tk]; sid[d1] = e1[tk]; sgt[d1] = g1[tk];
            e0[tk] = sid[lane]; e1[tk] = sid[64 + lane]; g0[tk] = sgt[lane]; g1[tk] = sgt[64 + lane];
            asm volatile("s_waitcnt lgkmcnt(0)" ::: "memory");
        }
        int dA[NTK], dB[NTK];
#pragma unroll
        for (int tk = 0; tk < NTK; ++tk) { dA[tk] = 0; dB[tk] = 0; }
#pragma unroll 1
        for (int gi = 0; gi < 8; ++gi) {
#pragma unroll
          for (int tk = 0; tk < NTK; ++tk) {
            int stage = 0;
            u32x4 ub[16];
#pragma unroll
            for (int k = 0; k < 16; ++k) { const int slot = gi * 16 + k; const int e = __builtin_amdgcn_readlane(slot < 64 ? e0[tk] : e1[tk], slot & 63);
                ub[k] = *(const u32x4*)(U4 + (size_t)e * (DM / 2) + lane * 16); }
#pragma unroll
            for (int k = 0; k < 16; ++k) { int a0 = 0, a1 = 0; const unsigned w[4] = {ub[k].x, ub[k].y, ub[k].z, ub[k].w};
#pragma unroll
                for (int d = 0; d < 4; ++d) { a0 = __builtin_amdgcn_sdot4((int)(w[d] & 0x0F0F0F0Fu), (int)hq[tk][2 * d], a0, false); a1 = __builtin_amdgcn_sdot4((int)(w[d] & 0xF0F0F0F0u), (int)hq[tk][2 * d + 1], a1, false); }
                const int rs = row16_isum((a0 << 4) + a1);
                stage = (l15 == k) ? rs : stage; }
            const int dsum = xrow_isum(stage);
            const bool mine = (lane >> 4) == (gi & 3);
            if (gi < 4) dA[tk] = mine ? dsum : dA[tk]; else dB[tk] = mine ? dsum : dB[tk];
            asm volatile("" ::: "memory");
          }
        }
        LAS unsigned* cf = (LAS unsigned*)((LAS unsigned char*)F.lds + 57344 + F.wid * 1024);
#pragma unroll
        for (int tk = 0; tk < NTK; ++tk) {
            const float aA = g0[tk] * gelu_erf((float)(dA[tk] + hsum[tk]) * (0.0625f * SU[e0[tk]] * sh[tk])) * SV[e0[tk]];
            const float aB = g1[tk] * gelu_erf((float)(dB[tk] + hsum[tk]) * (0.0625f * SU[e1[tk]] * sh[tk])) * SV[e1[tk]];
            const float amx = wave_max(fmaxf(fabsf(aA), fabsf(aB)));
            const float sa_ = amx > 0.f ? amx * (1.0f / 127.0f) : 1.0f, sai = 1.0f / sa_;
            const int qA = (int)__builtin_rintf(aA * sai), qB = (int)__builtin_rintf(aB * sai);
            const int qsum_ = xrow_isum(row16_isum(qA + qB));
            const unsigned pkA_ = ((unsigned)dppu<0x00>((unsigned)qA) & 0xffu) | (((unsigned)dppu<0x55>((unsigned)qA) & 0xffu) << 8) | (((unsigned)dppu<0xAA>((unsigned)qA) & 0xffu) << 16) | ((unsigned)dppu<0xFF>((unsigned)qA) << 24);
            const unsigned pkB_ = ((unsigned)dppu<0x00>((unsigned)qB) & 0xffu) | (((unsigned)dppu<0x55>((unsigned)qB) & 0xffu) << 8) | (((unsigned)dppu<0xAA>((unsigned)qB) & 0xffu) << 16) | ((unsigned)dppu<0xFF>((unsigned)qB) << 24);
            if ((lane & 3) == 0) { cf[tk * 32 + (lane >> 2)] = pkA_; cf[tk * 32 + 16 + (lane >> 2)] = pkB_; }
            if (lane == 0) { cf[128 + tk] = __float_as_uint(sa_); cf[132 + tk] = (unsigned)qsum_; }
        }
        asm volatile("s_waitcnt lgkmcnt(0)" ::: "memory");
        {   constexpr int pr = 0;
        int yi[NTK][8][4];
#pragma unroll
        for (int tk = 0; tk < NTK; ++tk)
#pragma unroll
            for (int i = 0; i < 8; ++i)
#pragma unroll
                for (int j = 0; j < 4; ++j) yi[tk][i][j] = 0;
#pragma unroll 1
        for (int sb = 0; sb < 128; sb += 16) {
#pragma unroll
          for (int tk = 0; tk < NTK; ++tk) {
            u32x4 vb[16]; unsigned a4[4];
#pragma unroll
            for (int k = 0; k < 16; ++k) { const int slot = sb + k; const int e = __builtin_amdgcn_readlane(slot < 64 ? e0[pr + tk] : e1[pr + tk], slot & 63);
                vb[k] = *(const u32x4*)(V4 + (size_t)e * (DM / 2) + lane * 16); }
#pragma unroll
            for (int qd = 0; qd < 4; ++qd) a4[qd] = cf[(pr + tk) * 32 + (sb >> 2) + qd];
#pragma unroll
            for (int qd = 0; qd < 4; ++qd) {
#pragma unroll
                for (int d = 0; d < 4; ++d) {
                    const unsigned w1 = vb[4 * qd][d], w2 = vb[4 * qd + 1][d], w3 = vb[4 * qd + 2][d], w4 = vb[4 * qd + 3][d];
                    const unsigned p01 = __builtin_amdgcn_perm(w2, w1, 0x05010400u), p01h = __builtin_amdgcn_perm(w2, w1, 0x07030602u), p23 = __builtin_amdgcn_perm(w4, w3, 0x05010400u), p23h = __builtin_amdgcn_perm(w4, w3, 0x07030602u);
                    const unsigned t4[4] = {__builtin_amdgcn_perm(p23, p01, 0x05040100u), __builtin_amdgcn_perm(p23, p01, 0x07060302u), __builtin_amdgcn_perm(p23h, p01h, 0x05040100u), __builtin_amdgcn_perm(p23h, p01h, 0x07060302u)};
#pragma unroll
                    for (int j = 0; j < 4; ++j) {
                        yi[tk][2 * d][j] = __builtin_amdgcn_sdot4((int)(t4[j] & 0x0F0F0F0Fu), (int)a4[qd], yi[tk][2 * d][j], false);
                        yi[tk][2 * d + 1][j] = __builtin_amdgcn_sdot4((int)(t4[j] & 0xF0F0F0F0u), (int)a4[qd], yi[tk][2 * d + 1][j], false); }
                }
            }
            asm volatile("" ::: "memory");
          }
        }
#pragma unroll
        for (int tk = 0; tk < NTK; ++tk) {
        const int tq = t + pr + tk;
        float z[8][4]; float s = 0.f; const int qs_ = (int)cf[132 + pr + tk]; const float sa_ = __uint_as_float(cf[128 + pr + tk]); const int ybias = 15 * qs_; const float sah = 0.5f * sa_, sa16 = 0.0625f * sa_;
#pragma unroll
        for (int i = 0; i < 8; ++i) { const int c = i * 256 + lane * 4; const u32x2 xr = __builtin_nontemporal_load((const u32x2*)(x1 + (size_t)tq * DM + c)); const f32x4 xv = {bf_lo(xr.x), bf_hi(xr.x), bf_lo(xr.y), bf_hi(xr.y)}, gf1 = *(const LAS f32x4*)(pl + c);
#pragma unroll
            for (int j = 0; j < 4; ++j) { const float yy = (i & 1) ? sa16 * (float)(yi[tk][i][j] + 8 * qs_) : sah * (float)(2 * yi[tk][i][j] - ybias); const float zz = fmaf(ALPHA, xv[j], gf1[j] * yy); z[i][j] = zz; s += zz; } }
        const float mean = wave_sum(s) * (1.0f / DM); float qv = 0.f;
#pragma unroll
        for (int i = 0; i < 8; ++i)
#pragma unroll
            for (int j = 0; j < 4; ++j) { z[i][j] -= mean; qv += z[i][j] * z[i][j]; }
        const float rstd = __builtin_amdgcn_rsqf(wave_sum(qv) * (1.0f / DM) + LN_EPS);
        float hmax = 0.f;
#pragma unroll
        for (int i = 0; i < 8; ++i) { const int c = i * 256 + lane * 4; const f32x4 gg = *(const LAS f32x4*)(pl + 2048 + c), be = *(const LAS f32x4*)(pl + 4096 + c); f32x4 o4;
#pragma unroll
            for (int j = 0; j < 4; ++j) o4[j] = fmaf(z[i][j] * rstd, gg[j], be[j]);
            __builtin_nontemporal_store(o4, (f32x4*)(xo + (size_t)tq * DM + c));
            if (!last) { const f32x4 shv = *(const LAS f32x4*)(pl + 8192 + c), sc1 = *(const LAS f32x4*)(pl + 6144 + c);
#pragma unroll
                for (int j = 0; j < 4; ++j) { z[i][j] = fmaf(o4[j], sc1[j], shv[j]); hmax = fmaxf(hmax, fabsf(z[i][j])); } } }
        if (!last) {
            hmax = wave_max(hmax); const float hs = hmax > 0.f ? hmax * (1.0f / 6.0f) : 1.0f, hi = 1.0f / hs;
            unsigned char* hrow = F.ws + WS_H + (size_t)tq * (DM / 2);
#pragma unroll
            for (int i = 0; i < 8; ++i) *(unsigned short*)(hrow + i * 128 + lane * 2) = (unsigned short)(fp4_code(z[i][0] * hi) | (fp4_code(z[i][1] * hi) << 4) | (fp4_code(z[i][2] * hi) << 8) | (fp4_code(z[i][3] * hi) << 12));
            if (lane == 0) ((float*)(F.ws + WS_SH))[tq] = hs;
        }
        }
        }
    }
    }
}

constexpr int NPL = 7;
constexpr int N_PHASES = 1 + NPL * DEPTH;
__global__ void __launch_bounds__(NTHREADS, 2) mk_fwd(Args args) {
    extern __shared__ __attribute__((aligned(16))) unsigned char lds_raw[];
    Frame F; F.a = &args; F.ws = args.ws; F.lds = (char*)lds_raw; F.tid = threadIdx.x; F.lane = F.tid & 63; F.wid = __builtin_amdgcn_readfirstlane(F.tid >> 6); F.G = gridDim.x; F.bid = blockIdx.x;
    LAS unsigned char* ldsl = (LAS unsigned char*)lds_raw;
    volatile LAS unsigned* misc = (volatile LAS unsigned*)(ldsl + LDS_MISC);
    if (F.tid < 64) misc[F.tid] = 0u;
    __syncthreads();
    XcdBarrier bar; bar.bar = (unsigned*)(args.ws + WS_CTL); bar.x = 0; bar.st = misc;
    if (args.use_bar) bar = xcd_barrier_post((unsigned*)(args.ws + WS_CTL), misc);
    const int lo = args.ph_lo, hi = args.ph_hi;
#define REFRAME() do { int tz_ = threadIdx.x; asm volatile("" : "+v"(tz_)); F.tid = tz_; F.lane = tz_ & 63; F.wid = __builtin_amdgcn_readfirstlane(tz_ >> 6); } while (0)
#ifndef MK_PHMASK
#define MK_PHMASK 0x3ff
#endif
#define PHJ(j) ((MK_PHMASK >> (j)) & 1)
#ifndef MK_DUP
#define MK_DUP 0
#endif
#define DUPJ(j) ((MK_DUP >> (j)) & 1)
#define IN(k) (lo <= (k) && (k) < hi)
#define SEAM(k) do { if (args.use_bar && IN((k) + 1)) xcd_barrier(bar); } while (0)
    if (PHJ(0) && IN(0)) { REFRAME(); phase_c0(F); if (DUPJ(0)) { __syncthreads(); phase_c0(F); } SEAM(0); }
    for (int l = 0; l < DEPTH; ++l) {
        const int pb = 1 + NPL * l;
        if (PHJ(2) && IN(pb + 0)) {
            REFRAME();
            pg8::Gemm g{(const bf16_t*)(F.ws + WS_H), (const bf16_t*)F.wl(l, WL_WIN), DM / 4, DM / 4}; pg8::SchedG1 S; S.init(NTOK, INW, DM / 4, F.G, F.bid);
            pg8::EpiG1 E{(float*)(F.ws + WS_QKRAW), (bf16_t*)(F.ws + WS_QKVB), (unsigned char*)(F.ws + WS_GATES), (const float*)(F.ws + WS_SH), (const float*)F.wl(l, WL_SWIN)};
            pg8::gemm_phase(ldsl + LDS_RING, g, S, E); if (DUPJ(2)) pg8::gemm_phase(ldsl + LDS_RING, g, S, E);
            asm volatile("s_waitcnt vmcnt(0)" ::: "memory"); __syncthreads(); REFRAME();
            pg8::Unit u; for (int i = 0; S.next(i, u); ++i) if (u.pn < 5) norm_rope_tile(F, l, u.pm, u.pn);
            SEAM(pb + 0);
        }
        if (PHJ(3) && IN(pb + 1)) { REFRAME(); phase_att(F, l); if (DUPJ(3)) phase_att(F, l); SEAM(pb + 1); }
        if (PHJ(4) && IN(pb + 2)) {
            REFRAME();
            pg8::Gemm g{(const bf16_t*)(F.ws + WS_AO), (const bf16_t*)F.wl(l, WL_WP), AOW, AOW}; pg8::SchedSimple S; S.init(NTOK, DM, AOW, F.G, F.bid);
            pg8::EpiG2 E{(const unsigned char*)(F.ws + WS_GATES), (bf16_t*)(F.ws + WS_MERGED), (const float*)(F.ws + WS_LSEB), (float*)(F.lds + LDS_WTAB)};
            pg8::gemm_phase(ldsl + LDS_RING, g, S, E); if (DUPJ(5)) pg8::gemm_phase(ldsl + LDS_RING, g, S, E); SEAM(pb + 2);
        }
        if (PHJ(5) && IN(pb + 3)) {
            REFRAME();
            pg8::Gemm g{(const bf16_t*)(F.ws + WS_MERGED), (const bf16_t*)F.wl(l, WL_WO), DM, DM}; pg8::SchedSimple S; S.init(NTOK, DM, DM, F.G, F.bid);
            pg8::EpiG3 E{(const float*)(F.ws + WS_MOD) + (size_t)l * NBATCH * MODW + 2 * DM, (bf16_t*)(F.ws + WS_Z)};
            pg8::gemm_phase(ldsl + LDS_RING, g, S, E); if (DUPJ(6)) pg8::gemm_phase(ldsl + LDS_RING, g, S, E); SEAM(pb + 3);
        }
        if (PHJ(6) && IN(pb + 4)) { REFRAME(); phase_ln1(F, l); if (DUPJ(7)) phase_ln1(F, l); SEAM(pb + 4); }
        if (PHJ(7) && IN(pb + 5)) {
            REFRAME();
            pg8::Gemm g{(const bf16_t*)(F.ws + WS_H2), (const bf16_t*)F.wl(l, WL_WQK), DM / 2, DM / 2}; pg8::SchedSimple S; S.init(NTOK, DM, DM / 2, F.G, F.bid);
            pg8::EpiSC8 E{(float*)(F.ws + WS_SC), (const float*)(F.ws + WS_SH2), (const float*)F.wl(l, WL_SWQK), &F, (float*)F.lds};
            pg8::gemm_phase(ldsl + LDS_RING, g, S, E);
            asm volatile("s_waitcnt vmcnt(0)" ::: "memory"); __syncthreads(); REFRAME();
            pg8::Unit u, un; for (int i = 0; S.next(i, u); ++i) if (S.next(i + 1, un)) topk_tile(F, u.pm, u.pn);
            if (DUPJ(9)) { __syncthreads(); pg8::gemm_phase(ldsl + LDS_RING, g, S, E); }
            SEAM(pb + 5);
        }
        if (PHJ(8) && IN(pb + 6)) { REFRAME(); phase_pe(F, l); if (DUPJ(10)) phase_pe(F, l); SEAM(pb + 6); }
    }
#undef IN
#undef SEAM
}

extern "C" void kernel_launch(void* const* d_in, const int* in_sizes, int n_in, void* d_out, int out_size, void* d_ws, size_t ws_size, hipStream_t stream) {
    static int grid = 0;
    if (grid == 0) {
        if (n_in != 20 || out_size != NTOK * DM || ws_size < WS_END) { fprintf(stderr, "kernel_launch: unexpected shapes: n_in %d out %d ws %zu (need %zu)\n", n_in, out_size, ws_size, (size_t)WS_END); grid = -1; return; }
        int dev = 0, cus = 0, per_cu = 0;
        if (hipGetDevice(&dev) != hipSuccess || hipDeviceGetAttribute(&cus, hipDeviceAttributeMultiprocessorCount, dev) != hipSuccess) { grid = -1; return; }
        if (hipFuncSetAttribute((const void*)mk_fwd, hipFuncAttributeMaxDynamicSharedMemorySize, LDS_BYTES) != hipSuccess) { fprintf(stderr, "kernel_launch: hipFuncSetAttribute failed\n"); grid = -1; return; }
        if (hipOccupancyMaxActiveBlocksPerMultiprocessor(&per_cu, (const void*)mk_fwd, NTHREADS, LDS_BYTES) != hipSuccess || per_cu < 1) { fprintf(stderr, "kernel_launch: occupancy query reports %d\n", per_cu); (void)hipGetLastError(); }
        grid = cus;
    }
    if (grid < 0) return;
    (void)hipMemsetAsync((char*)d_ws + WS_CTL, 0, CTL_BYTES, stream);
    Args a{};
    for (int i = 0; i < 20; ++i) a.in[i] = (const float*)d_in[i];
    a.out = (float*)d_out; a.ws = (unsigned char*)d_ws; a.pad = 0;
#if MK_ONE_LAUNCH
    a.ph_lo = 0; a.ph_hi = N_PHASES; a.use_bar = 1;
    hipLaunchKernelGGL(mk_fwd, dim3(grid), dim3(NTHREADS), LDS_BYTES, stream, a);
#else
    for (int p = 0; p < N_PHASES; ++p) { a.ph_lo = p; a.ph_hi = p + 1; a.use_bar = 0; hipLaunchKernelGGL(mk_fwd, dim3(grid), dim3(NTHREADS), LDS_BYTES, stream, a); }
#endif
    const hipError_t le = hipPeekAtLastError();
    if (le != hipSuccess) fprintf(stderr, "kernel_launch: launch failed: %s\n", hipGetErrorName(le));
}
```

```cpp
#include <hip/hip_runtime.h>
#include <hip/hip_bf16.h>
#include <cstdio>
#include <cstdint>

#ifndef MK_ONE_LAUNCH
#define MK_ONE_LAUNCH 1
#endif

#define LAS __attribute__((address_space(3)))
typedef unsigned short bf16_t;
typedef short bf16x8 __attribute__((ext_vector_type(8)));
typedef short s16x4 __attribute__((ext_vector_type(4)));
typedef float f32x2 __attribute__((ext_vector_type(2)));
typedef float f32x4 __attribute__((ext_vector_type(4)));
typedef float f32x16 __attribute__((ext_vector_type(16)));
typedef unsigned u32x2 __attribute__((ext_vector_type(2)));
typedef unsigned u32x4 __attribute__((ext_vector_type(4)));
typedef __bf16 bf16x2v __attribute__((ext_vector_type(2)));
typedef int i32x4 __attribute__((ext_vector_type(4)));
typedef int i32x8 __attribute__((ext_vector_type(8)));

constexpr int DM = 2048, NBATCH = 2, SEQ = 4096, NTOK = NBATCH * SEQ, DEPTH = 2, HD = 128;
constexpr int INW = 11520, QKVW = 5376, GLW = 6144, QKRAWW = 1280, AOW = 2816, MODW = 6 * DM;
constexpr int COL_QA = 0, COL_KA = 1024, COL_VA = 1280, COL_QB = 1536, COL_KB = 2304, COL_VB = 3072, COL_QC = 3840, COL_KC = 4864, COL_VC = 5120;
constexpr int AO_A = 0, AO_B = 1024, AO_C = 1792;
constexpr int NEXP = 16384, PEER_HK = 128;
constexpr float LN_EPS = 1e-5f, QK_EPS = 1e-6f, ALPHA = 1.4142135623730951f, LOG2E = 1.4426950408889634f, LN2 = 0.6931471805599453f;
constexpr int NTHREADS = 512, NWAVES = 8;

constexpr size_t al256(size_t x) { return (x + 255) / 256 * 256; }
constexpr size_t WS_CTL = 0;
constexpr size_t CTL_BYTES = 65536;
constexpr size_t WS_MOD = WS_CTL + CTL_BYTES;
constexpr size_t WS_ROPE = WS_MOD + al256((size_t)DEPTH * NBATCH * MODW * 4);
constexpr size_t WS_LSEB = WS_ROPE + 64 * 32 * 2 * 4;
constexpr size_t WS_W0 = WS_LSEB + (size_t)NTOK * 8 * 4;
constexpr size_t WL_WIN = 0;
constexpr size_t WL_SWIN = WL_WIN + (size_t)INW * DM / 2;
constexpr size_t WL_WP = WL_SWIN + al256((size_t)INW * 4);
constexpr size_t WL_WO = WL_WP + (size_t)DM * AOW * 2;
constexpr size_t WL_WQK = WL_WO + (size_t)DM * DM * 2;
constexpr size_t WL_SWQK = WL_WQK + (size_t)DM * DM;
constexpr size_t WL_UB = WL_SWQK + (size_t)DM * 4;
constexpr size_t WL_VB = WL_UB + (size_t)NEXP * DM / 2;
constexpr size_t WL_SU = WL_VB + (size_t)NEXP * DM / 2;
constexpr size_t WL_SV = WL_SU + (size_t)NEXP * 4;
constexpr size_t WL_BYTES = WL_SV + (size_t)NEXP * 4;
constexpr size_t WS_H = WS_W0 + DEPTH * WL_BYTES;
constexpr size_t WS_SH = WS_H + (size_t)NTOK * DM / 2;
constexpr size_t WS_H2 = WS_SH + (size_t)NTOK * 4;
constexpr size_t WS_SH2 = WS_H2 + (size_t)NTOK * DM;
constexpr size_t WS_QKVB = WS_SH2 + (size_t)NTOK * 4;
constexpr size_t WS_QKRAW = WS_QKVB + (size_t)NTOK * QKVW * 2;
constexpr size_t WS_GATES = WS_QKRAW + (size_t)NTOK * QKRAWW * 4;
constexpr size_t WS_SC = WS_GATES;
constexpr size_t WS_AO = WS_GATES + (size_t)NTOK * GLW * 2;
constexpr size_t WS_MTMP = WS_AO + (size_t)NTOK * AOW * 2;
constexpr size_t WS_Z = WS_MTMP;
constexpr size_t WS_MERGED = WS_MTMP + (size_t)NTOK * DM * 4;
constexpr size_t WS_X1 = WS_MERGED + (size_t)NTOK * DM * 2;
constexpr size_t WS_XCUR = WS_X1 + (size_t)NTOK * DM * 4;
constexpr size_t WS_EIDX = WS_XCUR + (size_t)NTOK * DM * 4;
constexpr size_t WS_EGATE = WS_EIDX + (size_t)NTOK * 128 * 4;
constexpr size_t WS_END = WS_EGATE + (size_t)NTOK * 128 * 4;
static_assert(WS_SC + (size_t)NTOK * DM * 4 <= WS_AO, "SC alias must fit in GATES");

__device__ __forceinline__ unsigned cvtpk(float lo, float hi) { return __builtin_bit_cast(unsigned, __builtin_convertvector((f32x2){lo, hi}, bf16x2v)); }
__device__ __forceinline__ float bf_lo(unsigned w) { return __uint_as_float(w << 16); }
__device__ __forceinline__ float bf_hi(unsigned w) { return __uint_as_float(w & 0xffff0000u); }
__device__ __forceinline__ float dot2(unsigned a, unsigned b, float acc) { return __builtin_amdgcn_fdot2_f32_bf16(__builtin_bit_cast(bf16x2v, a), __builtin_bit_cast(bf16x2v, b), acc, false); }
template <int CTRL> __device__ __forceinline__ float dppf(float x) { return __builtin_bit_cast(float, __builtin_amdgcn_mov_dpp(__builtin_bit_cast(int, x), CTRL, 0xf, 0xf, true)); }
template <int CTRL> __device__ __forceinline__ unsigned dppu(unsigned x) { return (unsigned)__builtin_amdgcn_mov_dpp((int)x, CTRL, 0xf, 0xf, true); }
constexpr int XOR1 = 0xB1, XOR2 = 0x4E, HMIR = 0x141, MIR = 0x140;
__device__ __forceinline__ float row16_sum(float x) { x += dppf<XOR1>(x); x += dppf<XOR2>(x); x += dppf<HMIR>(x); x += dppf<MIR>(x); return x; }
__device__ __forceinline__ float xrow_sum(float x) {
    auto s = __builtin_amdgcn_permlane16_swap(__float_as_uint(x), __float_as_uint(x), false, false);
    x = __uint_as_float(s[0]) + __uint_as_float(s[1]);
    auto t = __builtin_amdgcn_permlane32_swap(__float_as_uint(x), __float_as_uint(x), false, false);
    return __uint_as_float(t[0]) + __uint_as_float(t[1]);
}
__device__ __forceinline__ float wave_sum(float x) { return xrow_sum(row16_sum(x)); }
__device__ __forceinline__ int lperm(int v, int src) { return __builtin_amdgcn_ds_bpermute(src << 2, v); }
__device__ __forceinline__ unsigned lperm(unsigned v, int src) { return (unsigned)__builtin_amdgcn_ds_bpermute(src << 2, (int)v); }
__device__ __forceinline__ float lperm(float v, int src) { return __int_as_float(__builtin_amdgcn_ds_bpermute(src << 2, __float_as_int(v))); }
__device__ __forceinline__ float wave_max(float x) {
    x = fmaxf(x, dppf<XOR1>(x)); x = fmaxf(x, dppf<XOR2>(x)); x = fmaxf(x, dppf<HMIR>(x)); x = fmaxf(x, dppf<MIR>(x));
    auto s = __builtin_amdgcn_permlane16_swap(__float_as_uint(x), __float_as_uint(x), false, false); x = fmaxf(__uint_as_float(s[0]), __uint_as_float(s[1]));
    auto t = __builtin_amdgcn_permlane32_swap(__float_as_uint(x), __float_as_uint(x), false, false); return fmaxf(__uint_as_float(t[0]), __uint_as_float(t[1]));
}
__device__ __forceinline__ int row16_isum(int x) { x += (int)dppu<XOR1>((unsigned)x); x += (int)dppu<XOR2>((unsigned)x); x += (int)dppu<HMIR>((unsigned)x); x += (int)dppu<MIR>((unsigned)x); return x; }
__device__ __forceinline__ int xrow_isum(int x) {
    auto s = __builtin_amdgcn_permlane16_swap((unsigned)x, (unsigned)x, false, false); x = (int)s[0] + (int)s[1];
    auto t = __builtin_amdgcn_permlane32_swap((unsigned)x, (unsigned)x, false, false); return (int)t[0] + (int)t[1];
}
__device__ __forceinline__ unsigned pack4_raw(float a, float b, float c, float d) {
    unsigned w = __builtin_amdgcn_cvt_pk_u8_f32(a, 0, 0u); w = __builtin_amdgcn_cvt_pk_u8_f32(b, 1, w); w = __builtin_amdgcn_cvt_pk_u8_f32(c, 2, w); return __builtin_amdgcn_cvt_pk_u8_f32(d, 3, w);
}
__device__ __forceinline__ unsigned pack4_u8(float a, float b, float c, float d) {
    unsigned w = __builtin_amdgcn_cvt_pk_u8_f32(__builtin_rintf(a + 128.f), 0, 0u); w = __builtin_amdgcn_cvt_pk_u8_f32(__builtin_rintf(b + 128.f), 1, w);
    w = __builtin_amdgcn_cvt_pk_u8_f32(__builtin_rintf(c + 128.f), 2, w); return __builtin_amdgcn_cvt_pk_u8_f32(__builtin_rintf(d + 128.f), 3, w);
}
__device__ __forceinline__ float gelu_erf(float v) {
    const float av = fabsf(v), t = __builtin_amdgcn_rcpf(fmaf(av, 0.2316418882f, 1.0f));
    float q = fmaf(t, 0.5307027145f, -0.7265760135f); q = fmaf(q, t, 0.7107068705f); q = fmaf(q, t, -0.142248368f); q = fmaf(q, t, 0.127414796f); q = q * t;
    const float e = __builtin_amdgcn_exp2f(v * v * -0.72134752044f);
    const float m = v * (q * e);
    return v < 0.f ? m : v - m;
}
__device__ __forceinline__ void ld8f(const float* p, float (&v)[8]) { const f32x4 a = *(const f32x4*)p, b = *(const f32x4*)(p + 4); v[0] = a[0]; v[1] = a[1]; v[2] = a[2]; v[3] = a[3]; v[4] = b[0]; v[5] = b[1]; v[6] = b[2]; v[7] = b[3]; }
__device__ __forceinline__ void st8f(float* p, const float (&v)[8]) { *(f32x4*)p = (f32x4){v[0], v[1], v[2], v[3]}; *(f32x4*)(p + 4) = (f32x4){v[4], v[5], v[6], v[7]}; }
__device__ __forceinline__ u32x4 pack8(const float (&v)[8]) { return (u32x4){cvtpk(v[0], v[1]), cvtpk(v[2], v[3]), cvtpk(v[4], v[5]), cvtpk(v[6], v[7])}; }

#define XB_TMO      128
#define XB_XCNT(j)  (256  + 64 * (j))
#define XB_XSUB(j)  (1280 + 64 * (j))
#define XB_XGEN(j)  (2304 + 64 * (j))
#define XB_TOP      3328
#define XB_TOPGEN   3392
#define XCD_BAR_WORDS 3456
#define XB_MODCNT   3520
#define XB_SPIN_CAP (1u << 22)
__device__ __forceinline__ unsigned xb_ld(unsigned* p)              { return __hip_atomic_load(p, __ATOMIC_RELAXED, __HIP_MEMORY_SCOPE_AGENT); }
__device__ __forceinline__ unsigned xb_add(unsigned* p, unsigned v) { return __hip_atomic_fetch_add(p, v, __ATOMIC_RELAXED, __HIP_MEMORY_SCOPE_AGENT); }
__device__ __forceinline__ unsigned xb_xcc_id() { return (unsigned)__builtin_amdgcn_s_getreg((3 << 11) | 20) & 0xFu; }
#define XB_SPIN(cond, bar) do { unsigned _sp = 0; while (cond) { __builtin_amdgcn_s_sleep(1); \
    if ((++_sp & 255u) == 0u) { if (xb_ld(&(bar)[XB_TMO])) break; if (_sp > XB_SPIN_CAP) { atomicAdd(&(bar)[XB_TMO], 1u); break; } } } } while (0)
struct XcdBarrier { unsigned* bar; unsigned x; volatile LAS unsigned* st; };
__device__ __forceinline__ XcdBarrier xcd_barrier_post(unsigned* bar, volatile LAS unsigned* st) {
    XcdBarrier b; b.bar = bar; b.x = xb_xcc_id(); b.st = st;
    if (threadIdx.x == 0) (void)xb_add(&bar[XB_XCNT(b.x)], 1u);
    return b;
}
__device__ __forceinline__ void xcd_barrier_complete(unsigned* bar, unsigned x, unsigned& nloc, unsigned& nx) {
    const unsigned G = gridDim.x * gridDim.y * gridDim.z;
    unsigned sum, cnt, mine, sp = 0u;
    for (;;) {
        sum = 0u; cnt = 0u; mine = 0u;
#pragma unroll
        for (unsigned j = 0; j < 16; ++j) { const unsigned c = xb_ld(&bar[XB_XCNT(j)]); sum += c; cnt += (c > 0u) ? 1u : 0u; mine = (j == x) ? c : mine; }
        if (sum == G) break;
        __builtin_amdgcn_s_sleep(1);
        if ((++sp & 255u) == 0u) { if (xb_ld(&bar[XB_TMO])) break; if (sp > XB_SPIN_CAP) { atomicAdd(&bar[XB_TMO], 1u); break; } }
    }
    nloc = mine > 0u ? mine : 1u; nx = cnt > 0u ? cnt : 1u;
}
__device__ __forceinline__ void xcd_barrier(const XcdBarrier& b) {
    asm volatile("s_waitcnt vmcnt(0)" ::: "memory");
    __syncthreads();
    if (threadIdx.x == 0) {
        unsigned* bar = b.bar;
        __builtin_amdgcn_s_waitcnt(0);
        unsigned nloc = b.st[0], nx = b.st[1];
        if (nloc == 0u) { xcd_barrier_complete(bar, b.x, nloc, nx); b.st[0] = nloc; b.st[1] = nx; }
        const unsigned old = xb_add(&bar[XB_XSUB(b.x)], 1u);
        const unsigned gen = old / nloc;
        if (old + 1u == (gen + 1u) * nloc) {
            __builtin_amdgcn_fence(__ATOMIC_RELEASE, "agent");
            asm volatile("s_waitcnt vmcnt(0)" ::: "memory");
            const unsigned og = xb_add(&bar[XB_TOP], 1u);
            const unsigned tg = og / nx;
            if (og + 1u == (tg + 1u) * nx) xb_add(&bar[XB_TOPGEN], 1u);
            else XB_SPIN(xb_ld(&bar[XB_TOPGEN]) == tg, bar);
            xb_add(&bar[XB_XGEN(b.x)], 1u);
            __builtin_amdgcn_fence(__ATOMIC_ACQUIRE, "agent");
            asm volatile("s_waitcnt vmcnt(0)" ::: "memory");
        } else {
            XB_SPIN(xb_ld(&bar[XB_XGEN(b.x)]) == gen, bar);
            __builtin_amdgcn_fence(__ATOMIC_ACQUIRE, "agent");
            asm volatile("s_waitcnt vmcnt(0)" ::: "memory");
        }
    }
    __syncthreads();
}

struct Frame;
__device__ __forceinline__ void topk_rows(const Frame& F, const float* rows, int pitch, int tok0, int h, int nit);
namespace pg8 {
constexpr int BM = 256, BK = 64, HALF = 128, HTB = HALF * BK * 2, STAGE_BYTES = 8 * HTB, NXCD = 8, WGM = 8;
__host__ __device__ __forceinline__ int lds_byte(int r, int c) { const int st = (r >> 4) * 2 + (c >> 5), rr = r & 15, cc = c & 31, ob = rr * 64 + cc * 2; return st * 1024 + (ob ^ (((ob >> 9) & 1) << 5)); }
__host__ __device__ __forceinline__ void stage_rc(int b, int& R, int& C) { const int st = b / 1024, sb = b % 1024, swz = sb ^ (((sb >> 9) & 1) << 5); R = (st >> 1) * 16 + swz / 64; C = (st & 1) * 32 + (swz % 64) / 2; }
__host__ __device__ __forceinline__ int perm32(int rho) { const int n = rho >> 4, i = rho & 15; return 8 * (i >> 2) + 4 * n + (i & 3); }
struct Unit { int pm, pn, koff, nt, aux; };
struct Gemm { const bf16_t* A; const bf16_t* Bt; int lda, ldb; };
struct TileOrder {
    int nM, nN, nwg;
    __device__ void init(int M, int N) { nM = M / BM; nN = N / BM; nwg = nM * nN; }
    __device__ bool tile(long L, int& pm, int& pn) const {
        if (L >= nwg) return false;
        int wgid = (int)L; { const int q = nwg / NXCD, r = nwg % NXCD, xcd = wgid % NXCD, off = wgid / NXCD; wgid = (xcd < r ? xcd * (q + 1) : r * (q + 1) + (xcd - r) * q) + off; }
        const int nig = WGM * nN, gid = wgid / nig, fm = gid * WGM, gsz = (nM - fm) < WGM ? (nM - fm) : WGM;
        pm = fm + ((wgid % nig) % gsz); pn = (wgid % nig) / gsz; return true;
    }
};
struct SchedSimple {
    TileOrder T; int G, c, nt;
    __device__ void init(int M, int N, int K, int G_, int c_) { T.init(M, N); G = G_; c = c_; nt = K / BK; }
    __device__ bool next(int i, Unit& u) const { if (!T.tile((long)i * G + c, u.pm, u.pn)) return false; u.koff = 0; u.nt = nt; u.aux = 0; return true; }
};
struct SchedG1 {
    SchedSimple S0; int x, j; bool bal;
    __device__ void init(int M, int N, int K, int G_, int c_) { S0.init(M, N, K, G_, c_); bal = (G_ == 256 && M == 32 * BM && N == 45 * BM); x = c_ & 7; j = c_ >> 3; }
    __device__ bool next(int i, Unit& u) const {
        if (!bal) return S0.next(i, u);
        int o;
        if (j < 20) { if (i >= 6) return false; o = i * 20 + j; }
        else { const int jb = j - 20, no = jb < 4 ? 4 : 3;
            if (i >= 5) return false;
            o = i < no ? 120 + i * 12 + jb : 160 + (jb < 4 ? jb : 4 + (jb - 4) * 2 + (i - no)); }
        if (o < 160) { u.pn = 5 + (o >> 2); u.pm = 4 * x + (o & 3); } else { u.pn = (o - 160) >> 2; u.pm = 4 * x + ((o - 160) & 3); }
        u.koff = 0; u.nt = S0.nt; u.aux = 0; return true;
    }
};
template <class Epi, class Sched>
__device__ __forceinline__ void gemm_phase(LAS unsigned char* lds, const Gemm g, const Sched& S, const Epi& E) {
    int tid = threadIdx.x; asm volatile("" : "+v"(tid));
    const int wid = __builtin_amdgcn_readfirstlane(tid >> 6), lane = tid & 63, wr = wid >> 2, wc = wid & 3, fr = lane & 15, fq = lane >> 4;
    unsigned voffA[2], voffB[2];
#pragma unroll
    for (int i = 0; i < 2; ++i) { int R, C; stage_rc(tid * 16 + i * 8192, R, C); const int Rb = Epi::PERM ? ((R & ~31) + perm32(R & 31)) : R;
        voffA[i] = (unsigned)(R * g.lda + C) * 2u; voffB[i] = (unsigned)(Rb * g.ldb + C) * 2u; }
    const size_t kstep = (size_t)(BK * 2);
    const size_t hstepA = (size_t)HALF * g.lda * 2, hstepB = (size_t)HALF * g.ldb * 2;
    const unsigned ldsw = (unsigned)wid * 1024u;
    const int aoff = lds_byte(wr * 64 + fr, fq * 8), boff = lds_byte(wc * 32 + fr, fq * 8);
#define PG8_SA(b, h) (((b) * 2 + (h)) * HTB)
#define PG8_SB(b, h) ((4 + (b) * 2 + (h)) * HTB)
#define PG8_STAGE(bufoff, gbase, voff) do { _Pragma("unroll") for (int _i = 0; _i < 2; ++_i) \
        __builtin_amdgcn_global_load_lds((const unsigned*)((const char*)(gbase) + (voff)[_i]), (LAS unsigned*)(lds + (bufoff) + ldsw + _i * 8192), 16, 0, 0); } while (0)
#define PG8_LDA(dst, b, h) do { _Pragma("unroll") for (int m = 0; m < 4; ++m) _Pragma("unroll") for (int k = 0; k < 2; ++k) dst[m][k] = *(const LAS bf16x8*)(lds + PG8_SA(b, h) + aoff + m * 2048 + k * 1024); } while (0)
#define PG8_LDB(dst, b, h) do { _Pragma("unroll") for (int n = 0; n < 2; ++n) _Pragma("unroll") for (int k = 0; k < 2; ++k) dst[n][k] = *(const LAS bf16x8*)(lds + PG8_SB(b, h) + boff + n * 2048 + k * 1024); } while (0)
#define PG8_MMA(ai, bj, At, Bt) do { __builtin_amdgcn_s_setprio(1); _Pragma("unroll") for (int m = 0; m < 4; ++m) _Pragma("unroll") for (int n = 0; n < 2; ++n) _Pragma("unroll") for (int k = 0; k < 2; ++k) \
        acc[ai][bj][m][n] = Epi::mma(Bt[n][k], At[m][k], acc[ai][bj][m][n]); __builtin_amdgcn_s_setprio(0); } while (0)
#define PG8_WAIT_V(n) asm volatile("s_waitcnt vmcnt(" #n ")" ::: "memory")
#define PG8_WAIT_L(n) asm volatile("s_waitcnt lgkmcnt(" #n ")" ::: "memory")
#define PG8_BAR __builtin_amdgcn_s_barrier()
#define PG8_SCHED __builtin_amdgcn_sched_barrier(0)
    Unit cur, nxt; int ui = 0;
    if (!S.next(0, cur)) return;
    typedef typename Epi::acc_t acc_t;
    acc_t acc[2][2][4][2];
#pragma unroll
    for (int a = 0; a < 2; ++a)
#pragma unroll
        for (int b = 0; b < 2; ++b)
#pragma unroll
            for (int m = 0; m < 4; ++m)
#pragma unroll
                for (int n = 0; n < 2; ++n) acc[a][b][m][n] = (acc_t){0, 0, 0, 0};
    bf16x8 At[4][2], B0[2][2], B1[2][2];
    const char* cA = (const char*)g.A + ((size_t)cur.pm * BM * g.lda + cur.koff) * 2; const char* cB = (const char*)g.Bt + ((size_t)cur.pn * BM * g.ldb + cur.koff) * 2;
    PG8_STAGE(PG8_SB(0, 0), cB, voffB); PG8_STAGE(PG8_SA(0, 0), cA, voffA); PG8_STAGE(PG8_SB(0, 1), cB + hstepB, voffB); PG8_STAGE(PG8_SA(0, 1), cA + hstepA, voffA);
    if constexpr (Epi::HAS_MID) E.pre(cur);
    if (wr == 1) PG8_BAR;
    PG8_WAIT_V(4); PG8_BAR;
    PG8_STAGE(PG8_SB(1, 0), cB + kstep, voffB); PG8_STAGE(PG8_SA(1, 0), cA + kstep, voffA); PG8_STAGE(PG8_SB(1, 1), cB + hstepB + kstep, voffB);
    PG8_WAIT_V(6); PG8_BAR;
    for (;;) {
        const bool has_next = S.next(ui + 1, nxt);
        const char* nA = has_next ? (const char*)g.A + ((size_t)nxt.pm * BM * g.lda + nxt.koff) * 2 : cA; const char* nB = has_next ? (const char*)g.Bt + ((size_t)nxt.pn * BM * g.ldb + nxt.koff) * 2 : cB;
        const int nt = cur.nt;
        for (int t = 0; t < nt; t += 2) {
            if constexpr (Epi::HAS_MID) { if (E.mid_at(t)) E.mid(acc, cur, t, ui, wc, fr, fq); }
            const bool last = (t == nt - 2);
            const char* a1 = cA + (size_t)(t + 1) * kstep;
            const char* a2 = last ? nA : cA + (size_t)(t + 2) * kstep; const char* b2 = last ? nB : cB + (size_t)(t + 2) * kstep;
            const char* a3 = a2 + kstep; const char* b3 = b2 + kstep;
            PG8_LDB(B0, 0, 0); PG8_SCHED; PG8_LDA(At, 0, 0); PG8_STAGE(PG8_SA(1, 1), a1 + hstepA, voffA);
            PG8_WAIT_L(8); PG8_BAR; PG8_WAIT_L(0); PG8_MMA(0, 0, At, B0); PG8_BAR; PG8_SCHED;
            PG8_LDB(B1, 0, 1); PG8_STAGE(PG8_SB(0, 0), b2, voffB);
            PG8_BAR; PG8_WAIT_L(0); PG8_MMA(0, 1, At, B1); PG8_BAR;
            PG8_LDA(At, 0, 1); PG8_STAGE(PG8_SA(0, 0), a2, voffA);
            PG8_BAR; PG8_WAIT_L(0); PG8_MMA(1, 0, At, B0); PG8_BAR; PG8_SCHED;
            PG8_STAGE(PG8_SB(0, 1), b2 + hstepB, voffB);
            PG8_WAIT_V(6); PG8_BAR; PG8_MMA(1, 1, At, B1); PG8_BAR;
            PG8_LDB(B0, 1, 0); PG8_SCHED; PG8_LDA(At, 1, 0); PG8_STAGE(PG8_SA(0, 1), a2 + hstepA, voffA);
            PG8_WAIT_L(8); PG8_BAR; PG8_WAIT_L(0); PG8_MMA(0, 0, At, B0); PG8_BAR; PG8_SCHED;
            PG8_LDB(B1, 1, 1); PG8_STAGE(PG8_SB(1, 0), b3, voffB);
            PG8_BAR; PG8_WAIT_L(0); PG8_MMA(0, 1, At, B1); PG8_BAR;
            PG8_LDA(At, 1, 1); PG8_STAGE(PG8_SA(1, 0), a3, voffA);
            PG8_BAR; PG8_WAIT_L(0); PG8_MMA(1, 0, At, B0); PG8_BAR; PG8_SCHED;
            PG8_STAGE(PG8_SB(1, 1), b3 + hstepB, voffB);
            PG8_WAIT_V(6); PG8_BAR; PG8_MMA(1, 1, At, B1); PG8_BAR;
        }
        if constexpr (Epi::AFTER_DRAIN) { if (has_next) E(acc, cur, wr, wc, fr, fq); } else E(acc, cur, wr, wc, fr, fq);
        if (!has_next) break;
#pragma unroll
        for (int a = 0; a < 2; ++a)
#pragma unroll
            for (int b = 0; b < 2; ++b)
#pragma unroll
                for (int m = 0; m < 4; ++m)
#pragma unroll
                    for (int n = 0; n < 2; ++n) acc[a][b][m][n] = (acc_t){0, 0, 0, 0};
        cur = nxt; cA = nA; cB = nB; ++ui;
    }
    PG8_WAIT_V(0);
    if (wr == 0) PG8_BAR;
    PG8_BAR;
    if constexpr (Epi::AFTER_DRAIN) E.fused(acc, cur, wr, wc, fr, fq);
#undef PG8_SA
#undef PG8_SB
#undef PG8_STAGE
#undef PG8_LDA
#undef PG8_LDB
#undef PG8_MMA
#undef PG8_WAIT_V
#undef PG8_WAIT_L
#undef PG8_BAR
#undef PG8_SCHED
}

struct EpiG1 {
    static constexpr bool PERM = true; static constexpr bool HAS_MID = false; static constexpr bool AFTER_DRAIN = false;
    typedef f32x4 acc_t;
    static __device__ __forceinline__ f32x4 mma(bf16x8 b, bf16x8 a, f32x4 c) {
        const i32x4 bb = __builtin_bit_cast(i32x4, b), aa = __builtin_bit_cast(i32x4, a);
        const i32x8 B8 = {bb[0], bb[1], bb[2], bb[3], 0, 0, 0, 0}, A8 = {aa[0], aa[1], aa[2], aa[3], 0, 0, 0, 0};
        return __builtin_amdgcn_mfma_scale_f32_16x16x128_f8f6f4(B8, A8, c, 4, 4, 0, 0x7F7F7F7F, 0, 0x7F7F7F7F);
    }
    float* qkraw; bf16_t* qkvb; unsigned char* gates; const float* sh; const float* sw;
    __device__ __forceinline__ void operator()(const f32x4 (&acc)[2][2][4][2], const Unit& u, int wr, int wc, int fr, int fq) const {
        const int row0 = u.pm * BM + wr * 64 + fr, colt = wc * 32 + 8 * fq, pn = u.pn;
        f32x4 cw[2][2];
#pragma unroll
        for (int bj = 0; bj < 2; ++bj) { cw[bj][0] = *(const f32x4*)(sw + pn * BM + bj * HALF + colt); cw[bj][1] = *(const f32x4*)(sw + pn * BM + bj * HALF + colt + 4); }
        f32x4 cwl[2][2];
#pragma unroll
        for (int bj = 0; bj < 2; ++bj) { cwl[bj][0] = cw[bj][0] * -LOG2E; cwl[bj][1] = cw[bj][1] * -LOG2E; }
#pragma unroll
        for (int ai = 0; ai < 2; ++ai)
#pragma unroll
            for (int m = 0; m < 4; ++m) {
                const size_t row = (size_t)(row0 + ai * HALF + m * 16);
                const float rs = sh[row];
                if (pn >= 21) {
                    unsigned w[4];
#pragma unroll
                    for (int bj = 0; bj < 2; ++bj) { const f32x4 v0 = acc[ai][bj][m][0] * cwl[bj][0] * rs, v1 = acc[ai][bj][m][1] * cwl[bj][1] * rs; float sg[8];
#pragma unroll
                        for (int j = 0; j < 4; ++j) { sg[j] = __builtin_rintf(__builtin_amdgcn_rcpf(fmaf(__builtin_amdgcn_exp2f(v0[j]), 1.0f / 255.0f, 1.0f / 255.0f))); sg[4 + j] = __builtin_rintf(__builtin_amdgcn_rcpf(fmaf(__builtin_amdgcn_exp2f(v1[j]), 1.0f / 255.0f, 1.0f / 255.0f))); }
                        w[2 * bj] = pack4_raw(sg[0], sg[1], sg[2], sg[3]); w[2 * bj + 1] = pack4_raw(sg[4], sg[5], sg[6], sg[7]); }
                    *(u32x4*)(gates + row * GLW + (pn - 21) * BM + (wc * 4 + fq) * 16) = (u32x4){w[0], w[1], w[2], w[3]};
                } else {
#pragma unroll
                for (int bj = 0; bj < 2; ++bj) {
                    const f32x4 v0 = acc[ai][bj][m][0] * cw[bj][0] * rs, v1 = acc[ai][bj][m][1] * cw[bj][1] * rs;
                    const int col = pn * BM + bj * HALF + colt;
                    if (pn < 5) { float* p = qkraw + row * QKRAWW + col; *(f32x4*)p = v0; *(f32x4*)(p + 4) = v1; }
                    else { u32x4 w; w.x = cvtpk(v0[0], v0[1]); w.y = cvtpk(v0[2], v0[3]); w.z = cvtpk(v1[0], v1[1]); w.w = cvtpk(v1[2], v1[3]); *(u32x4*)(qkvb + row * QKVW + col) = w; }
                }
                }
            }
    }
};
struct EpiG2 {
    static constexpr bool PERM = true; static constexpr bool HAS_MID = true; static constexpr bool AFTER_DRAIN = false;
    typedef f32x4 acc_t;
    static __device__ __forceinline__ f32x4 mma(bf16x8 b, bf16x8 a, f32x4 c) { return __builtin_amdgcn_mfma_f32_16x16x32_bf16(b, a, c, 0, 0, 0); }
    const unsigned char* gates; bf16_t* merged; const float* lse; float* wtab;
    static __device__ __forceinline__ float gb(unsigned w, int k) { return fmaxf((float)((w >> (8 * k)) & 0xffu), 0.25f); }
    __device__ __forceinline__ bool mid_at(int t) const { return t >= 16 && t <= 28; }
    __device__ __forceinline__ void build(const Unit& u) const {
        int tz = threadIdx.x; asm volatile("" : "+v"(tz));
        const int wid = tz >> 6, lane = tz & 63, wr = wid >> 2;
        float* tab = wtab + wid * 768;
#pragma unroll
            for (int k = 0; k < 4; ++k) { const int p = lane + 64 * k, ti = p >> 1, hg = p & 1, row = (ti >> 6) * HALF + wr * 64 + ((ti >> 4) & 3) * 16 + (ti & 15), tok = u.pm * BM + row, bb = tok / SEQ, sq = tok % SEQ;
                const float a0 = lse[(size_t)hg * NTOK + (size_t)bb * SEQ + sq], a1 = lse[(size_t)(2 + hg) * NTOK + ((size_t)(bb * 4 + (sq & 3))) * (SEQ / 4) + (sq >> 2)], a2 = lse[(size_t)(4 + hg) * NTOK + ((size_t)(bb * 16 + (sq & 15))) * (SEQ / 16) + (sq >> 4)];
                const float mx = fmaxf(a0, fmaxf(a1, a2)); const float e0 = __builtin_amdgcn_exp2f((a0 - mx) * LOG2E), e1 = __builtin_amdgcn_exp2f((a1 - mx) * LOG2E), e2 = __builtin_amdgcn_exp2f((a2 - mx) * LOG2E);
                const float inv = 1.0f / (e0 + e1 + e2); tab[ti * 6 + hg] = fmaxf(e0 * inv, 1e-30f); tab[ti * 6 + 2 + hg] = fmaxf(e1 * inv, 1e-30f); tab[ti * 6 + 4 + hg] = fmaxf(e2 * inv, 1e-30f); }
            asm volatile("s_waitcnt lgkmcnt(0)" ::: "memory");
    }
    __device__ __forceinline__ void pre(const Unit& u) const { build(u); }
    __device__ __forceinline__ void mid(f32x4 (&acc)[2][2][4][2], const Unit& u, int t, int ui, int, int, int) const {
        int tz = threadIdx.x; asm volatile("" : "+v"(tz));
        const int wid = tz >> 6, lane = tz & 63, wr = wid >> 2, wc = wid & 3, fr = lane & 15, fq = lane >> 4;
        float* tab = wtab + wid * 768;
        if (t == 16 && ui != 0) build(u);
        {   const int h = (t - 16) >> 1;
#pragma unroll
            for (int ai = 0; ai < 2; ++ai)
#pragma unroll
                for (int m = 0; m < 4; ++m) { const float* e = tab + ((ai * 4 + m) * 16 + fr) * 6;
                    const float rf = h == 0 ? __builtin_amdgcn_rcpf(e[0]) : (h == 6 ? e[5] : e[h - 1] * __builtin_amdgcn_rcpf(e[h]));
#pragma unroll
                    for (int bj = 0; bj < 2; ++bj) { acc[ai][bj][m][0] *= rf; acc[ai][bj][m][1] *= rf; } }
            if (t != 16 && t != 28) return;
        }
        const int row0 = u.pm * BM + wr * 64 + fr, gcol = u.pn * BM + (wc * 4 + fq) * 16, br = t == 16 ? 0 : 1;
#pragma unroll
        for (int ai = 0; ai < 2; ++ai)
#pragma unroll
            for (int m = 0; m < 4; ++m) {
                const size_t row = (size_t)(row0 + ai * HALF + m * 16);
                const u32x4 gaq = *(const u32x4*)(gates + row * GLW + br * DM + gcol), gnq = *(const u32x4*)(gates + row * GLW + (br + 1) * DM + gcol);
#pragma unroll
                for (int bj = 0; bj < 2; ++bj) {
                    const unsigned gax = bj ? gaq.z : gaq.x, gay = bj ? gaq.w : gaq.y, gnx = bj ? gnq.z : gnq.x, gny = bj ? gnq.w : gnq.y;
                    const float a0 = br == 0 ? (float)(gax & 0xffu) : gb(gax, 0), a1 = br == 0 ? (float)((gax >> 8) & 0xffu) : gb(gax, 1), a2 = br == 0 ? (float)((gax >> 16) & 0xffu) : gb(gax, 2), a3 = br == 0 ? (float)(gax >> 24) : gb(gax, 3);
                    const float a4 = br == 0 ? (float)(gay & 0xffu) : gb(gay, 0), a5 = br == 0 ? (float)((gay >> 8) & 0xffu) : gb(gay, 1), a6 = br == 0 ? (float)((gay >> 16) & 0xffu) : gb(gay, 2), a7 = br == 0 ? (float)(gay >> 24) : gb(gay, 3);
                    acc[ai][bj][m][0] *= (f32x4){a0 * __builtin_amdgcn_rcpf(gb(gnx, 0)), a1 * __builtin_amdgcn_rcpf(gb(gnx, 1)), a2 * __builtin_amdgcn_rcpf(gb(gnx, 2)), a3 * __builtin_amdgcn_rcpf(gb(gnx, 3))};
                    acc[ai][bj][m][1] *= (f32x4){a4 * __builtin_amdgcn_rcpf(gb(gny, 0)), a5 * __builtin_amdgcn_rcpf(gb(gny, 1)), a6 * __builtin_amdgcn_rcpf(gb(gny, 2)), a7 * __builtin_amdgcn_rcpf(gb(gny, 3))};
                }
            }
    }
    __device__ __forceinline__ void operator()(const f32x4 (&acc)[2][2][4][2], const Unit& u, int wr, int wc, int fr, int fq) const {
        const int row0 = u.pm * BM + wr * 64 + fr, colt = u.pn * BM + wc * 32 + 8 * fq, gcol = u.pn * BM + (wc * 4 + fq) * 16;
        constexpr float K = 1.0f / 255.0f;
#pragma unroll
        for (int ai = 0; ai < 2; ++ai)
#pragma unroll
            for (int m = 0; m < 4; ++m) {
                const size_t row = (size_t)(row0 + ai * HALF + m * 16);
                const u32x4 gq = *(const u32x4*)(gates + row * GLW + 2 * DM + gcol);
#pragma unroll
                for (int bj = 0; bj < 2; ++bj) {
                    const int col = colt + bj * HALF;
                    const unsigned gx = bj ? gq.z : gq.x, gy = bj ? gq.w : gq.y;
                    const f32x4 v0 = acc[ai][bj][m][0], v1 = acc[ai][bj][m][1];
                    const float r[8] = {gb(gx, 0) * K * v0[0], gb(gx, 1) * K * v0[1], gb(gx, 2) * K * v0[2], gb(gx, 3) * K * v0[3], gb(gy, 0) * K * v1[0], gb(gy, 1) * K * v1[1], gb(gy, 2) * K * v1[2], gb(gy, 3) * K * v1[3]};
                    *(u32x4*)(merged + row * DM + col) = pack8(r);
                }
            }
    }
};
struct EpiG3 {
    static constexpr bool PERM = true; static constexpr bool HAS_MID = false; static constexpr bool AFTER_DRAIN = false;
    typedef f32x4 acc_t;
    static __device__ __forceinline__ f32x4 mma(bf16x8 b, bf16x8 a, f32x4 c) { return __builtin_amdgcn_mfma_f32_16x16x32_bf16(b, a, c, 0, 0, 0); }
    const float* ga  ; bf16_t* y;
    __device__ __forceinline__ void operator()(const f32x4 (&acc)[2][2][4][2], const Unit& u, int wr, int wc, int fr, int fq) const {
        const int row0 = u.pm * BM + wr * 64 + fr, colt = u.pn * BM + wc * 32 + 8 * fq;
        const float* gab = ga + (size_t)((u.pm * BM) / SEQ) * MODW;
        f32x4 gv[2][2];
#pragma unroll
        for (int bj = 0; bj < 2; ++bj) { gv[bj][0] = *(const f32x4*)(gab + colt + bj * HALF) + 1.0f; gv[bj][1] = *(const f32x4*)(gab + colt + bj * HALF + 4) + 1.0f; }
#pragma unroll
        for (int ai = 0; ai < 2; ++ai)
#pragma unroll
            for (int m = 0; m < 4; ++m) { const size_t ro = (size_t)(row0 + ai * HALF + m * 16) * DM + colt;
#pragma unroll
                for (int bj = 0; bj < 2; ++bj) { const f32x4 v0 = gv[bj][0] * acc[ai][bj][m][0], v1 = gv[bj][1] * acc[ai][bj][m][1];
                    u32x4 w; w.x = cvtpk(v0[0], v0[1]); w.y = cvtpk(v0[2], v0[3]); w.z = cvtpk(v1[0], v1[1]); w.w = cvtpk(v1[2], v1[3]);
                    *(u32x4*)(y + ro + bj * HALF) = w; } }
    }
};
struct EpiSC8 {
    static constexpr bool PERM = false; static constexpr bool HAS_MID = false; static constexpr bool AFTER_DRAIN = true;
    typedef i32x4 acc_t;
    static __device__ __forceinline__ i32x4 mma(bf16x8 b, bf16x8 a, i32x4 c) { return __builtin_amdgcn_mfma_i32_16x16x64_i8(__builtin_bit_cast(i32x4, b), __builtin_bit_cast(i32x4, a), c, 0, 0, 0); }
    float* C; const float* sh; const float* sw; const Frame* F; float* tile;
    __device__ __forceinline__ void fused(const i32x4 (&acc)[2][2][4][2], const Unit& u, int wr, int wc, int fr, int fq) const {
        const int col0 = wc * 32 + 4 * fq;
        f32x4 cw[2][2];
#pragma unroll
        for (int bj = 0; bj < 2; ++bj)
#pragma unroll
            for (int n = 0; n < 2; ++n) cw[bj][n] = *(const f32x4*)(sw + u.pn * BM + col0 + bj * HALF + n * 16);
#pragma unroll
        for (int ai = 0; ai < 2; ++ai) {
#pragma unroll
            for (int m = 0; m < 4; ++m) { const int lr = wr * 64 + m * 16 + fr; const float rs = sh[u.pm * BM + ai * HALF + lr];
#pragma unroll
                for (int bj = 0; bj < 2; ++bj)
#pragma unroll
                    for (int n = 0; n < 2; ++n) { const i32x4 a = acc[ai][bj][m][n]; *(f32x4*)(tile + lr * 260 + col0 + bj * HALF + n * 16) = (f32x4){(float)a[0], (float)a[1], (float)a[2], (float)a[3]} * cw[bj][n] * rs; } }
            __syncthreads();
            { int tz = threadIdx.x; asm volatile("" : "+v"(tz)); const int w = __builtin_amdgcn_readfirstlane(tz >> 6);
              topk_rows(*F, tile + (size_t)(w * 16) * 260, 260, u.pm * BM + ai * HALF + w * 16, u.pn, 4); }
            __syncthreads();
        }
    }
    __device__ __forceinline__ void operator()(const i32x4 (&acc)[2][2][4][2], const Unit& u, int wr, int wc, int fr, int fq) const {
        const int row0 = u.pm * BM + wr * 64 + fr, col0 = u.pn * BM + wc * 32 + 4 * fq;
        f32x4 cw[2][2];
#pragma unroll
        for (int bj = 0; bj < 2; ++bj)
#pragma unroll
            for (int n = 0; n < 2; ++n) cw[bj][n] = *(const f32x4*)(sw + col0 + bj * HALF + n * 16);
#pragma unroll
        for (int ai = 0; ai < 2; ++ai)
#pragma unroll
            for (int m = 0; m < 4; ++m) { const int row = row0 + ai * HALF + m * 16; const float rs = sh[row]; float* rowp = C + (size_t)row * DM + col0;
#pragma unroll
                for (int bj = 0; bj < 2; ++bj)
#pragma unroll
                    for (int n = 0; n < 2; ++n) { const i32x4 a = acc[ai][bj][m][n]; *(f32x4*)(rowp + bj * HALF + n * 16) = (f32x4){(float)a[0], (float)a[1], (float)a[2], (float)a[3]} * cw[bj][n] * rs; } }
    }
};
}

namespace att {
constexpr int D = 128, NW = 8, QBLK = 32, KVBLK = 64;
constexpr float SCALE = 0.088388347648318440f;
constexpr float THR = 8.f;
constexpr int SHM_V = KVBLK * D * 2, SHM_K = KVBLK * D * 2, SHM_ATTN = 2 * SHM_V + 2 * SHM_K + NW * 64 * 4;
struct Args {
    const bf16_t* Q; const bf16_t* K; const bf16_t* V; bf16_t* O; float* lse;
    int ldq, ldk, ldo, ldl;
    int kt0, NT;
    int q0, W;
    float slope_l2, m_init, l_init;
};
#define KSWZ(row, colB) ((row) * 256 + ((colB) ^ (((row) & 7) << 4)))
#define SBAR() __builtin_amdgcn_sched_barrier(0)
__device__ __forceinline__ int crow(int r, int hi) { return (r & 3) + 8 * (r >> 2) + 4 * hi; }
template <bool FIRST>
__device__ __forceinline__ void partialSM_dense(f32x16& p0, f32x16& p1, f32x16& negm, float& alpha) {
    float pmax = p0[0];
#pragma unroll
    for (int r = 1; r < 16; ++r) pmax = fmaxf(pmax, p0[r]);
#pragma unroll
    for (int r = 0; r < 16; ++r) pmax = fmaxf(pmax, p1[r]);
    { auto rr = __builtin_amdgcn_permlane32_swap(__float_as_uint(pmax), __float_as_uint(pmax), false, false); pmax = fmaxf(__uint_as_float(rr[0]), __uint_as_float(rr[1])); }
    if (!FIRST && __builtin_expect(__all(pmax <= THR * LOG2E), 1)) { alpha = 1.f; }
    else {
        const float d = FIRST ? pmax : fmaxf(pmax, 0.f);
        alpha = FIRST ? 1.f : __builtin_amdgcn_exp2f(-d); const float nm = negm[0] - d;
#pragma unroll
        for (int r = 0; r < 16; ++r) { p0[r] -= d; p1[r] -= d; negm[r] = nm; }
        asm volatile("" : "+v"(negm));
    }
#pragma unroll
    for (int r = 0; r < 16; ++r) p0[r] = __builtin_amdgcn_exp2f(p0[r]);
}
__device__ __forceinline__ void partialSM_band(f32x16& p0, f32x16& p1, float& m_reg, float& mn, float& alpha, float qrel, int hi, float slope_l2, float Wf) {
    constexpr float C = SCALE * LOG2E;
    const float ninf = -__builtin_inff();
    float pmax = ninf; const float h4 = (float)(4 * hi);
#pragma unroll
    for (int r = 0; r < 16; ++r) { const float kl = (float)((r & 3) + 8 * (r >> 2)) + h4; const float d0 = fabsf(qrel - kl), d1 = fabsf(qrel - (kl + 32.f));
        float t0 = fmaf(p0[r], C, -slope_l2 * d0), t1 = fmaf(p1[r], C, -slope_l2 * d1);
        t0 = d0 <= Wf ? t0 : ninf; t1 = d1 <= Wf ? t1 : ninf; p0[r] = t0; p1[r] = t1; pmax = fmaxf(pmax, fmaxf(t0, t1)); }
    { auto rr = __builtin_amdgcn_permlane32_swap(__float_as_uint(pmax), __float_as_uint(pmax), false, false); pmax = fmaxf(__uint_as_float(rr[0]), __uint_as_float(rr[1])); }
    if (__all(pmax - m_reg <= THR * LOG2E)) { mn = m_reg; alpha = 1.f; }
    else { mn = fmaxf(m_reg, pmax); alpha = __builtin_amdgcn_exp2f(m_reg - mn); m_reg = mn; }
#pragma unroll
    for (int r = 0; r < 16; ++r) p1[r] = p1[r] - mn;
#pragma unroll
    for (int r = 0; r < 16; ++r) p0[r] = __builtin_amdgcn_exp2f(p0[r] - mn);
}
__device__ __forceinline__ void finishSM(f32x16& p0, f32x16& p1, float alpha, float& l_reg, bf16x8& pa0, bf16x8& pa1, bf16x8& pa2, bf16x8& pa3) {
#pragma unroll
    for (int r = 0; r < 16; ++r) p1[r] = __builtin_amdgcn_exp2f(p1[r]);
    float ps = 0;
#pragma unroll
    for (int r = 0; r < 16; ++r) ps += p0[r];
#pragma unroll
    for (int r = 0; r < 16; ++r) ps += p1[r];
    { auto rr = __builtin_amdgcn_permlane32_swap(__float_as_uint(ps), __float_as_uint(ps), false, false); ps = __uint_as_float(rr[0]) + __uint_as_float(rr[1]); }
    l_reg = l_reg * alpha + ps;
#define PK4(P, BASE, OUT) do { unsigned a0 = cvtpk(P[BASE + 0], P[BASE + 1]), a1 = cvtpk(P[BASE + 2], P[BASE + 3]);   \
    unsigned b0 = cvtpk(P[BASE + 4], P[BASE + 5]), b1 = cvtpk(P[BASE + 6], P[BASE + 7]);                              \
    auto r0 = __builtin_amdgcn_permlane32_swap(a0, b0, false, false); auto r1 = __builtin_amdgcn_permlane32_swap(a1, b1, false, false); \
    u32x4 w = {r0[0], r1[0], r0[1], r1[1]}; OUT = *reinterpret_cast<bf16x8*>(&w); } while (0)
    PK4(p0, 0, pa0); PK4(p0, 8, pa1); PK4(p1, 0, pa2); PK4(p1, 8, pa3);
#undef PK4
}
__device__ __forceinline__ void qkt(f32x16& p0, f32x16& p1, const char* Ks, const bf16x8* qr, int r32, int hi) {
    p0 = f32x16{}; p1 = f32x16{};
#pragma unroll
    for (int d0 = 0; d0 < 8; ++d0) { const int cb = (d0 * 16 + hi * 8) * 2;
        const bf16x8 b0 = *reinterpret_cast<const bf16x8*>(Ks + KSWZ(r32, cb));
        const bf16x8 b1 = *reinterpret_cast<const bf16x8*>(Ks + KSWZ(32 + r32, cb));
        p0 = __builtin_amdgcn_mfma_f32_32x32x16_bf16(b0, qr[d0], p0, 0, 0, 0);
        p1 = __builtin_amdgcn_mfma_f32_32x32x16_bf16(b1, qr[d0], p1, 0, 0, 0); }
}
__device__ __forceinline__ void qkt_c(f32x16& p0, f32x16& p1, const char* Ks, const bf16x8* qr, const f32x16& c, int r32, int hi) {
#pragma unroll
    for (int d0 = 0; d0 < 8; ++d0) { const int cb = (d0 * 16 + hi * 8) * 2;
        const bf16x8 b0 = *reinterpret_cast<const bf16x8*>(Ks + KSWZ(r32, cb));
        const bf16x8 b1 = *reinterpret_cast<const bf16x8*>(Ks + KSWZ(32 + r32, cb));
        if (d0 == 0) { p0 = __builtin_amdgcn_mfma_f32_32x32x16_bf16(b0, qr[0], c, 0, 0, 0); p1 = __builtin_amdgcn_mfma_f32_32x32x16_bf16(b1, qr[0], c, 0, 0, 0); }
        else { p0 = __builtin_amdgcn_mfma_f32_32x32x16_bf16(b0, qr[d0], p0, 0, 0, 0); p1 = __builtin_amdgcn_mfma_f32_32x32x16_bf16(b1, qr[d0], p1, 0, 0, 0); } }
}
__device__ __forceinline__ int v_st(int k, int c) { const int kk = (k & ~0xC) | ((k & 4) << 1) | ((k & 8) >> 1); return ((kk >> 3) * 4 + (c >> 5)) * 512 + ((kk & 7) * 32 + (c & 31)) * 2; }
__device__ __forceinline__ int v_rd_base(int lane) { return ((lane & 3) << 3) | (((lane >> 2) & 3) << 6) | (((lane >> 4) & 1) << 5) | (((lane >> 5) & 1) << 8); }
constexpr int v_rd_off(int d0, int ks, int half) { return d0 * 512 + ks * 4096 + half * 2048; }
template <int OFF> __device__ __forceinline__ s16x4 tr_read(int vb) { s16x4 r; asm volatile("ds_read_b64_tr_b16 %0, %1 offset:%2" : "=&v"(r) : "v"(vb), "i"(OFF) : "memory"); return r; }
template <int D0> __device__ __forceinline__ void pv_one(f32x16& od, int vb, bf16x8 pa0, bf16x8 pa1, bf16x8 pa2, bf16x8 pa3) {
    const s16x4 l0 = tr_read<v_rd_off(D0, 0, 0)>(vb), h0 = tr_read<v_rd_off(D0, 0, 1)>(vb), l1 = tr_read<v_rd_off(D0, 1, 0)>(vb), h1 = tr_read<v_rd_off(D0, 1, 1)>(vb);
    const s16x4 l2 = tr_read<v_rd_off(D0, 2, 0)>(vb), h2 = tr_read<v_rd_off(D0, 2, 1)>(vb), l3 = tr_read<v_rd_off(D0, 3, 0)>(vb), h3 = tr_read<v_rd_off(D0, 3, 1)>(vb);
    asm volatile("s_waitcnt lgkmcnt(0)" ::: "memory"); SBAR();
#define PK(L, H) (bf16x8){L[0], L[1], L[2], L[3], H[0], H[1], H[2], H[3]}
    od = __builtin_amdgcn_mfma_f32_32x32x16_bf16(pa0, PK(l0, h0), od, 0, 0, 0);
    od = __builtin_amdgcn_mfma_f32_32x32x16_bf16(pa1, PK(l1, h1), od, 0, 0, 0);
    od = __builtin_amdgcn_mfma_f32_32x32x16_bf16(pa2, PK(l2, h2), od, 0, 0, 0);
    od = __builtin_amdgcn_mfma_f32_32x32x16_bf16(pa3, PK(l3, h3), od, 0, 0, 0);
#undef PK
}
__device__ __forceinline__ void pv_d0(f32x16* o, int vb, bf16x8 pa0, bf16x8 pa1, bf16x8 pa2, bf16x8 pa3) {
    pv_one<0>(o[0], vb, pa0, pa1, pa2, pa3); pv_one<1>(o[1], vb, pa0, pa1, pa2, pa3); pv_one<2>(o[2], vb, pa0, pa1, pa2, pa3); pv_one<3>(o[3], vb, pa0, pa1, pa2, pa3);
}
__device__ __forceinline__ void store_o(const f32x16 (&o)[4], float l_reg, char* lds, bf16_t* O, int ldo) {
    int tz = threadIdx.x; asm volatile("" : "+v"(tz));
    const int wid = tz >> 6, lane = tz & 63, r32 = lane & 31, hi = lane >> 5;
    float* li_l = (float*)(lds + 2 * SHM_V + 2 * SHM_K) + wid * 64;
    if (hi == 0) li_l[r32] = l_reg; asm volatile("s_waitcnt lgkmcnt(0)" ::: "memory");
    float rli[16];
#pragma unroll
    for (int r = 0; r < 16; ++r) rli[r] = __builtin_amdgcn_rcpf(li_l[crow(r, hi)]);
    __syncthreads();
    char* ow = lds + wid * 8192;
#pragma unroll
    for (int r = 0; r < 16; ++r) { const int orow = crow(r, hi);
#pragma unroll
        for (int d0 = 0; d0 < 4; ++d0) *(bf16_t*)(ow + orow * 256 + (d0 * 32 + r32) * 2) = (bf16_t)(cvtpk(o[d0][r] * rli[r], 0.f) & 0xffffu); }
    asm volatile("s_waitcnt lgkmcnt(0)" ::: "memory");
    bf16_t* Ow = O + (wid * QBLK) * ldo;
#pragma unroll
    for (int i = 0; i < 8; ++i) { const int p = i * 64 + lane, row = p >> 4, c16 = p & 15;
        const u32x4 v = *(const u32x4*)(ow + row * 256 + c16 * 16);
        *(u32x4*)(Ow + row * ldo + c16 * 8) = v; }
    __syncthreads();
}
#define RESC(al) do { if (__any((al) < 1.f)) { if (hi == 0) al_l[r32] = (al); asm volatile("s_waitcnt lgkmcnt(0)" ::: "memory"); \
    _Pragma("unroll") for (int d = 0; d < 4; ++d) _Pragma("unroll") for (int r = 0; r < 16; ++r) o[d][r] *= al_l[crow(r, hi)]; } } while (0)
#define SWRITE(b, S) do { *(bf16x8*)(V_lds + (b) * SHM_V + vst0) = S.vs0; *(bf16x8*)(V_lds + (b) * SHM_V + vst1) = S.vs1; const int kc = sc * 2; \
    *(bf16x8*)(K_lds + (b) * SHM_K + KSWZ(sr, kc)) = S.ks0; *(bf16x8*)(K_lds + (b) * SHM_K + KSWZ(32 + sr, kc)) = S.ks1; } while (0)
struct Slot { bf16x8 vs0, vs1, ks0, ks1; };
template <int LDQK, int LDO, int VDELTA>
__device__ __forceinline__ void attn_dense_unit(const bf16_t* Q, const bf16_t* K, bf16_t* O, int NT, char* lds) {
    int tid = threadIdx.x; asm volatile("" : "+v"(tid));
    const int wid = __builtin_amdgcn_readfirstlane(tid >> 6), lane = tid & 63, r32 = lane & 31, hi = lane >> 5;
    char* V_lds = lds; char* K_lds = lds + 2 * SHM_V;
    float* ws = (float*)(lds + 2 * SHM_V + 2 * SHM_K) + wid * 64; float* al_l = ws + 32;
    float l_reg = 0.f; f32x16 o[4] = {}; bf16x8 qr[8]; f32x16 negm = f32x16{}; asm volatile("" : "+v"(negm));
    const bf16_t* Qw = Q + (wid * QBLK + r32) * LDQK + hi * 8;
#pragma unroll
    for (int d0 = 0; d0 < 8; ++d0) qr[d0] = *reinterpret_cast<const bf16x8*>(Qw + d0 * 16);
    const int vb0 = (int)(uintptr_t)V_lds + v_rd_base(lane);
    int koff[2];
#pragma unroll
    for (int q = 0; q < 2; ++q) { const int row = 4 * (2 * wid + q) + (lane >> 4), cb = ((lane & 15) * 16) ^ ((row & 7) << 4); koff[q] = row * LDQK + (cb >> 1); }
    const int vkk = 8 * wid + ((lane & 31) >> 2), vkey = (vkk & ~0xC) | ((vkk & 4) << 1) | ((vkk & 8) >> 1);
    const int voff = vkey * LDQK + (lane >> 5) * 32 + (lane & 3) * 8 + VDELTA;
    LAS unsigned char* Kl = (LAS unsigned char*)K_lds + 2 * wid * 1024; LAS unsigned char* Vl = (LAS unsigned char*)V_lds + 2 * wid * 1024;
#define DMA_K(tile, buf) do { const bf16_t* kt_ = K + (size_t)((tile) < NT ? (tile) : NT - 1) * (KVBLK * LDQK); _Pragma("unroll") for (int q_ = 0; q_ < 2; ++q_) \
        __builtin_amdgcn_global_load_lds((const unsigned*)(kt_ + koff[q_]), (LAS unsigned*)(Kl + (buf) * SHM_K + q_ * 1024), 16, 0, 0); } while (0)
#define DMA_V(tile, buf) do { const bf16_t* vt_ = K + (size_t)((tile) < NT ? (tile) : NT - 1) * (KVBLK * LDQK) + voff; _Pragma("unroll") for (int q_ = 0; q_ < 2; ++q_) \
        __builtin_amdgcn_global_load_lds((const unsigned*)(vt_ + q_ * 64), (LAS unsigned*)(Vl + (buf) * SHM_V + q_ * 1024), 16, 0, 0); } while (0)
#define WBAR4() do { asm volatile("s_waitcnt vmcnt(4)" ::: "memory"); __builtin_amdgcn_s_barrier(); } while (0)
#define XBAR() do { asm volatile("s_waitcnt lgkmcnt(0)" ::: "memory"); __builtin_amdgcn_s_barrier(); } while (0)
    f32x16 pA0, pA1, pB0, pB1; float alA, alB; bf16x8 pa0, pa1, pa2, pa3;
    DMA_K(0, 0); DMA_V(0, 0); DMA_K(1, 1);
    WBAR4();
    qkt_c(pA0, pA1, K_lds, qr, negm, r32, hi); partialSM_dense<true>(pA0, pA1, negm, alA);
    XBAR();
    DMA_V(1, 1); DMA_K(2, 0);
    WBAR4();
#define STEP_E(t) do { SBAR(); qkt_c(pB0, pB1, K_lds + SHM_K, qr, negm, r32, hi); \
        finishSM(pA0, pA1, alA, l_reg, pa0, pa1, pa2, pa3); SBAR(); \
        pv_d0(o, vb0, pa0, pa1, pa2, pa3); partialSM_dense<false>(pB0, pB1, negm, alB); \
        XBAR(); DMA_V((t) + 2, 0); DMA_K((t) + 3, 1); RESC(alB); WBAR4(); } while (0)
#define STEP_O(t) do { SBAR(); qkt_c(pA0, pA1, K_lds, qr, negm, r32, hi); \
        finishSM(pB0, pB1, alB, l_reg, pa0, pa1, pa2, pa3); SBAR(); \
        pv_d0(o, vb0 + (int)SHM_V, pa0, pa1, pa2, pa3); partialSM_dense<false>(pA0, pA1, negm, alA); \
        XBAR(); DMA_V((t) + 2, 1); DMA_K((t) + 3, 0); RESC(alA); WBAR4(); } while (0)
    int t = 0;
    for (; t + 2 < NT; t += 2) { STEP_E(t); STEP_O(t + 1); }
    STEP_E(t);
    finishSM(pB0, pB1, alB, l_reg, pa0, pa1, pa2, pa3); SBAR();
    pv_d0(o, vb0 + (int)SHM_V, pa0, pa1, pa2, pa3);
    asm volatile("s_waitcnt vmcnt(0)" ::: "memory");
    store_o(o, l_reg, lds, O, LDO);
#undef DMA_K
#undef DMA_V
#undef WBAR4
#undef XBAR
#undef STEP_E
#undef STEP_O
}
__device__ __forceinline__ void attn_band_unit(const Args& a, char* lds) {
    int tid = threadIdx.x; asm volatile("" : "+v"(tid));
    const int wid = tid >> 6, lane = tid & 63, r32 = lane & 31, hi = lane >> 5;
    char* V_lds = lds; char* K_lds = lds + 2 * SHM_V;
    float* ws = (float*)(lds + 2 * SHM_V + 2 * SHM_K) + wid * 64; float* li_l = ws; float* al_l = ws + 32;
    float m_reg = a.m_init, l_reg = a.l_init; f32x16 o[4] = {}; bf16x8 qr[8];
    const bf16_t* Qw = a.Q + (wid * QBLK + r32) * a.ldq + hi * 8;
#pragma unroll
    for (int d0 = 0; d0 < 8; ++d0) qr[d0] = *reinterpret_cast<const bf16x8*>(Qw + d0 * 16);
    const int sr = tid >> 4, sc = (tid & 15) * 8, vst0 = v_st(sr, sc), vst1 = v_st(32 + sr, sc);
    const int vb0 = (int)(uintptr_t)V_lds + v_rd_base(lane);
    const char* Kh = (const char*)(a.K + (long)a.kt0 * KVBLK * a.ldk); const char* Vh = (const char*)(a.V + (long)a.kt0 * KVBLK * a.ldk);
    const unsigned so0 = (unsigned)(sr * a.ldk + sc) * 2u, so1 = so0 + (unsigned)(32 * a.ldk) * 2u; const long tstep = (long)KVBLK * a.ldk * 2;
    const float qrel0 = (float)(a.q0 + wid * QBLK + r32 - a.kt0 * KVBLK), Wf = (float)a.W, slope = a.slope_l2;
    Slot st; const int NT = a.NT;
#define SLOAD1(tile) do { const char* vt_ = Vh + (long)(tile) * tstep; const char* kt_ = Kh + (long)(tile) * tstep; \
    st.vs0 = *reinterpret_cast<const bf16x8*>(vt_ + so0); st.vs1 = *reinterpret_cast<const bf16x8*>(vt_ + so1); \
    st.ks0 = *reinterpret_cast<const bf16x8*>(kt_ + so0); st.ks1 = *reinterpret_cast<const bf16x8*>(kt_ + so1); } while (0)
    SLOAD1(0); asm volatile("s_waitcnt vmcnt(0)" ::: "memory"); SWRITE(0, st); __syncthreads();
    for (int j = 0; j < NT; ++j) {
        const int bsel = j & 1;
        if (j + 1 < NT) SLOAD1(j + 1);
        const int kb = (a.kt0 + j) * KVBLK, qlo = a.q0 + __builtin_amdgcn_readfirstlane(wid) * QBLK;
        if (kb <= qlo + QBLK - 1 + a.W && kb + KVBLK - 1 >= qlo - a.W) {
        f32x16 p0, p1; float mn, al; bf16x8 pa0, pa1, pa2, pa3;
        qkt(p0, p1, K_lds + bsel * SHM_K, qr, r32, hi);
        partialSM_band(p0, p1, m_reg, mn, al, qrel0 - (float)(j * KVBLK), hi, slope, Wf);
        RESC(al);
        finishSM(p0, p1, al, l_reg, pa0, pa1, pa2, pa3); SBAR();
        pv_d0(o, vb0 + bsel * (int)SHM_V, pa0, pa1, pa2, pa3);
        }
        if (j + 1 < NT) { asm volatile("s_waitcnt vmcnt(0)" ::: "memory"); if (bsel) { SWRITE(0, st); } else { SWRITE(1, st); } }
        __syncthreads();
    }
    if (a.lse != nullptr && hi == 0) a.lse[(wid * QBLK + r32) * a.ldl] = (m_reg + __builtin_amdgcn_logf(l_reg)) * LN2;
    store_o(o, l_reg, lds, a.O, a.ldo);
#undef SLOAD1
}
#undef RESC
#undef SWRITE
}

struct Args {
    const float* in[20]; float* out; unsigned char* ws; int ph_lo, ph_hi, use_bar, pad;
};
enum { IN_X = 0, IN_C, IN_WMOD, IN_BMOD, IN_WIN, IN_AQG, IN_AKG, IN_CSINK, IN_WPA, IN_WPB, IN_WPC, IN_WO, IN_LN1G, IN_LN1B, IN_PWQ, IN_PKEYS, IN_PU, IN_PV, IN_LN2G, IN_LN2B };
constexpr int LDS_RING = 0, LDS_WTAB = 128 * 1024  , LDS_MISC = 152 * 1024, LDS_BYTES = 153 * 1024;

struct Frame {
    const Args* a; unsigned char* ws; char* lds; int tid, wid, lane, G, bid;
    __device__ __forceinline__ unsigned char* wl(int l, size_t off) const { return ws + WS_W0 + (size_t)l * WL_BYTES + off; }
};

__device__ __forceinline__ void tconv_tile(const float* src, int N, bf16_t* dst, int ldd, int k0, int n0, float* tl, int tid) {
    {   const int r = tid >> 6, c4 = (tid & 63) * 4; f32x4 v[8];
#pragma unroll
        for (int i = 0; i < 8; ++i) v[i] = *(const f32x4*)(src + (size_t)(k0 + r + 8 * i) * N + n0 + c4);
#pragma unroll
        for (int i = 0; i < 8; ++i) { float* p = tl + (r + 8 * i) * 257 + c4; p[0] = v[i][0]; p[1] = v[i][1]; p[2] = v[i][2]; p[3] = v[i][3]; } }
    __syncthreads();
    {   const int n = tid >> 1, kh = (tid & 1) * 32;
#pragma unroll
        for (int q = 0; q < 4; ++q) { float v[8];
#pragma unroll
            for (int j = 0; j < 8; ++j) v[j] = tl[(kh + q * 8 + j) * 257 + n];
            *(u32x4*)(dst + (size_t)(n0 + n) * ldd + k0 + kh + q * 8) = pack8(v); } }
    __syncthreads();
}
__device__ __forceinline__ unsigned fp4_code(float y) {
    const float a = fabsf(y);
    const unsigned c = (a >= 0.25f) + (a >= 0.75f) + (a >= 1.25f) + (a >= 1.75f) + (a >= 2.5f) + (a >= 3.5f) + (a >= 5.0f);
    return c | (y < 0.f ? 8u : 0u);
}
__device__ __forceinline__ unsigned fp4_pack8(const float* v, float inv) {
    unsigned w = 0u;
#pragma unroll
    for (int j = 0; j < 8; ++j) w |= fp4_code(v[j] * inv) << (4 * j);
    return w;
}
__device__ __forceinline__ void store_h_q8(const float (&v)[2][16], unsigned char* hrow, float* shp, int lane) {
    float am = 0.f;
#pragma unroll
    for (int hf = 0; hf < 2; ++hf)
#pragma unroll
        for (int j = 0; j < 16; ++j) am = fmaxf(am, fabsf(v[hf][j]));
    am = wave_max(am); const float sc = am > 0.f ? am * (1.0f / 6.0f) : 1.0f, inv = 1.0f / sc;
#pragma unroll
    for (int hf = 0; hf < 2; ++hf) *(u32x2*)(hrow + hf * 512 + lane * 8) = (u32x2){fp4_pack8(&v[hf][0], inv), fp4_pack8(&v[hf][8], inv)};
    if (lane == 0) *shp = sc;
}

__device__ void phase_c0(const Frame& F) {
    const Args& A = *F.a; const int tid = F.tid, G = F.G, bid = F.bid;
    float* tl = (float*)F.lds;
    if (tid < 8) {
        float* rope = (float*)(F.ws + WS_ROPE);
        for (int e = bid * 8 + tid; e < 64 * 32; e += G * 8) {
            const int pos = e >> 5, i = e & 31;
            double inv = 1.0; for (int k = 0; k < i; ++k) inv *= 0.74989420933245582730;
            const double ang = (double)pos * (double)(float)inv;
            const double kq = __builtin_rint(ang * 0.63661977236758134308);
            const double r = (ang - kq * 1.5707963267948966192) - kq * 6.123233995736766e-17;
            const double r2 = r * r;
            double s = r * (1.0 + r2 * (-1.0 / 6 + r2 * (1.0 / 120 + r2 * (-1.0 / 5040 + r2 * (1.0 / 362880 + r2 * (-1.0 / 39916800 + r2 * (1.0 / 6227020800.0)))))));
            double c = 1.0 + r2 * (-0.5 + r2 * (1.0 / 24 + r2 * (-1.0 / 720 + r2 * (1.0 / 40320 + r2 * (-1.0 / 3628800 + r2 * (1.0 / 479001600.0 + r2 * (-1.0 / 87178291200.0)))))));
            const int q = ((int)kq) & 3;
            const double cs = q == 0 ? c : (q == 1 ? -s : (q == 2 ? -c : s)), sn = q == 0 ? s : (q == 1 ? c : (q == 2 ? -s : -c));
            rope[e] = (float)cs; rope[2048 + e] = (float)sn;
        }
    }
    for (int u = bid; u < 256; u += G) {
        const int gc0 = u * 96, l = gc0 / MODW, n0 = gc0 % MODW;
        const float* wm = A.in[IN_WMOD] + (size_t)l * DM * MODW; const float* cv = A.in[IN_C];
        const int rr = tid / 24, cq = tid % 24;
        f32x4 a0 = {0.f, 0.f, 0.f, 0.f}, a1 = {0.f, 0.f, 0.f, 0.f};
        if (rr < 21) {
            for (int k = rr; k < DM; k += 14 * 21) { f32x4 w[14];
#pragma unroll
                for (int i = 0; i < 14; ++i) { const int kk = k + 21 * i < DM ? k + 21 * i : DM - 1; w[i] = __builtin_nontemporal_load((const f32x4*)(wm + (size_t)kk * MODW + n0 + cq * 4)); }
#pragma unroll
                for (int i = 0; i < 14; ++i) { const bool ok = k + 21 * i < DM; const int kk = ok ? k + 21 * i : DM - 1; const float c0 = ok ? cv[kk] : 0.f, c1 = ok ? cv[DM + kk] : 0.f; a0 += w[i] * c0; a1 += w[i] * c1; } }
        }
        float* red = tl;
        if (rr < 21) { *(f32x4*)(red + (rr * 2 + 0) * 96 + cq * 4) = a0; *(f32x4*)(red + (rr * 2 + 1) * 96 + cq * 4) = a1; }
        __syncthreads();
        if (tid < 192) { const int b = tid / 96, n = tid % 96; float s = 0.f; for (int r = 0; r < 21; ++r) s += red[(r * 2 + b) * 96 + n];
            ((float*)(F.ws + WS_MOD))[((size_t)l * NBATCH + b) * MODW + n0 + n] = s + A.in[IN_BMOD][(size_t)l * MODW + n0 + n]; }
        __syncthreads();
    }
    {
        int mine = 0; for (int u = bid; u < 43; u += G) ++mine;
        if (mine > 0) { asm volatile("s_waitcnt vmcnt(0)" ::: "memory"); __syncthreads();
            if (tid == 0) { __builtin_amdgcn_fence(__ATOMIC_RELEASE, "agent"); asm volatile("s_waitcnt vmcnt(0)" ::: "memory"); (void)xb_add((unsigned*)(F.ws + WS_CTL) + XB_MODCNT, (unsigned)mine); } }
    }
    for (int u0 = bid; u0 < DEPTH * 16 * 8; u0 += G) {
        const int u = G == 256 ? (((u0 & 7) | ((u0 >> 6) << 3)) << 3) | ((u0 >> 3) & 7) : u0;
        const int l = u >> 7, hp = (u >> 3) & 15, kb = u & 7, p = hp & 1;
        const float* keys = A.in[IN_PKEYS] + ((size_t)(l * 2 + p) * 128) * 128; const float* wq = A.in[IN_PWQ] + (size_t)l * DM * DM;
        unsigned char* dst = F.wl(l, WL_WQK) + (size_t)(hp * 128 + kb * 16) * DM; float* swq = (float*)F.wl(l, WL_SWQK) + hp * 128 + kb * 16;
        float* red = (float*)F.lds; unsigned char* bt = (unsigned char*)F.lds + 1024;
        const int lane = F.lane, w = F.wid, li = lane & 15, lg = lane >> 4;
        f32x4 af[8];
#pragma unroll
        for (int blk = 0; blk < 8; ++blk) af[blk] = *(const f32x4*)(keys + (size_t)(kb * 16 + li) * 128 + blk * 16 + lg * 4);
        f32x4 bv[2][8]; f32x4 acc[16];
        const float* wrow = wq + (size_t)(w * 256 + li) * DM + hp * 128 + lg * 4;
#pragma unroll
        for (int blk = 0; blk < 8; ++blk) bv[0][blk] = *(const f32x4*)(wrow + blk * 16);
#pragma unroll
        for (int db = 0; db < 16; ++db) {
            const int cur = db & 1;
            if (db + 1 < 16) {
#pragma unroll
                for (int blk = 0; blk < 8; ++blk) bv[cur ^ 1][blk] = *(const f32x4*)(wrow + (size_t)(db + 1) * 16 * DM + blk * 16); }
            f32x4 a = {0.f, 0.f, 0.f, 0.f};
#pragma unroll
            for (int blk = 0; blk < 8; ++blk)
#pragma unroll
                for (int s2 = 0; s2 < 4; ++s2) a = __builtin_amdgcn_mfma_f32_16x16x4f32(af[blk][s2], bv[cur][blk][s2], a, 0, 0, 0);
            acc[db] = a;
        }
        float am[4] = {0.f, 0.f, 0.f, 0.f};
#pragma unroll
        for (int db = 0; db < 16; ++db)
#pragma unroll
            for (int r = 0; r < 4; ++r) am[r] = fmaxf(am[r], fabsf(acc[db][r]));
#pragma unroll
        for (int r = 0; r < 4; ++r) { float x = am[r]; x = fmaxf(x, dppf<XOR1>(x)); x = fmaxf(x, dppf<XOR2>(x)); x = fmaxf(x, dppf<HMIR>(x)); x = fmaxf(x, dppf<MIR>(x)); am[r] = x; }
        if (li == 0) {
#pragma unroll
            for (int r = 0; r < 4; ++r) red[w * 16 + lg * 4 + r] = am[r]; }
        __syncthreads();
        float inv[4];
#pragma unroll
        for (int r = 0; r < 4; ++r) { float x = 0.f;
#pragma unroll
            for (int ww = 0; ww < 8; ++ww) x = fmaxf(x, red[ww * 16 + lg * 4 + r]);
            const float sc = x > 0.f ? x * (1.0f / 127.0f) : 1.0f; inv[r] = 1.0f / sc;
            if (w == 0 && li == 0) swq[lg * 4 + r] = sc; }
#pragma unroll
        for (int db = 0; db < 16; ++db)
#pragma unroll
            for (int r = 0; r < 4; ++r) bt[(lg * 4 + r) * DM + w * 256 + db * 16 + li] = (unsigned char)((int)__builtin_rintf(acc[db][r] * inv[r]) & 0xff);
        __syncthreads();
#pragma unroll
        for (int q = 0; q < 4; ++q) { const int pc = q * NTHREADS + tid, k = pc >> 7, c16 = (pc & 127) * 16;
            *(u32x4*)(dst + (size_t)k * DM + c16) = *(const u32x4*)(bt + k * DM + c16); }
        __syncthreads();
    }
    for (int it = bid; it < DEPTH * 608; it += G) {
        const int l = it / 608; int r = it % 608 + 1440;
        const float* src; int N; bf16_t* dst; int ldd, koff, nkt;
        if (r < 1568) { r -= 1440; src = A.in[IN_WPA] + (size_t)l * 1024 * DM; N = DM; dst = (bf16_t*)F.wl(l, WL_WP); ldd = AOW; koff = AO_A; nkt = 16; }
        else if (r < 1664) { r -= 1568; src = A.in[IN_WPB] + (size_t)l * 768 * DM; N = DM; dst = (bf16_t*)F.wl(l, WL_WP); ldd = AOW; koff = AO_B; nkt = 12; }
        else if (r < 1792) { r -= 1664; src = A.in[IN_WPC] + (size_t)l * 1024 * DM; N = DM; dst = (bf16_t*)F.wl(l, WL_WP); ldd = AOW; koff = AO_C; nkt = 16; }
        else { r -= 1792; src = A.in[IN_WO] + (size_t)l * DM * DM; N = DM; dst = (bf16_t*)F.wl(l, WL_WO); ldd = DM; koff = 0; nkt = 32; }
        const int kt = r % nkt, ntile = r / nkt;
        tconv_tile(src, N, dst + koff, ldd, kt * 64, ntile * 256, tl, tid);
    }
    {
        const int lane = F.lane, wbase = bid * 32 + F.wid * 4;
        auto rowof = [&](int i) { return (i >> 2) * (G * 32) + wbase + (i & 3); };
        auto ldrow = [&](f32x4 (&v)[8], int rw) {
            if (rw < 4 * NEXP) { const int which = rw / NEXP, e = rw % NEXP;
                const float* src = A.in[(which & 1) ? IN_PV : IN_PU] + ((size_t)(which >> 1) * NEXP + e) * DM;
#pragma unroll
                for (int i = 0; i < 8; ++i) v[i] = __builtin_nontemporal_load((const f32x4*)(src + i * 256 + lane * 4)); } };
        auto cvrow = [&](const f32x4 (&v)[8], int rw) {
            if (rw >= 4 * NEXP) return;
            const int which = rw / NEXP, e = rw % NEXP, l = which >> 1, tb = which & 1;
            float am = 0.f, sq = 0.f;
#pragma unroll
            for (int i = 0; i < 8; ++i)
#pragma unroll
                for (int j = 0; j < 4; ++j) { am = fmaxf(am, fabsf(v[i][j])); sq = fmaf(v[i][j], v[i][j], sq); }
            am = wave_max(am); sq = wave_sum(sq);
            const float st = fminf(am * (1.0f / 7.5f), 0.3352f * __builtin_sqrtf(sq * (1.0f / DM)));
            const float sc = st > 0.f ? st : 1.0f, inv = 1.0f / sc;
            unsigned wd[4];
#pragma unroll
            for (int d = 0; d < 4; ++d) { float bq[4];
#pragma unroll
                for (int j = 0; j < 4; ++j) { const float lo = fminf(fmaxf(__builtin_floorf(v[2 * d][j] * inv) + 8.f, 0.f), 15.f), hi = fminf(fmaxf(__builtin_floorf(v[2 * d + 1][j] * inv) + 8.f, 0.f), 15.f); bq[j] = fmaf(hi >= 8.f ? hi - 8.f : hi + 8.f, 16.f, lo); }
                wd[d] = pack4_raw(bq[0], bq[1], bq[2], bq[3]); }
            *(u32x4*)(F.wl(l, tb ? WL_VB : WL_UB) + (size_t)e * (DM / 2) + lane * 16) = (u32x4){wd[0], wd[1], wd[2], wd[3]};
            if (lane == 0) ((float*)F.wl(l, tb ? WL_SV : WL_SU))[e] = sc; };
        const int nrw = ((4 * NEXP + G * 32 - 1) / (G * 32)) * 4;
        f32x4 va[8], vb[8];
        ldrow(va, rowof(0));
        for (int i = 0; i < nrw; i += 2) {
            ldrow(vb, rowof(i + 1));
            cvrow(va, rowof(i));
            if (i + 2 < nrw) ldrow(va, rowof(i + 2));
            cvrow(vb, rowof(i + 1));
        }
    }
    for (int u = G - 1 - bid; u < DEPTH * 360; u += G) {
        const int l = u / 360, n0 = (u % 360) * 32, g = tid & 7, kb = tid >> 3;
        const float* src = A.in[IN_WIN] + ((size_t)l * DM + kb * 32) * INW + n0 + g * 4;
        f32x4 v[32];
#pragma unroll
        for (int i = 0; i < 32; ++i) v[i] = __builtin_nontemporal_load((const f32x4*)(src + (size_t)i * INW));
        f32x4 m = {0.f, 0.f, 0.f, 0.f};
#pragma unroll
        for (int i = 0; i < 32; ++i) { m[0] = fmaxf(m[0], fabsf(v[i][0])); m[1] = fmaxf(m[1], fabsf(v[i][1])); m[2] = fmaxf(m[2], fabsf(v[i][2])); m[3] = fmaxf(m[3], fabsf(v[i][3])); }
#pragma unroll
        for (int j = 0; j < 4; ++j) { float x = m[j]; x = fmaxf(x, lperm(x, F.lane ^ 8)); x = fmaxf(x, lperm(x, F.lane ^ 16)); x = fmaxf(x, lperm(x, F.lane ^ 32)); m[j] = x; }
        float* red = tl;
        if (F.lane < 8) *(f32x4*)(red + F.wid * 32 + g * 4) = m;
        __syncthreads();
#pragma unroll
        for (int ww = 0; ww < 8; ++ww) { const f32x4 o = *(const f32x4*)(red + ww * 32 + g * 4); m[0] = fmaxf(m[0], o[0]); m[1] = fmaxf(m[1], o[1]); m[2] = fmaxf(m[2], o[2]); m[3] = fmaxf(m[3], o[3]); }
        unsigned char* dst = F.wl(l, WL_WIN) + (size_t)(n0 + g * 4) * (DM / 2) + kb * 16;
#pragma unroll
        for (int j = 0; j < 4; ++j) {
            const float sc = m[j] > 0.f ? m[j] * (1.0f / 6.0f) : 1.0f, inv = 1.0f / sc; unsigned w[4];
#pragma unroll
            for (int q = 0; q < 4; ++q) { float e8[8];
#pragma unroll
                for (int jj = 0; jj < 8; ++jj) e8[jj] = v[q * 8 + jj][j];
                w[q] = fp4_pack8(e8, inv); }
            *(u32x4*)(dst + (size_t)j * (DM / 2)) = (u32x4){w[0], w[1], w[2], w[3]};
            if (kb == 0) ((float*)F.wl(l, WL_SWIN))[n0 + g * 4 + j] = sc;
        }
        __syncthreads();
    }
    if (tid == 0) { unsigned* ctl = (unsigned*)(F.ws + WS_CTL); XB_SPIN(xb_ld(&ctl[XB_MODCNT]) < 43u, ctl); __builtin_amdgcn_fence(__ATOMIC_ACQUIRE, "agent"); }
    __syncthreads();
    {
    const float* x = A.in[IN_X]; const float* mod = (const float*)(F.ws + WS_MOD);
    for (int tt = F.bid * 32 + F.wid * 4; tt < NTOK; tt += F.G * 32) for (int t = tt; t < tt + 4; ++t) {
        const int b = t / SEQ; float v[2][16];
#pragma unroll
        for (int hf = 0; hf < 2; ++hf)
#pragma unroll
            for (int q = 0; q < 2; ++q) { const int c = hf * 1024 + F.lane * 16 + q * 8; float xv[8], sh[8], sc[8]; ld8f(x + (size_t)t * DM + c, xv); ld8f(mod + (size_t)b * MODW + c, sh); ld8f(mod + (size_t)b * MODW + DM + c, sc);
#pragma unroll
                for (int j = 0; j < 8; ++j) v[hf][q * 8 + j] = fmaf(xv[j], 1.0f + sc[j], sh[j]); }
        store_h_q8(v, F.ws + WS_H + (size_t)t * (DM / 2), (float*)(F.ws + WS_SH) + t, F.lane);
    }
    }
}


__device__ __forceinline__ void norm_rope_tile(const Frame& F, int l, int pm, int pn) {
    const float* raw = (const float*)(F.ws + WS_QKRAW); bf16_t* qkvb = (bf16_t*)(F.ws + WS_QKVB); const float* rope = (const float*)(F.ws + WS_ROPE);
    const int lane = F.lane, i = lane & 31; const bool isq = pn < 4;
    const float qs = isq ? att::SCALE * LOG2E : 1.0f;
    const float g0 = F.a->in[isq ? IN_AQG : IN_AKG][l * HD + lane] * qs, g1 = F.a->in[isq ? IN_AQG : IN_AKG][l * HD + 64 + lane] * qs;
    for (int q0 = F.wid * 64; q0 < F.wid * 64 + 64; q0 += 4) {
        float x0[4], x1[4], cr[4], sr[4], cc[4], sn[4];
#pragma unroll
        for (int k = 0; k < 4; ++k) { const int q = q0 + k, t = pm * 256 + (q >> 1), hh = pn * 2 + (q & 1), s = t % SEQ, pr = s >> 6, pc = s & 63;
            const float* src = raw + (size_t)t * QKRAWW + hh * HD; x0[k] = src[lane]; x1[k] = src[64 + lane];
            cr[k] = rope[pr * 32 + i]; sr[k] = rope[2048 + pr * 32 + i]; cc[k] = rope[pc * 32 + i]; sn[k] = rope[2048 + pc * 32 + i]; }
#pragma unroll
        for (int k = 0; k < 4; ++k) { const int q = q0 + k, t = pm * 256 + (q >> 1), hh = pn * 2 + (q & 1);
            const float ss = wave_sum(x0[k] * x0[k] + x1[k] * x1[k]);
            const float rs = __builtin_amdgcn_rsqf(ss * (1.0f / HD) + QK_EPS);
            const float a0 = x0[k] * rs * g0, a1 = x1[k] * rs * g1;
            const float y0 = lperm(a0, lane ^ 32), y1 = lperm(a1, lane ^ 32);
            const float o0 = lane < 32 ? a0 * cr[k] - y0 * sr[k] : a0 * cr[k] + y0 * sr[k];
            const float o1 = lane < 32 ? a1 * cc[k] - y1 * sn[k] : a1 * cc[k] + y1 * sn[k];
            bf16_t* dst = qkvb + (size_t)t * QKVW + hh * HD;
            dst[lane] = (bf16_t)(cvtpk(o0, 0.f) & 0xffffu); dst[64 + lane] = (bf16_t)(cvtpk(o1, 0.f) & 0xffffu); }
    }
}
__device__ __forceinline__ void band_range(int q0, int W, int L, int& kt0, int& NT) {
    int lo = q0 - W; if (lo < 0) lo = 0; int hi = q0 + 256 + W; if (hi > L) hi = L;
    const int t0 = lo >> 6, t1 = (hi + 63) >> 6;
    kt0 = t0; NT = t1 - t0;
}
__device__ __forceinline__ void attn_c_args(const Frame& F, int l, int u, att::Args& a) {
    const int qb = u & 15, h = (u >> 4) & 7, b = u >> 7, kvh = h >> 2;
    bf16_t* qkvb = (bf16_t*)(F.ws + WS_QKVB); bf16_t* ao = (bf16_t*)(F.ws + WS_AO);
    const size_t t0 = (size_t)b * SEQ;
    a.Q = qkvb + (t0 + qb * 256) * QKVW + COL_QC + h * HD; a.K = qkvb + t0 * QKVW + COL_KC + kvh * HD; a.V = qkvb + t0 * QKVW + COL_VC + kvh * HD;
    a.O = ao + (t0 + qb * 256) * AOW + AO_C + h * HD; a.lse = nullptr; a.ldq = QKVW; a.ldk = QKVW; a.ldo = AOW; a.ldl = 0;
    a.q0 = qb * 256; a.W = 128; band_range(a.q0, a.W, SEQ, a.kt0, a.NT);
    a.slope_l2 = __builtin_amdgcn_exp2f(-(float)(h + 1)) * LOG2E;
    a.m_init = F.a->in[IN_CSINK][l * 8 + h] * LOG2E; a.l_init = 1.0f;
}
__device__ __forceinline__ void attn_b_args(const Frame& F, int u, att::Args& a) {
    const int g = u >> 6, v = u & 63;
    const int r = g == 0 ? 1 : (g == 1 ? 4 : 16), sub = SEQ / r;
    int b, c, hg, qb;
    if (g == 0) { qb = v & 15; hg = (v >> 4) & 1; b = v >> 5; c = 0; }
    else if (g == 1) { qb = v & 3; c = (v >> 2) & 3; hg = (v >> 4) & 1; b = v >> 5; }
    else { qb = 0; c = v & 15; hg = (v >> 4) & 1; b = v >> 5; }
    const int head = g * 2 + hg;
    bf16_t* qkvb = (bf16_t*)(F.ws + WS_QKVB); bf16_t* ao = (bf16_t*)(F.ws + WS_AO); float* lse = (float*)(F.ws + WS_LSEB);
    const size_t t0 = (size_t)b * SEQ + c;
    a.ldq = r * QKVW; a.ldk = r * QKVW; a.ldo = r * AOW; a.ldl = 1;
    a.Q = qkvb + t0 * QKVW + COL_QB + head * HD + (size_t)(qb * 256) * a.ldq; a.K = qkvb + t0 * QKVW + COL_KB + head * HD; a.V = qkvb + t0 * QKVW + COL_VB + head * HD;
    a.O = ao + t0 * AOW + AO_B + head * HD + (size_t)(qb * 256) * a.ldo; a.lse = lse + (size_t)head * NTOK + ((size_t)(b * r + c)) * sub + qb * 256;
    a.q0 = qb * 256; a.W = 64; band_range(a.q0, a.W, sub, a.kt0, a.NT);
    a.slope_l2 = __builtin_amdgcn_exp2f(-8.0f * (float)(head + 1) / 6.0f) * (float)r * LOG2E;
    a.m_init = -1e30f; a.l_init = 0.f;
}
__device__ __forceinline__ void attn_a_unit(const Frame& F, int u) {
    const int xs = u & 7, idx = u >> 3, b = xs >> 2, kvh = (xs >> 1) & 1, h = kvh * 4 + (xs & 1) * 2 + (idx >> 4), qb = idx & 15;
    bf16_t* qkvb = (bf16_t*)(F.ws + WS_QKVB); bf16_t* ao = (bf16_t*)(F.ws + WS_AO);
    const size_t t0 = (size_t)b * SEQ;
    att::attn_dense_unit<QKVW, AOW, COL_VA - COL_KA>(qkvb + (t0 + qb * 256) * QKVW + COL_QA + h * HD, qkvb + t0 * QKVW + COL_KA + kvh * HD,
                                    ao + (t0 + qb * 256) * AOW + AO_A + h * HD, SEQ / 64, F.lds);
}
__device__ void phase_att(const Frame& F, int l) {
    for (int u = F.bid; u < 256; u += F.G) attn_a_unit(F, u);
    for (int u = F.bid; u < 256 + 192; u += F.G) { att::Args a; if (u < 256) attn_c_args(F, l, u, a); else attn_b_args(F, u - 256, a); att::attn_band_unit(a, F.lds); }
}

__device__ void phase_ln1(const Frame& F, int l) {
    const bf16_t* yb = (const bf16_t*)(F.ws + WS_Z); const float* xin = l == 0 ? F.a->in[IN_X] : (const float*)(F.ws + WS_XCUR); bf16_t* x1 = (bf16_t*)(F.ws + WS_X1); unsigned char* h2 = F.ws + WS_H2; float* sh2 = (float*)(F.ws + WS_SH2);
    const float* g = F.a->in[IN_LN1G] + (size_t)l * DM; const float* bb = F.a->in[IN_LN1B] + (size_t)l * DM;
    const float* mod = (const float*)(F.ws + WS_MOD) + (size_t)l * NBATCH * MODW;
    LAS float* pl = (LAS float*)F.lds;
    for (int tt = F.bid * 32 + F.wid * 4; tt < NTOK; tt += F.G * 32) {
      {   const int bq = tt / SEQ, c = F.tid * 4;
          __syncthreads();
          *(LAS f32x4*)(pl + c) = *(const f32x4*)(g + c); *(LAS f32x4*)(pl + 2048 + c) = *(const f32x4*)(bb + c);
          *(LAS f32x4*)(pl + 4096 + c) = *(const f32x4*)(mod + (size_t)bq * MODW + 4 * DM + c) + 1.0f; *(LAS f32x4*)(pl + 6144 + c) = *(const f32x4*)(mod + (size_t)bq * MODW + 3 * DM + c);
          __syncthreads(); }
      for (int t = tt; t < tt + 4; ++t) {
        float v[4][8]; float s = 0.f;
#pragma unroll
        for (int i = 0; i < 4; ++i) { const size_t o = (size_t)t * DM + i * 512 + F.lane * 8; ld8f(xin + o, v[i]); const u32x4 yw = *(const u32x4*)(yb + o);
            const float yy[8] = {bf_lo(yw.x), bf_hi(yw.x), bf_lo(yw.y), bf_hi(yw.y), bf_lo(yw.z), bf_hi(yw.z), bf_lo(yw.w), bf_hi(yw.w)};
#pragma unroll
            for (int j = 0; j < 8; ++j) { v[i][j] = fmaf(ALPHA, v[i][j], yy[j]); s += v[i][j]; } }
        const float mean = wave_sum(s) * (1.0f / DM); float q = 0.f;
#pragma unroll
        for (int i = 0; i < 4; ++i)
#pragma unroll
            for (int j = 0; j < 8; ++j) { v[i][j] -= mean; q += v[i][j] * v[i][j]; }
        const float rstd = __builtin_amdgcn_rsqf(wave_sum(q) * (1.0f / DM) + LN_EPS);
        float hmax = 0.f;
#pragma unroll
        for (int i = 0; i < 4; ++i) { const int c = i * 512 + F.lane * 8; float gg[8], be[8], sh[8], sc[8];
            { const f32x4 a0 = *(const LAS f32x4*)(pl + c), a1 = *(const LAS f32x4*)(pl + c + 4), b0 = *(const LAS f32x4*)(pl + 2048 + c), b1 = *(const LAS f32x4*)(pl + 2048 + c + 4);
              const f32x4 c0 = *(const LAS f32x4*)(pl + 4096 + c), c1 = *(const LAS f32x4*)(pl + 4096 + c + 4), d0 = *(const LAS f32x4*)(pl + 6144 + c), d1 = *(const LAS f32x4*)(pl + 6144 + c + 4);
#pragma unroll
              for (int j = 0; j < 4; ++j) { gg[j] = a0[j]; gg[4 + j] = a1[j]; be[j] = b0[j]; be[4 + j] = b1[j]; sc[j] = c0[j]; sc[4 + j] = c1[j]; sh[j] = d0[j]; sh[4 + j] = d1[j]; } }
#pragma unroll
            for (int j = 0; j < 8; ++j) v[i][j] = fmaf(v[i][j] * rstd, gg[j], be[j]);
            *(u32x4*)(x1 + (size_t)t * DM + c) = pack8(v[i]);
#pragma unroll
            for (int j = 0; j < 8; ++j) { v[i][j] = fmaf(v[i][j], sc[j], sh[j]); hmax = fmaxf(hmax, fabsf(v[i][j])); } }
        hmax = wave_max(hmax); const float hs = hmax > 0.f ? hmax * (1.0f / 127.0f) : 1.0f, hi = 1.0f / hs;
#pragma unroll
        for (int i = 0; i < 4; ++i) *(u32x2*)(h2 + (size_t)t * DM + i * 512 + F.lane * 8) = (u32x2){pack4_u8(v[i][0] * hi, v[i][1] * hi, v[i][2] * hi, v[i][3] * hi) ^ 0x80808080u, pack4_u8(v[i][4] * hi, v[i][5] * hi, v[i][6] * hi, v[i][7] * hi) ^ 0x80808080u};
        if (F.lane == 0) sh2[t] = hs;
    }
    }
}

__device__ __forceinline__ unsigned row16_umax(unsigned x) { x = max(x, dppu<XOR1>(x)); x = max(x, dppu<XOR2>(x)); x = max(x, dppu<HMIR>(x)); x = max(x, dppu<MIR>(x)); return x; }
__device__ __forceinline__ unsigned fsort(float v) { const unsigned f = __float_as_uint(v); return (f & 0x80000000u) ? ~f : (f | 0x80000000u); }
__device__ __forceinline__ void topk_rows(const Frame& F, const float* rows, int pitch, int tok0, int h, int nit) {
    int* eidx = (int*)(F.ws + WS_EIDX); float* egate = (float*)(F.ws + WS_EGATE);
    const int lane = F.lane, row = lane >> 4, l15 = lane & 15, rbase = lane & 48;
#pragma unroll 1
    for (int it = 0; it < nit; ++it) {
        const int t0 = tok0 + it * 4;
        float sval[2]; int sidx[2];
        unsigned kk[2][8]; const float* srcp[2];
#pragma unroll
        for (int ps = 0; ps < 2; ++ps) {
            const int tok = t0 + 2 * ps + (row >> 1), p = row & 1;
            const float* src = rows + (size_t)(tok - tok0) * pitch + p * 128; srcp[ps] = src;
            const f32x4 va = *(const f32x4*)(src + l15 * 8), vb = *(const f32x4*)(src + l15 * 8 + 4);
            unsigned (&k)[8] = kk[ps];
#pragma unroll
            for (int j = 0; j < 4; ++j) { k[j] = (fsort(va[j]) & ~127u) | (unsigned)(127 - (l15 * 8 + j)); k[4 + j] = (fsort(vb[j]) & ~127u) | (unsigned)(127 - (l15 * 8 + 4 + j)); }
#define CE(i, j) do { const unsigned hi_ = max(k[i], k[j]), lo_ = min(k[i], k[j]); k[i] = hi_; k[j] = lo_; } while (0)
            CE(0, 1); CE(2, 3); CE(4, 5); CE(6, 7); CE(0, 2); CE(1, 3); CE(4, 6); CE(5, 7); CE(1, 2); CE(5, 6);
            CE(0, 4); CE(1, 5); CE(2, 6); CE(3, 7); CE(2, 4); CE(3, 5); CE(1, 2); CE(3, 4); CE(5, 6);
#undef CE
        }
        unsigned sel0 = 0u, sel1 = 0u;
#pragma unroll
        for (int r = 0; r < 16; ++r) {
            unsigned m0 = kk[0][0], m1 = kk[1][0];
            m0 = max(m0, dppu<XOR1>(m0)); m1 = max(m1, dppu<XOR1>(m1)); m0 = max(m0, dppu<XOR2>(m0)); m1 = max(m1, dppu<XOR2>(m1));
            m0 = max(m0, dppu<HMIR>(m0)); m1 = max(m1, dppu<HMIR>(m1)); m0 = max(m0, dppu<MIR>(m0)); m1 = max(m1, dppu<MIR>(m1));
            const bool w0 = kk[0][0] == m0, w1 = kk[1][0] == m1;
#pragma unroll
            for (int j = 0; j < 7; ++j) { kk[0][j] = w0 ? kk[0][j + 1] : kk[0][j]; kk[1][j] = w1 ? kk[1][j + 1] : kk[1][j]; }
            kk[0][7] = w0 ? 0u : kk[0][7]; kk[1][7] = w1 ? 0u : kk[1][7];
            sel0 = l15 == r ? m0 : sel0; sel1 = l15 == r ? m1 : sel1;
        }
        sidx[0] = 127 - (int)(sel0 & 127u); sval[0] = srcp[0][sidx[0]]; sidx[1] = 127 - (int)(sel1 & 127u); sval[1] = srcp[1][sidx[1]];
        const int srcx = ((row & 1) * 2) * 16 + l15, srcy = srcx + 16;
        const float xv0 = lperm(sval[0], srcx), xv1 = lperm(sval[1], srcx), yv0 = lperm(sval[0], srcy), yv1 = lperm(sval[1], srcy);
        const int xi0 = lperm(sidx[0], srcx), xi1 = lperm(sidx[1], srcx), yi0 = lperm(sidx[0], srcy), yi1 = lperm(sidx[1], srcy);
        const float v1 = row < 2 ? xv0 : xv1, yv = row < 2 ? yv0 : yv1; const int i1 = row < 2 ? xi0 : xi1, yi = row < 2 ? yi0 : yi1;
        const unsigned long long CI0 = 0x0c87654322110000ull, CJ0 = 0x000000004040c840ull, CCN = 0x0442223414444444ull;
        const int ci0 = (int)(CI0 >> (4 * l15)) & 15, cj0 = (int)(CJ0 >> (4 * l15)) & 15, ccn = (int)(CCN >> (4 * l15)) & 15; const bool ccol = l15 >= 13;
        unsigned kq[4];
#pragma unroll
        for (int q = 0; q < 4; ++q) { const int ii = ci0 + (ccol ? q : 0), jj = cj0 + (ccol ? 0 : q);
            const float sm = lperm(v1, rbase + ii) + lperm(yv, rbase + (jj & 15));
            kq[q] = q < ccn ? ((fsort(sm) & ~63u) | (unsigned)(l15 * 4 + q)) : 0u; }
#define CE4(i, j) do { const unsigned hi_ = max(kq[i], kq[j]), lo_ = min(kq[i], kq[j]); kq[i] = hi_; kq[j] = lo_; } while (0)
        CE4(0, 1); CE4(2, 3); CE4(0, 2); CE4(1, 3); CE4(1, 2);
#undef CE4
        unsigned rec = 0u;
#pragma unroll
        for (int r = 0; r < 16; ++r) {
            const unsigned m = row16_umax(kq[0]); const bool win = kq[0] == m;
            kq[0] = win ? kq[1] : kq[0]; kq[1] = win ? kq[2] : kq[1]; kq[2] = win ? kq[3] : kq[2]; kq[3] = win ? 0u : kq[3];
            rec = l15 == r ? m : rec;
        }
        const int wl = (int)(rec >> 2) & 15, wq = (int)rec & 3; const bool wcol = wl >= 13;
        const int wi = ((int)(CI0 >> (4 * wl)) & 15) + (wcol ? wq : 0), wj = ((int)(CJ0 >> (4 * wl)) & 15) + (wcol ? 0 : wq);
        const float rec_s = lperm(v1, rbase + wi) + lperm(yv, rbase + wj);
        const int rec_e = lperm(i1, rbase + wi) * 128 + lperm(yi, rbase + wj);
        float smax = rec_s; smax = fmaxf(smax, dppf<XOR1>(smax)); smax = fmaxf(smax, dppf<XOR2>(smax)); smax = fmaxf(smax, dppf<HMIR>(smax)); smax = fmaxf(smax, dppf<MIR>(smax));
        const float e = __builtin_amdgcn_exp2f((rec_s - smax) * LOG2E);
        const float tot = row16_sum(e);
        const size_t o = ((size_t)h * NTOK + (t0 + row)) * 16 + l15;
        eidx[o] = rec_e; egate[o] = e / tot;
    }
}

__device__ void topk_tile(const Frame& F, int pm, int h) {
    const int tok0 = pm * 256 + F.wid * 32;
    topk_rows(F, (const float*)(F.ws + WS_SC) + (size_t)tok0 * DM + h * 256, DM, tok0, h, 8);
}

__device__ void phase_pe(const Frame& F, int l) {
    const unsigned char* U4 = F.wl(l, WL_UB); const unsigned char* V4 = F.wl(l, WL_VB);
    const float* SU = (const float*)F.wl(l, WL_SU); const float* SV = (const float*)F.wl(l, WL_SV);
    const unsigned char* h2 = F.ws + WS_H2; const float* sh2 = (const float*)(F.ws + WS_SH2); const bf16_t* x1 = (const bf16_t*)(F.ws + WS_X1);
    const int* eidx = (const int*)(F.ws + WS_EIDX); const float* egate = (const float*)(F.ws + WS_EGATE);
    const float* mod = (const float*)(F.ws + WS_MOD) + (size_t)l * NBATCH * MODW;
    const float* modn = (const float*)(F.ws + WS_MOD) + (size_t)(l + 1) * NBATCH * MODW;
    const float* g = F.a->in[IN_LN2G] + (size_t)l * DM; const float* bb = F.a->in[IN_LN2B] + (size_t)l * DM;
    const bool last = (l == DEPTH - 1);
    float* xo = last ? F.a->out : (float*)(F.ws + WS_XCUR);
    const int lane = F.lane, l15 = lane & 15;
    LAS float* pl = (LAS float*)((LAS unsigned char*)F.lds + 16384);
    for (int tt = F.bid * 32 + F.wid * 4; tt < NTOK; tt += F.G * 32) {
      {   const int bq = tt / SEQ, c = F.tid * 4;
          __syncthreads();
          *(LAS f32x4*)(pl + c) = *(const f32x4*)(mod + (size_t)bq * MODW + 5 * DM + c) + 1.0f; *(LAS f32x4*)(pl + 2048 + c) = *(const f32x4*)(g + c); *(LAS f32x4*)(pl + 4096 + c) = *(const f32x4*)(bb + c);
          if (!last) { *(LAS f32x4*)(pl + 6144 + c) = *(const f32x4*)(modn + (size_t)bq * MODW + DM + c) + 1.0f; *(LAS f32x4*)(pl + 8192 + c) = *(const f32x4*)(modn + (size_t)bq * MODW + c); }
          __syncthreads(); }
      constexpr int NTK = 4;
      for (int t = tt; t < tt + 4; t += NTK) {
        __syncthreads();
        unsigned hq[NTK][8]; float sh[NTK]; int hsum[NTK];
        int e0[NTK], e1[NTK]; float g0[NTK], g1[NTK];
#pragma unroll
        for (int tk = 0; tk < NTK; ++tk) {
            sh[tk] = sh2[t + tk]; int hsE = 0, hsO = 0;
#pragma unroll
            for (int i = 0; i < 8; ++i) { hq[tk][i] = *(const unsigned*)(h2 + (size_t)(t + tk) * DM + i * 256 + lane * 4); if (i & 1) hsO = __builtin_amdgcn_sdot4((int)hq[tk][i], 0x01010101, hsO, false); else hsE = __builtin_amdgcn_sdot4((int)hq[tk][i], 0x01010101, hsE, false); }
            hsum[tk] = xrow_isum(row16_isum(8 * hsO - 120 * hsE));
            const size_t eo0 = ((size_t)(lane >> 4) * NTOK + (t + tk)) * 16 + l15, eo1 = eo0 + (size_t)4 * NTOK * 16;
            e0[tk] = eidx[eo0]; e1[tk] = eidx[eo1]; g0[tk] = egate[eo0]; g1[tk] = egate[eo1];
        }
#pragma unroll
        for (int tk = 0; tk < NTK; ++tk) {
            LAS unsigned* cnt = (LAS unsigned*)F.lds + F.wid * 512; LAS int* sid = (LAS int*)(cnt + 64); LAS float* sgt = (LAS float*)(cnt + 192);
            if (lane < 9) cnt[lane] = 0u;
            const int o0 = e0[tk] >> 11, o1 = e1[tk] >> 11;
            const unsigned p0 = __atomic_fetch_add(cnt + o0, 1u, __ATOMIC_RELAXED), p1 = __atomic_fetch_add(cnt + o1, 1u, __ATOMIC_RELAXED);
            int cc[8], dd[9]; dd[0] = 0;
#pragma unroll
            for (int k = 0; k < 8; ++k) { cc[k] = (int)cnt[k]; dd[k + 1] = dd[k] + (cc[k] < 16 ? 16 - cc[k] : 0); }
            unsigned d0 = 16u * (unsigned)o0 + p0, d1 = 16u * (unsigned)o1 + p1;
            if (p0 >= 16u) { const int r = (int)__atomic_fetch_add(cnt + 8, 1u, __ATOMIC_RELAXED);
#pragma unroll
                for (int k = 0; k < 8; ++k) d0 = (r >= dd[k] && r < dd[k + 1]) ? (unsigned)(16 * k + cc[k] + r - dd[k]) : d0; }
            if (p1 >= 16u) { const int r = (int)__atomic_fetch_add(cnt + 8, 1u, __ATOMIC_RELAXED);
#pragma unroll
                for (int k = 0; k < 8; ++k) d1 = (r >= dd[k] && r < dd[k + 1]) ? (unsigned)(16 * k + cc[k] + r - dd[k]) : d1; }
            sid[d0] = e0[tk]; sgt[d0] = g0[tk]; sid[d1] = e1[tk]; sgt[d1] = g1[tk];
            e0[tk] = sid[lane]; e1[tk] = sid[64 + lane]; g0[tk] = sgt[lane]; g1[tk] = sgt[64 + lane];
            asm volatile("s_waitcnt lgkmcnt(0)" ::: "memory");
        }
        int dA[NTK], dB[NTK];
#pragma unroll
        for (int tk = 0; tk < NTK; ++tk) { dA[tk] = 0; dB[tk] = 0; }
#pragma unroll 1
        for (int gi = 0; gi < 8; ++gi) {
#pragma unroll
          for (int tk = 0; tk < NTK; ++tk) {
            int stage = 0;
            u32x4 ub[16];
#pragma unroll
            for (int k = 0; k < 16; ++k) { const int slot = gi * 16 + k; const int e = __builtin_amdgcn_readlane(slot < 64 ? e0[tk] : e1[tk], slot & 63);
                ub[k] = *(const u32x4*)(U4 + (size_t)e * (DM / 2) + lane * 16); }
#pragma unroll
            for (int k = 0; k < 16; ++k) { int a0 = 0, a1 = 0; const unsigned w[4] = {ub[k].x, ub[k].y, ub[k].z, ub[k].w};
#pragma unroll
                for (int d = 0; d < 4; ++d) { a0 = __builtin_amdgcn_sdot4((int)(w[d] & 0x0F0F0F0Fu), (int)hq[tk][2 * d], a0, false); a1 = __builtin_amdgcn_sdot4((int)(w[d] & 0xF0F0F0F0u), (int)hq[tk][2 * d + 1], a1, false); }
                const int rs = row16_isum((a0 << 4) + a1);
                stage = (l15 == k) ? rs : stage; }
            const int dsum = xrow_isum(stage);
            const bool mine = (lane >> 4) == (gi & 3);
            if (gi < 4) dA[tk] = mine ? dsum : dA[tk]; else dB[tk] = mine ? dsum : dB[tk];
            asm volatile("" ::: "memory");
          }
        }
        LAS unsigned* cf = (LAS unsigned*)((LAS unsigned char*)F.lds + 57344 + F.wid * 1024);
#pragma unroll
        for (int tk = 0; tk < NTK; ++tk) {
            const float aA = g0[tk] * gelu_erf((float)(dA[tk] + hsum[tk]) * (0.0625f * SU[e0[tk]] * sh[tk])) * SV[e0[tk]];
            const float aB = g1[tk] * gelu_erf((float)(dB[tk] + hsum[tk]) * (0.0625f * SU[e1[tk]] * sh[tk])) * SV[e1[tk]];
            const float amx = wave_max(fmaxf(fabsf(aA), fabsf(aB)));
            const float sa_ = amx > 0.f ? amx * (1.0f / 127.0f) : 1.0f, sai = 1.0f / sa_;
            const int qA = (int)__builtin_rintf(aA * sai), qB = (int)__builtin_rintf(aB * sai);
            const int qsum_ = xrow_isum(row16_isum(qA + qB));
            const unsigned pkA_ = ((unsigned)dppu<0x00>((unsigned)qA) & 0xffu) | (((unsigned)dppu<0x55>((unsigned)qA) & 0xffu) << 8) | (((unsigned)dppu<0xAA>((unsigned)qA) & 0xffu) << 16) | ((unsigned)dppu<0xFF>((unsigned)qA) << 24);
            const unsigned pkB_ = ((unsigned)dppu<0x00>((unsigned)qB) & 0xffu) | (((unsigned)dppu<0x55>((unsigned)qB) & 0xffu) << 8) | (((unsigned)dppu<0xAA>((unsigned)qB) & 0xffu) << 16) | ((unsigned)dppu<0xFF>((unsigned)qB) << 24);
            if ((lane & 3) == 0) { cf[tk * 32 + (lane >> 2)] = pkA_; cf[tk * 32 + 16 + (lane >> 2)] = pkB_; }
            if (lane == 0) { cf[128 + tk] = __float_as_uint(sa_); cf[132 + tk] = (unsigned)qsum_; }
        }
        asm volatile("s_waitcnt lgkmcnt(0)" ::: "memory");
        {   constexpr int pr = 0;
        int yi[NTK][8][4];
#pragma unroll
        for (int tk = 0; tk < NTK; ++tk)
#pragma unroll
            for (int i = 0; i < 8; ++i)
#pragma unroll
                for (int j = 0; j < 4; ++j) yi[tk][i][j] = 0;
#pragma unroll 1
        for (int sb = 0; sb < 128; sb += 16) {
#pragma unroll
          for (int tk = 0; tk < NTK; ++tk) {
            u32x4 vb[16]; unsigned a4[4];
#pragma unroll
            for (int k = 0; k < 16; ++k) { const int slot = sb + k; const int e = __builtin_amdgcn_readlane(slot < 64 ? e0[pr + tk] : e1[pr + tk], slot & 63);
                vb[k] = *(const u32x4*)(V4 + (size_t)e * (DM / 2) + lane * 16); }
#pragma unroll
            for (int qd = 0; qd < 4; ++qd) a4[qd] = cf[(pr + tk) * 32 + (sb >> 2) + qd];
#pragma unroll
            for (int qd = 0; qd < 4; ++qd) {
#pragma unroll
                for (int d = 0; d < 4; ++d) {
                    const unsigned w1 = vb[4 * qd][d], w2 = vb[4 * qd + 1][d], w3 = vb[4 * qd + 2][d], w4 = vb[4 * qd + 3][d];
                    const unsigned p01 = __builtin_amdgcn_perm(w2, w1, 0x05010400u), p01h = __builtin_amdgcn_perm(w2, w1, 0x07030602u), p23 = __builtin_amdgcn_perm(w4, w3, 0x05010400u), p23h = __builtin_amdgcn_perm(w4, w3, 0x07030602u);
                    const unsigned t4[4] = {__builtin_amdgcn_perm(p23, p01, 0x05040100u), __builtin_amdgcn_perm(p23, p01, 0x07060302u), __builtin_amdgcn_perm(p23h, p01h, 0x05040100u), __builtin_amdgcn_perm(p23h, p01h, 0x07060302u)};
#pragma unroll
                    for (int j = 0; j < 4; ++j) {
                        yi[tk][2 * d][j] = __builtin_amdgcn_sdot4((int)(t4[j] & 0x0F0F0F0Fu), (int)a4[qd], yi[tk][2 * d][j], false);
                        yi[tk][2 * d + 1][j] = __builtin_amdgcn_sdot4((int)(t4[j] & 0xF0F0F0F0u), (int)a4[qd], yi[tk][2 * d + 1][j], false); }
                }
            }
            asm volatile("" ::: "memory");
          }
        }
        u32x2 xq[NTK][8];
#pragma unroll
        for (int i = 0; i < 8; ++i) xq[0][i] = __builtin_nontemporal_load((const u32x2*)(x1 + (size_t)(t + pr) * DM + i * 256 + lane * 4));
#pragma unroll
        for (int tk = 0; tk < NTK; ++tk) {
        const int tq = t + pr + tk;
        if (tk + 1 < NTK) {
#pragma unroll
            for (int i = 0; i < 8; ++i) xq[tk + 1 < NTK ? tk + 1 : tk][i] = __builtin_nontemporal_load((const u32x2*)(x1 + (size_t)(tq + 1) * DM + i * 256 + lane * 4)); }
        float z[8][4]; float s = 0.f; const int qs_ = (int)cf[132 + pr + tk]; const float sa_ = __uint_as_float(cf[128 + pr + tk]); const int ybias = 15 * qs_; const float sah = 0.5f * sa_, sa16 = 0.0625f * sa_;
#pragma unroll
        for (int i = 0; i < 8; ++i) { const int c = i * 256 + lane * 4; const u32x2 xr = xq[tk][i]; const f32x4 xv = {bf_lo(xr.x), bf_hi(xr.x), bf_lo(xr.y), bf_hi(xr.y)}, gf1 = *(const LAS f32x4*)(pl + c);
#pragma unroll
            for (int j = 0; j < 4; ++j) { const float yy = (i & 1) ? sa16 * (float)(yi[tk][i][j] + 8 * qs_) : sah * (float)(2 * yi[tk][i][j] - ybias); const float zz = fmaf(ALPHA, xv[j], gf1[j] * yy); z[i][j] = zz; s += zz; } }
        const float mean = wave_sum(s) * (1.0f / DM); float qv = 0.f;
#pragma unroll
        for (int i = 0; i < 8; ++i)
#pragma unroll
            for (int j = 0; j < 4; ++j) { z[i][j] -= mean; qv += z[i][j] * z[i][j]; }
        const float rstd = __builtin_amdgcn_rsqf(wave_sum(qv) * (1.0f / DM) + LN_EPS);
        float hmax = 0.f;
#pragma unroll
        for (int i = 0; i < 8; ++i) { const int c = i * 256 + lane * 4; const f32x4 gg = *(const LAS f32x4*)(pl + 2048 + c), be = *(const LAS f32x4*)(pl + 4096 + c); f32x4 o4;
#pragma unroll
            for (int j = 0; j < 4; ++j) o4[j] = fmaf(z[i][j] * rstd, gg[j], be[j]);
            __builtin_nontemporal_store(o4, (f32x4*)(xo + (size_t)tq * DM + c));
            if (!last) { const f32x4 shv = *(const LAS f32x4*)(pl + 8192 + c), sc1 = *(const LAS f32x4*)(pl + 6144 + c);
#pragma unroll
                for (int j = 0; j < 4; ++j) { z[i][j] = fmaf(o4[j], sc1[j], shv[j]); hmax = fmaxf(hmax, fabsf(z[i][j])); } } }
        if (!last) {
            hmax = wave_max(hmax); const float hs = hmax > 0.f ? hmax * (1.0f / 6.0f) : 1.0f, hi = 1.0f / hs;
            unsigned char* hrow = F.ws + WS_H + (size_t)tq * (DM / 2);
#pragma unroll
            for (int i = 0; i < 8; ++i) *(unsigned short*)(hrow + i * 128 + lane * 2) = (unsigned short)(fp4_code(z[i][0] * hi) | (fp4_code(z[i][1] * hi) << 4) | (fp4_code(z[i][2] * hi) << 8) | (fp4_code(z[i][3] * hi) << 12));
            if (lane == 0) ((float*)(F.ws + WS_SH))[tq] = hs;
        }
        }
        }
    }
    }
}

constexpr int NPL = 7;
constexpr int N_PHASES = 1 + NPL * DEPTH;
__global__ void __launch_bounds__(NTHREADS, 2) mk_fwd(Args args) {
    extern __shared__ __attribute__((aligned(16))) unsigned char lds_raw[];
    Frame F; F.a = &args; F.ws = args.ws; F.lds = (char*)lds_raw; F.tid = threadIdx.x; F.lane = F.tid & 63; F.wid = __builtin_amdgcn_readfirstlane(F.tid >> 6); F.G = gridDim.x; F.bid = blockIdx.x;
    LAS unsigned char* ldsl = (LAS unsigned char*)lds_raw;
    volatile LAS unsigned* misc = (volatile LAS unsigned*)(ldsl + LDS_MISC);
    if (F.tid < 64) misc[F.tid] = 0u;
    __syncthreads();
    XcdBarrier bar; bar.bar = (unsigned*)(args.ws + WS_CTL); bar.x = 0; bar.st = misc;
    if (args.use_bar) bar = xcd_barrier_post((unsigned*)(args.ws + WS_CTL), misc);
    const int lo = args.ph_lo, hi = args.ph_hi;
#define REFRAME() do { int tz_ = threadIdx.x; asm volatile("" : "+v"(tz_)); F.tid = tz_; F.lane = tz_ & 63; F.wid = __builtin_amdgcn_readfirstlane(tz_ >> 6); } while (0)
#ifndef MK_PHMASK
#define MK_PHMASK 0x3ff
#endif
#define PHJ(j) ((MK_PHMASK >> (j)) & 1)
#ifndef MK_DUP
#define MK_DUP 0
#endif
#define DUPJ(j) ((MK_DUP >> (j)) & 1)
#define IN(k) (lo <= (k) && (k) < hi)
#define SEAM(k) do { if (args.use_bar && IN((k) + 1)) xcd_barrier(bar); } while (0)
    if (PHJ(0) && IN(0)) { REFRAME(); phase_c0(F); if (DUPJ(0)) { __syncthreads(); phase_c0(F); } SEAM(0); }
    for (int l = 0; l < DEPTH; ++l) {
        const int pb = 1 + NPL * l;
        if (PHJ(2) && IN(pb + 0)) {
            REFRAME();
            pg8::Gemm g{(const bf16_t*)(F.ws + WS_H), (const bf16_t*)F.wl(l, WL_WIN), DM / 4, DM / 4}; pg8::SchedG1 S; S.init(NTOK, INW, DM / 4, F.G, F.bid);
            pg8::EpiG1 E{(float*)(F.ws + WS_QKRAW), (bf16_t*)(F.ws + WS_QKVB), (unsigned char*)(F.ws + WS_GATES), (const float*)(F.ws + WS_SH), (const float*)F.wl(l, WL_SWIN)};
            pg8::gemm_phase(ldsl + LDS_RING, g, S, E); if (DUPJ(2)) pg8::gemm_phase(ldsl + LDS_RING, g, S, E);
            asm volatile("s_waitcnt vmcnt(0)" ::: "memory"); __syncthreads(); REFRAME();
            pg8::Unit u; for (int i = 0; S.next(i, u); ++i) if (u.pn < 5) norm_rope_tile(F, l, u.pm, u.pn);
            SEAM(pb + 0);
        }
        if (PHJ(3) && IN(pb + 1)) { REFRAME(); phase_att(F, l); if (DUPJ(3)) phase_att(F, l); SEAM(pb + 1); }
        if (PHJ(4) && IN(pb + 2)) {
            REFRAME();
            pg8::Gemm g{(const bf16_t*)(F.ws + WS_AO), (const bf16_t*)F.wl(l, WL_WP), AOW, AOW}; pg8::SchedSimple S; S.init(NTOK, DM, AOW, F.G, F.bid);
            pg8::EpiG2 E{(const unsigned char*)(F.ws + WS_GATES), (bf16_t*)(F.ws + WS_MERGED), (const float*)(F.ws + WS_LSEB), (float*)(F.lds + LDS_WTAB)};
            pg8::gemm_phase(ldsl + LDS_RING, g, S, E); if (DUPJ(5)) pg8::gemm_phase(ldsl + LDS_RING, g, S, E); SEAM(pb + 2);
        }
        if (PHJ(5) && IN(pb + 3)) {
            REFRAME();
            pg8::Gemm g{(const bf16_t*)(F.ws + WS_MERGED), (const bf16_t*)F.wl(l, WL_WO), DM, DM}; pg8::SchedSimple S; S.init(NTOK, DM, DM, F.G, F.bid);
            pg8::EpiG3 E{(const float*)(F.ws + WS_MOD) + (size_t)l * NBATCH * MODW + 2 * DM, (bf16_t*)(F.ws + WS_Z)};
            pg8::gemm_phase(ldsl + LDS_RING, g, S, E); if (DUPJ(6)) pg8::gemm_phase(ldsl + LDS_RING, g, S, E); SEAM(pb + 3);
        }
        if (PHJ(6) && IN(pb + 4)) { REFRAME(); phase_ln1(F, l); if (DUPJ(7)) phase_ln1(F, l); SEAM(pb + 4); }
        if (PHJ(7) && IN(pb + 5)) {
            REFRAME();
            pg8::Gemm g{(const bf16_t*)(F.ws + WS_H2), (const bf16_t*)F.wl(l, WL_WQK), DM / 2, DM / 2}; pg8::SchedSimple S; S.init(NTOK, DM, DM / 2, F.G, F.bid);
            pg8::EpiSC8 E{(float*)(F.ws + WS_SC), (const float*)(F.ws + WS_SH2), (const float*)F.wl(l, WL_SWQK), &F, (float*)F.lds};
            pg8::gemm_phase(ldsl + LDS_RING, g, S, E);
            asm volatile("s_waitcnt vmcnt(0)" ::: "memory"); __syncthreads(); REFRAME();
            pg8::Unit u, un; for (int i = 0; S.next(i, u); ++i) if (S.next(i + 1, un)) topk_tile(F, u.pm, u.pn);
            if (DUPJ(9)) { __syncthreads(); pg8::gemm_phase(ldsl + LDS_RING, g, S, E); }
            SEAM(pb + 5);
        }
        if (PHJ(8) && IN(pb + 6)) { REFRAME(); phase_pe(F, l); if (DUPJ(10)) phase_pe(F, l); SEAM(pb + 6); }
    }
#undef IN
#undef SEAM
}

extern "C" void kernel_launch(void* const* d_in, const int* in_sizes, int n_in, void* d_out, int out_size, void* d_ws, size_t ws_size, hipStream_t stream) {
    static int grid = 0;
    if (grid == 0) {
        if (n_in != 20 || out_size != NTOK * DM || ws_size < WS_END) { fprintf(stderr, "kernel_launch: unexpected shapes: n_in %d out %d ws %zu (need %zu)\n", n_in, out_size, ws_size, (size_t)WS_END); grid = -1; return; }
        int dev = 0, cus = 0, per_cu = 0;
        if (hipGetDevice(&dev) != hipSuccess || hipDeviceGetAttribute(&cus, hipDeviceAttributeMultiprocessorCount, dev) != hipSuccess) { grid = -1; return; }
        if (hipFuncSetAttribute((const void*)mk_fwd, hipFuncAttributeMaxDynamicSharedMemorySize, LDS_BYTES) != hipSuccess) { fprintf(stderr, "kernel_launch: hipFuncSetAttribute failed\n"); grid = -1; return; }
        if (hipOccupancyMaxActiveBlocksPerMultiprocessor(&per_cu, (const void*)mk_fwd, NTHREADS, LDS_BYTES) != hipSuccess || per_cu < 1) { fprintf(stderr, "kernel_launch: occupancy query reports %d\n", per_cu); (void)hipGetLastError(); }
        grid = cus;
    }
    if (grid < 0) return;
    (void)hipMemsetAsync((char*)d_ws + WS_CTL, 0, CTL_BYTES, stream);
    Args a{};
    for (int i = 0; i < 20; ++i) a.in[i] = (const float*)d_in[i];
    a.out = (float*)d_out; a.ws = (unsigned char*)d_ws; a.pad = 0;
#if MK_ONE_LAUNCH
    a.ph_lo = 0; a.ph_hi = N_PHASES; a.use_bar = 1;
    hipLaunchKernelGGL(mk_fwd, dim3(grid), dim3(NTHREADS), LDS_BYTES, stream, a);
#else
    for (int p = 0; p < N_PHASES; ++p) { a.ph_lo = p; a.ph_hi = p + 1; a.use_bar = 0; hipLaunchKernelGGL(mk_fwd, dim3(grid), dim3(NTHREADS), LDS_BYTES, stream, a); }
#endif
    const hipError_t le = hipPeekAtLastError();
    if (le != hipSuccess) fprintf(stderr, "kernel_launch: launch failed: %s\n", hipGetErrorName(le));
}
```
